# Optimizing an MI355X kernel written in HIP

```python
import jax, jax.numpy as jnp
from jax import lax
import numpy as np

D_MODEL = 1024
BATCH = 4
SEQ = 8192
DEPTH = 2

N_MIXERS = 2
ATTN_HEADS = 8
HEAD_DIM = D_MODEL // ATTN_HEADS
MOBA_BLOCK = 256
MOBA_TOPK = 3
Q_CHUNK = 16
CONV_WIDTH = 3
FFN_HIDDEN = ((-(-8 * D_MODEL // 3) + 255) // 256) * 256
RMS_EPS = 1e-6
N_ATTN_LAYERS = (DEPTH + N_MIXERS - 1) // N_MIXERS
N_CONV_LAYERS = DEPTH // N_MIXERS

kernel_name = "moba_shortconv_hybrid_trunk"


def rms_norm(x, g):
    xf = x.astype(jnp.float32)
    y = xf * lax.rsqrt(jnp.mean(xf * xf, axis=-1, keepdims=True) + RMS_EPS)
    return (y * g.astype(jnp.float32)).astype(x.dtype)


def moba_attention(h, w_qkv, w_o):
    B, S, _ = h.shape
    H, Dh, BS = ATTN_HEADS, HEAD_DIM, MOBA_BLOCK
    nb = -(-S // BS)
    pad = nb * BS - S
    qkv = jnp.einsum('bsd,de->bse', h, w_qkv).reshape(B, S, 3, H, Dh)
    q = jnp.transpose(qkv[:, :, 0], (0, 2, 1, 3))
    k = jnp.pad(jnp.transpose(qkv[:, :, 1], (0, 2, 1, 3)), ((0, 0), (0, 0), (0, pad), (0, 0)))
    v = jnp.pad(jnp.transpose(qkv[:, :, 2], (0, 2, 1, 3)), ((0, 0), (0, 0), (0, pad), (0, 0)))
    kb = k.reshape(B, H, nb, BS, Dh)
    vb = v.reshape(B, H, nb, BS, Dh)
    k_mean = jnp.mean(kb.astype(jnp.float32), axis=3)
    topk = min(MOBA_TOPK, nb)
    n_chunks = S // Q_CHUNK
    q_chunks = jnp.moveaxis(q.reshape(B, H, n_chunks, Q_CHUNK, Dh), 2, 0)
    starts = jnp.arange(n_chunks, dtype=jnp.int32) * Q_CHUNK
    b_ix = jnp.arange(B)[:, None, None, None]
    h_ix = jnp.arange(H)[None, :, None, None]
    blk_ids = jnp.arange(nb, dtype=jnp.int32)
    offs = jnp.arange(BS, dtype=jnp.int32)
    scale = Dh ** -0.5
    neg = jnp.finfo(jnp.float32).min

    def one_chunk(args):
        qc, start = args
        t = start + jnp.arange(Q_CHUNK, dtype=jnp.int32)
        own = t // BS
        gate = jnp.einsum('bhqd,bhnd->bhqn', qc.astype(jnp.float32), k_mean)
        past = blk_ids[None, :] < own[:, None]
        gate = jnp.where(past, gate, neg)
        _, sel = lax.top_k(gate, topk)
        own_b = jnp.broadcast_to(own[None, None, :, None], (B, H, Q_CHUNK, 1))
        idx = jnp.concatenate([sel, own_b], axis=-1)
        valid_blk = jnp.concatenate(
            [sel < own[None, None, :, None], jnp.ones((B, H, Q_CHUNK, 1), dtype=bool)], axis=-1)
        kpos = idx[..., None] * BS + offs
        mask = valid_blk[..., None] & (kpos <= t[None, None, :, None, None])
        kg = kb[b_ix, h_ix, idx]
        vg = vb[b_ix, h_ix, idx]
        s = jnp.einsum('bhqd,bhqnkd->bhqnk', qc, kg).astype(jnp.float32) * scale
        s = jnp.where(mask, s, neg)
        p = jax.nn.softmax(s.reshape(B, H, Q_CHUNK, -1), axis=-1).reshape(s.shape)
        return jnp.einsum('bhqnk,bhqnkd->bhqd', p.astype(vg.dtype), vg)

    out = lax.map(one_chunk, (q_chunks, starts))
    out = jnp.moveaxis(out, 0, 2).reshape(B, H, S, Dh)
    out = jnp.transpose(out, (0, 2, 1, 3)).reshape(B, S, H * Dh)
    return jnp.einsum('bse,ed->bsd', out, w_o)


def short_conv_mixer(h, w_in, conv_w, w_out):
    S = h.shape[1]
    bcx = jnp.einsum('bsd,de->bse', h, w_in)
    b_gate, c_gate, xt = jnp.split(bcx, 3, axis=-1)
    u = c_gate * xt
    up = jnp.pad(u, ((0, 0), (CONV_WIDTH - 1, 0), (0, 0)))
    conv = conv_w[0] * up[:, 0:S]
    for j in range(1, CONV_WIDTH):
        conv = conv + conv_w[j] * up[:, j:j + S]
    return jnp.einsum('bsd,de->bse', b_gate * conv, w_out)


def swiglu(h, w_in, w_out):
    g, u = jnp.split(jnp.einsum('bsd,df->bsf', h, w_in), 2, axis=-1)
    return jnp.einsum('bsf,fd->bsd', jax.nn.silu(g) * u, w_out)


def setup_inputs(seed: int = 0) -> dict:
    key = jax.random.key(seed)
    ks = jax.random.split(key, 12)
    D, F = D_MODEL, FFN_HIDDEN
    na, nc = N_ATTN_LAYERS, N_CONV_LAYERS
    f32 = jnp.float32

    def w(k, shape, fan_in):
        return jax.random.normal(k, shape, f32) * (fan_in ** -0.5)

    def gain(k, shape):
        return 1.0 + 0.05 * jax.random.normal(k, shape, f32)

    return {
        "x": jax.random.normal(ks[0], (BATCH, SEQ, D), f32),
        "attn_norm": gain(ks[1], (na, D)),
        "attn_w_qkv": w(ks[2], (na, D, 3 * ATTN_HEADS * HEAD_DIM), D),
        "attn_w_o": w(ks[3], (na, ATTN_HEADS * HEAD_DIM, D), ATTN_HEADS * HEAD_DIM),
        "conv_norm": gain(ks[4], (nc, D)),
        "conv_w_in": w(ks[5], (nc, D, 3 * D), D),
        "conv_w": w(ks[6], (nc, CONV_WIDTH, D), CONV_WIDTH),
        "conv_w_out": w(ks[7], (nc, D, D), D),
        "ffn_norm": gain(ks[8], (DEPTH, D)),
        "ffn_w_in": w(ks[9], (DEPTH, D, 2 * F), D),
        "ffn_w_out": w(ks[10], (DEPTH, F, D), F),
        "final_norm": gain(ks[11], (D,)),
    }


def reference(x, attn_norm, attn_w_qkv, attn_w_o, conv_norm, conv_w_in, conv_w, conv_w_out,
              ffn_norm, ffn_w_in, ffn_w_out, final_norm):
    for i in range(DEPTH):
        j = i // N_MIXERS
        if i % N_MIXERS == 0:
            x = x + moba_attention(rms_norm(x, attn_norm[j]), attn_w_qkv[j], attn_w_o[j])
        else:
            x = x + short_conv_mixer(rms_norm(x, conv_norm[j]), conv_w_in[j], conv_w[j], conv_w_out[j])
        x = x + swiglu(rms_norm(x, ffn_norm[i]), ffn_w_in[i], ffn_w_out[i])
    return rms_norm(x, final_norm)
```

```cpp
#include <hip/hip_runtime.h>
#include <cstdio>
#include <cstdint>
namespace pg8 {
#define PG8_LAS __attribute__((address_space(3)))
typedef unsigned short bf16_t;
typedef short bf16x8 __attribute__((ext_vector_type(8)));
typedef float f32x4 __attribute__((ext_vector_type(4)));
typedef unsigned u32x4 __attribute__((ext_vector_type(4)));
constexpr int BM = 256, BK = 64, HALF = 128, HTB = HALF * BK * 2  , STAGE_BYTES = 8 * HTB, NXCD = 8, WGM = 8;

__host__ __device__ __forceinline__ int lds_byte(int r, int c) { const int st = (r >> 4) * 2 + (c >> 5), rr = r & 15, cc = c & 31, ob = rr * 64 + cc * 2; return st * 1024 + (ob ^ (((ob >> 9) & 1) << 5)); }
__host__ __device__ __forceinline__ void stage_rc(int b, int& R, int& C) { const int st = b / 1024, sb = b % 1024, swz = sb ^ (((sb >> 9) & 1) << 5); R = (st >> 1) * 16 + swz / 64; C = (st & 1) * 32 + (swz % 64) / 2; }
__host__ __device__ __forceinline__ int perm32(int rho) { const int n = rho >> 4, i = rho & 15; return 8 * (i >> 2) + 4 * n + (i & 3); }

struct Unit { int pm, pn; };
struct Gemm { const bf16_t* A; const bf16_t* Bt; int M, N, K; };

struct StaticOrder {
    int nM, nN, nwg, G, c;
    __host__ __device__ void init(int M, int N, int G_, int c_) { nM = M / BM; nN = N / BM; nwg = nM * nN; G = G_; c = c_; }
    __host__ __device__ bool next(int i, Unit& u) const {
        const long L = (long)i * G + c; if (L >= nwg) return false;
        int wgid = (int)L; { const int q = nwg / NXCD, r = nwg % NXCD, xcd = wgid % NXCD, off = wgid / NXCD; wgid = (xcd < r ? xcd * (q + 1) : r * (q + 1) + (xcd - r) * q) + off; }
        const int nig = WGM * nN, gid = wgid / nig, fm = gid * WGM, gsz = (nM - fm) < WGM ? (nM - fm) : WGM;
        u.pm = fm + ((wgid % nig) % gsz); u.pn = (wgid % nig) / gsz; return true;
    }
    __device__ __forceinline__ void a_ready(const Unit&) const {}
    __device__ __forceinline__ void done(const Unit&) const {}
};

__device__ __forceinline__ unsigned cvt_pk_bf16(float lo, float hi) { unsigned r; asm volatile("v_cvt_pk_bf16_f32 %0, %1, %2" : "=v"(r) : "v"(lo), "v"(hi)); return r; }
constexpr int   ROWLEN = 1024;
constexpr float RMS_EPS = 1e-6f, INV_D = 1.0f / 1024.0f;
__device__ __forceinline__ u32x4 pack8(const f32x4 a, const f32x4 b) { u32x4 w; w.x = cvt_pk_bf16(a[0], a[1]); w.y = cvt_pk_bf16(a[2], a[3]); w.z = cvt_pk_bf16(b[0], b[1]); w.w = cvt_pk_bf16(b[2], b[3]); return w; }
__device__ __forceinline__ float rowscale(const float* ss, int row) { return __builtin_amdgcn_rsqf(ss[row] * INV_D + RMS_EPS); }

struct EpiQKV {
    static constexpr bool PERM = true, AFTER_DRAIN = false;
    bf16_t* Q; size_t tstride; const float* ss; float* ksum; float qscale;
    __device__ __forceinline__ void operator()(const f32x4 (&acc)[2][2][4][2], const Unit& u, int wr, int wc, int fr, int fq) const {
        const int t = u.pn >> 2, colt = (u.pn & 3) * BM + wc * 32 + 8 * fq;
        bf16_t* base = Q + (size_t)t * tstride;
        const float sc = (t == 0) ? qscale : 1.0f;
        f32x4 cs[2][2];
#pragma unroll
        for (int bj = 0; bj < 2; ++bj)
#pragma unroll
            for (int n = 0; n < 2; ++n) cs[bj][n] = (f32x4){0.f, 0.f, 0.f, 0.f};
#pragma unroll
        for (int ai = 0; ai < 2; ++ai)
#pragma unroll
            for (int m = 0; m < 4; ++m) {
                const int row = u.pm * BM + ai * HALF + wr * 64 + m * 16 + fr;
                const float r = rowscale(ss, row) * sc;
#pragma unroll
                for (int bj = 0; bj < 2; ++bj) {
                    const f32x4 v0 = acc[ai][bj][m][0] * r, v1 = acc[ai][bj][m][1] * r;
                    cs[bj][0] += v0; cs[bj][1] += v1;
                    *(u32x4*)(base + (size_t)row * ROWLEN + colt + bj * HALF) = pack8(v0, v1);
                }
            }
        if (t == 1) {
#pragma unroll
            for (int bj = 0; bj < 2; ++bj)
#pragma unroll
                for (int n = 0; n < 2; ++n)
#pragma unroll
                    for (int e = 0; e < 4; ++e) {
                        float s = cs[bj][n][e];
                        s += __shfl_xor(s, 1); s += __shfl_xor(s, 2); s += __shfl_xor(s, 4); s += __shfl_xor(s, 8);
                        if (fr == 0) atomicAdd(ksum + (size_t)u.pm * ROWLEN + colt + bj * HALF + 4 * n + e, s);
                    }
        }
    }
};

template <bool WANT_NEXT> struct EpiRes {
    static constexpr bool PERM = true, AFTER_DRAIN = false;
    const float* xin; float* xout; bf16_t* xb; float* ss;
    __device__ __forceinline__ void operator()(const f32x4 (&acc)[2][2][4][2], const Unit& u, int wr, int wc, int fr, int fq) const {
        const int col0 = u.pn * BM + wc * 32 + 8 * fq;
#pragma unroll
        for (int ai = 0; ai < 2; ++ai)
#pragma unroll
            for (int m = 0; m < 4; ++m) {
                const int row = u.pm * BM + ai * HALF + wr * 64 + m * 16 + fr;
                float sq = 0.f;
#pragma unroll
                for (int bj = 0; bj < 2; ++bj) {
                    const size_t off = (size_t)row * ROWLEN + col0 + bj * HALF;
                    const f32x4 v0 = *(const f32x4*)(xin + off) + acc[ai][bj][m][0], v1 = *(const f32x4*)(xin + off + 4) + acc[ai][bj][m][1];
                    *(f32x4*)(xout + off) = v0; *(f32x4*)(xout + off + 4) = v1;
                    if (WANT_NEXT) {
                        *(u32x4*)(xb + off) = pack8(v0, v1);
                        sq += (v0[0] * v0[0] + v0[1] * v0[1]) + (v0[2] * v0[2] + v0[3] * v0[3]) + (v1[0] * v1[0] + v1[1] * v1[1]) + (v1[2] * v1[2] + v1[3] * v1[3]);
                    }
                }
                if (WANT_NEXT) { sq += __shfl_xor(sq, 16); sq += __shfl_xor(sq, 32); if (fq == 0) atomicAdd(ss + row, sq); }
            }
    }
};

struct EpiSwiglu {
    static constexpr bool PERM = true, AFTER_DRAIN = false;
    bf16_t* Hh; int ldh; const float* ss;
    __device__ __forceinline__ void operator()(const f32x4 (&acc)[2][2][4][2], const Unit& u, int wr, int wc, int fr, int fq) const {
        const int col0 = u.pn * HALF + wc * 32 + 8 * fq;
#pragma unroll
        for (int ai = 0; ai < 2; ++ai)
#pragma unroll
            for (int m = 0; m < 4; ++m) {
                const int row = u.pm * BM + ai * HALF + wr * 64 + m * 16 + fr;
                const float r = rowscale(ss, row);
                f32x4 hv[2];
#pragma unroll
                for (int n = 0; n < 2; ++n) {
                    const f32x4 g = acc[ai][0][m][n] * r, uu = acc[ai][1][m][n] * r;
#pragma unroll
                    for (int e = 0; e < 4; ++e) hv[n][e] = g[e] * uu[e] * __builtin_amdgcn_rcpf(1.0f + __builtin_amdgcn_exp2f(g[e] * -1.4426950408889634f));
                }
                *(u32x4*)(Hh + (size_t)row * ldh + col0) = pack8(hv[0], hv[1]);
            }
    }
};

struct EpiConvIn {
    static constexpr bool PERM = true, AFTER_DRAIN = false;
    bf16_t* U; bf16_t* Bb; const float* ss;
    __device__ __forceinline__ void operator()(const f32x4 (&acc)[2][2][4][2], const Unit& u, int wr, int wc, int fr, int fq) const {
#pragma unroll
        for (int ai = 0; ai < 2; ++ai)
#pragma unroll
            for (int m = 0; m < 4; ++m) {
                const int row = u.pm * BM + ai * HALF + wr * 64 + m * 16 + fr;
                const float r = rowscale(ss, row);
                if (u.pn < 8) {
                    const float r2 = r * r;
                    const f32x4 a = acc[ai][0][m][0] * acc[ai][1][m][0] * r2, b = acc[ai][0][m][1] * acc[ai][1][m][1] * r2;
                    *(u32x4*)(U + (size_t)row * ROWLEN + u.pn * HALF + wc * 32 + 8 * fq) = pack8(a, b);
                } else {
#pragma unroll
                    for (int bj = 0; bj < 2; ++bj)
                        *(u32x4*)(Bb + (size_t)row * ROWLEN + (u.pn - 8) * BM + bj * HALF + wc * 32 + 8 * fq) = pack8(acc[ai][bj][m][0] * r, acc[ai][bj][m][1] * r);
                }
            }
    }
};

template <class Epi, class Sched, bool ALIGN_EPI = false, bool SP2 = false>
__device__ __forceinline__ void gemm_phase(PG8_LAS unsigned char* lds, const Gemm g, const Sched& S, const Epi& E) {
    const int tid = threadIdx.x, wid = __builtin_amdgcn_readfirstlane(tid >> 6), lane = tid & 63, wr = wid >> 2, wc = wid & 3, fr = lane & 15, fq = lane >> 4;
    const int K = g.K, nt = K / BK;
    unsigned voffA[2], voffB[2];
#pragma unroll
    for (int i = 0; i < 2; ++i) { int R, C; stage_rc(tid * 16 + i * 8192, R, C); const int Rb = Epi::PERM ? ((R & ~31) + perm32(R & 31)) : R;
        voffA[i] = (unsigned)(R * K + C) * 2u; voffB[i] = (unsigned)(Rb * K + C) * 2u; }
    const size_t kstep = (size_t)(BK * 2);
    const size_t hstep = (size_t)HALF * K * 2;
    const size_t tstep = 2 * hstep;
    const unsigned ldsw = (unsigned)wid * 1024u;
    const int aoff = lds_byte(wr * 64 + fr, fq * 8), boff = lds_byte(wc * 32 + fr, fq * 8);
#define PG8_SA(b, h) (((b) * 2 + (h)) * HTB)
#define PG8_SB(b, h) ((4 + (b) * 2 + (h)) * HTB)
#define PG8_STAGE(bufoff, gbase, voff) do { _Pragma("unroll") for (int _i = 0; _i < 2; ++_i) \
        __builtin_amdgcn_global_load_lds((const unsigned*)((const char*)(gbase) + (voff)[_i]), (PG8_LAS unsigned*)(lds + (bufoff) + ldsw + _i * 8192), 16, 0, 0); } while (0)
#define PG8_LDA(dst, b, h) do { _Pragma("unroll") for (int m = 0; m < 4; ++m) _Pragma("unroll") for (int k = 0; k < 2; ++k) dst[m][k] = *(const PG8_LAS bf16x8*)(lds + PG8_SA(b, h) + aoff + m * 2048 + k * 1024); } while (0)
#define PG8_LDB(dst, b, h) do { _Pragma("unroll") for (int n = 0; n < 2; ++n) _Pragma("unroll") for (int k = 0; k < 2; ++k) dst[n][k] = *(const PG8_LAS bf16x8*)(lds + PG8_SB(b, h) + boff + n * 2048 + k * 1024); } while (0)
#define PG8_MMA(ai, bj, At, Bt) do { __builtin_amdgcn_s_setprio(1); _Pragma("unroll") for (int m = 0; m < 4; ++m) _Pragma("unroll") for (int n = 0; n < 2; ++n) _Pragma("unroll") for (int k = 0; k < 2; ++k) \
        acc[ai][bj][m][n] = __builtin_amdgcn_mfma_f32_16x16x32_bf16(Bt[n][k], At[m][k], acc[ai][bj][m][n], 0, 0, 0); __builtin_amdgcn_s_setprio(0); } while (0)
#define PG8_WAIT_V(n) asm volatile("s_waitcnt vmcnt(" #n ")" ::: "memory")
#define PG8_WAIT_L(n) asm volatile("s_waitcnt lgkmcnt(" #n ")" ::: "memory")
#define PG8_BAR __builtin_amdgcn_s_barrier()
#define PG8_SCHED __builtin_amdgcn_sched_barrier(0)
    Unit cur, nxt; int ui = 0;
    if (!S.next(0, cur)) return;
    f32x4 acc[2][2][4][2];
#pragma unroll
    for (int a = 0; a < 2; ++a)
#pragma unroll
        for (int b = 0; b < 2; ++b)
#pragma unroll
            for (int m = 0; m < 4; ++m)
#pragma unroll
                for (int n = 0; n < 2; ++n) acc[a][b][m][n] = (f32x4){0.f, 0.f, 0.f, 0.f};
    bf16x8 At[4][2], B0[2][2], B1[2][2];
    const char* cA = (const char*)g.A + (size_t)cur.pm * tstep; const char* cB = (const char*)g.Bt + (size_t)cur.pn * tstep;
    S.a_ready(cur);
    if constexpr (SP2) {
        PG8_STAGE(PG8_SB(0, 0), cB, voffB); PG8_STAGE(PG8_SB(0, 1), cB + hstep, voffB); PG8_STAGE(PG8_SA(0, 0), cA, voffA); PG8_STAGE(PG8_SA(0, 1), cA + hstep, voffA);
        if (wr == 1) PG8_BAR;
        PG8_WAIT_V(2); PG8_BAR;
        PG8_STAGE(PG8_SB(1, 0), cB + kstep, voffB); PG8_STAGE(PG8_SA(1, 0), cA + kstep, voffA); PG8_STAGE(PG8_SB(1, 1), cB + hstep + kstep, voffB);
        PG8_WAIT_V(6); PG8_BAR;
    } else {
        PG8_STAGE(PG8_SB(0, 0), cB, voffB); PG8_STAGE(PG8_SA(0, 0), cA, voffA); PG8_STAGE(PG8_SB(0, 1), cB + hstep, voffB); PG8_STAGE(PG8_SA(0, 1), cA + hstep, voffA);
        if (wr == 1) PG8_BAR;
        PG8_WAIT_V(4); PG8_BAR;
        PG8_STAGE(PG8_SB(1, 0), cB + kstep, voffB); PG8_STAGE(PG8_SA(1, 0), cA + kstep, voffA); PG8_STAGE(PG8_SB(1, 1), cB + hstep + kstep, voffB);
        PG8_WAIT_V(6); PG8_BAR;
    }
    for (;;) {
        const bool has_next = S.next(ui + 1, nxt);
        const char* nA = has_next ? (const char*)g.A + (size_t)nxt.pm * tstep : cA; const char* nB = has_next ? (const char*)g.Bt + (size_t)nxt.pn * tstep : cB;
        for (int t = 0; t < nt; t += 2) {
            const bool last = (t == nt - 2);
            const char* a1 = cA + (size_t)(t + 1) * kstep;
            const char* a2 = last ? nA : cA + (size_t)(t + 2) * kstep; const char* b2 = last ? nB : cB + (size_t)(t + 2) * kstep;
            const char* a3 = a2 + kstep; const char* b3 = b2 + kstep;
            if (last && has_next) S.a_ready(nxt);
            if constexpr (SP2) {
            PG8_LDB(B0, 0, 0); PG8_LDB(B1, 0, 1); PG8_SCHED; PG8_LDA(At, 0, 0); PG8_STAGE(PG8_SA(1, 1), a1 + hstep, voffA);
            PG8_WAIT_V(8); PG8_WAIT_L(0); PG8_BAR; PG8_MMA(0, 0, At, B0); PG8_MMA(0, 1, At, B1); PG8_BAR; PG8_SCHED;
            PG8_LDA(At, 0, 1); PG8_STAGE(PG8_SB(0, 0), b2, voffB); PG8_STAGE(PG8_SB(0, 1), b2 + hstep, voffB); PG8_STAGE(PG8_SA(0, 0), a2, voffA);
            PG8_WAIT_V(8); PG8_WAIT_L(0); PG8_BAR; PG8_MMA(1, 0, At, B0); PG8_MMA(1, 1, At, B1); PG8_BAR; PG8_SCHED;
            PG8_LDB(B0, 1, 0); PG8_LDB(B1, 1, 1); PG8_SCHED; PG8_LDA(At, 1, 0); PG8_STAGE(PG8_SA(0, 1), a2 + hstep, voffA);
            PG8_WAIT_V(8); PG8_WAIT_L(0); PG8_BAR; PG8_MMA(0, 0, At, B0); PG8_MMA(0, 1, At, B1); PG8_BAR; PG8_SCHED;
            PG8_LDA(At, 1, 1); PG8_STAGE(PG8_SB(1, 0), b3, voffB); PG8_STAGE(PG8_SB(1, 1), b3 + hstep, voffB); PG8_STAGE(PG8_SA(1, 0), a3, voffA);
            PG8_WAIT_V(8); PG8_WAIT_L(0); PG8_BAR; PG8_MMA(1, 0, At, B0); PG8_MMA(1, 1, At, B1); PG8_BAR; PG8_SCHED;
            } else {
            PG8_LDB(B0, 0, 0); PG8_SCHED; PG8_LDA(At, 0, 0); PG8_STAGE(PG8_SA(1, 1), a1 + hstep, voffA);
            PG8_WAIT_L(8); PG8_BAR; PG8_WAIT_L(0); PG8_MMA(0, 0, At, B0); PG8_BAR; PG8_SCHED;
            PG8_LDB(B1, 0, 1); PG8_STAGE(PG8_SB(0, 0), b2, voffB);
            PG8_BAR; PG8_WAIT_L(0); PG8_MMA(0, 1, At, B1); PG8_BAR;
            PG8_LDA(At, 0, 1); PG8_STAGE(PG8_SA(0, 0), a2, voffA);
            PG8_BAR; PG8_WAIT_L(0); PG8_MMA(1, 0, At, B0); PG8_BAR; PG8_SCHED;
            PG8_STAGE(PG8_SB(0, 1), b2 + hstep, voffB);
            PG8_WAIT_V(6); PG8_BAR; PG8_MMA(1, 1, At, B1); PG8_BAR;
            PG8_LDB(B0, 1, 0); PG8_SCHED; PG8_LDA(At, 1, 0); PG8_STAGE(PG8_SA(0, 1), a2 + hstep, voffA);
            PG8_WAIT_L(8); PG8_BAR; PG8_WAIT_L(0); PG8_MMA(0, 0, At, B0); PG8_BAR; PG8_SCHED;
            PG8_LDB(B1, 1, 1); PG8_STAGE(PG8_SB(1, 0), b3, voffB);
            PG8_BAR; PG8_WAIT_L(0); PG8_MMA(0, 1, At, B1); PG8_BAR;
            PG8_LDA(At, 1, 1); PG8_STAGE(PG8_SA(1, 0), a3, voffA);
            PG8_BAR; PG8_WAIT_L(0); PG8_MMA(1, 0, At, B0); PG8_BAR; PG8_SCHED;
            PG8_STAGE(PG8_SB(1, 1), b3 + hstep, voffB);
            PG8_WAIT_V(6); PG8_BAR; PG8_MMA(1, 1, At, B1); PG8_BAR;
            }
        }
        if constexpr (ALIGN_EPI) { if (wr == 0) PG8_BAR; }
        if constexpr (!Epi::AFTER_DRAIN) { E(acc, cur, wr, wc, fr, fq); S.done(cur); }
        if (!has_next) break;
#pragma unroll
        for (int a = 0; a < 2; ++a)
#pragma unroll
            for (int b = 0; b < 2; ++b)
#pragma unroll
                for (int m = 0; m < 4; ++m)
#pragma unroll
                    for (int n = 0; n < 2; ++n) acc[a][b][m][n] = (f32x4){0.f, 0.f, 0.f, 0.f};
        cur = nxt; cA = nA; cB = nB; ++ui;
        if constexpr (ALIGN_EPI) { if (wr == 1) PG8_BAR; }
    }
    PG8_WAIT_V(0);
    if constexpr (!ALIGN_EPI) { if (wr == 0) PG8_BAR; }
    PG8_BAR;
    if constexpr (Epi::AFTER_DRAIN) { E.fused(acc, cur, wr, wc, fr, fq, lds, wid, lane); S.done(cur); }
#undef PG8_SA
#undef PG8_SB
#undef PG8_STAGE
#undef PG8_LDA
#undef PG8_LDB
#undef PG8_MMA
#undef PG8_WAIT_V
#undef PG8_WAIT_L
#undef PG8_BAR
#undef PG8_SCHED
}
}

#ifndef PG8_SP2
#define PG8_SP2 true
#endif
#ifndef PG8_ALIGN
#define PG8_ALIGN true
#endif
#define GAS __attribute__((address_space(1)))
#define LAS __attribute__((address_space(3)))
typedef unsigned short bf16;
typedef unsigned v4u __attribute__((ext_vector_type(4)));
typedef float f32x4 __attribute__((ext_vector_type(4)));
typedef short bf16x8 __attribute__((ext_vector_type(8)));
typedef GAS unsigned gu32;
typedef GAS unsigned long long gu64;
#define RLX_AGENT __ATOMIC_RELAXED, __HIP_MEMORY_SCOPE_AGENT
#define LDS_WAIT() asm volatile("s_waitcnt lgkmcnt(0)" ::: "memory")
#define VM_WAIT() asm volatile("s_waitcnt vmcnt(0)" ::: "memory")
__device__ __forceinline__ unsigned long long rt() { return __builtin_amdgcn_s_memrealtime(); }

#define XB_TMO      128
#define XB_XCNT(j)  (256  + 64 * (j))
#define XB_XSUB(j)  (1280 + 64 * (j))
#define XB_XGEN(j)  (2304 + 64 * (j))
#define XB_TOP      3328
#define XB_TOPGEN   3392
#define XCD_BAR_WORDS 3456
#define XB_SPIN_CAP (1u << 18)

__device__ __forceinline__ unsigned xb_ld(unsigned* p)              { return __hip_atomic_load(p, __ATOMIC_RELAXED, __HIP_MEMORY_SCOPE_AGENT); }
__device__ __forceinline__ unsigned xb_add(unsigned* p, unsigned v) { return __hip_atomic_fetch_add(p, v, __ATOMIC_RELAXED, __HIP_MEMORY_SCOPE_AGENT); }
__device__ __forceinline__ unsigned xb_xcc_id() { return (unsigned)__builtin_amdgcn_s_getreg((3 << 11) | 20) & 0xFu; }
#define XB_SPIN(cond, bar) do { unsigned _sp = 0; while (cond) { __builtin_amdgcn_s_sleep(1); \
    if ((++_sp & 255u) == 0u) { if (xb_ld(&(bar)[XB_TMO])) break; if (_sp > XB_SPIN_CAP) { atomicAdd(&(bar)[XB_TMO], 1u); break; } } } } while (0)

struct XcdBarrier {
    unsigned* bar; unsigned x;
    volatile LAS unsigned* st;
};

__device__ __forceinline__ XcdBarrier xcd_barrier_post(unsigned* bar, volatile LAS unsigned* st) {
    XcdBarrier b; b.bar = bar; b.x = xb_xcc_id(); b.st = st;
    if (threadIdx.x == 0) (void)xb_add(&bar[XB_XCNT(b.x)], 1u);
    return b;
}
__device__ __forceinline__ void xcd_barrier_complete(unsigned* bar, unsigned x, unsigned& nloc, unsigned& nx) {
    const unsigned G = gridDim.x * gridDim.y * gridDim.z;
    unsigned sum, cnt, mine, sp = 0u;
    for (;;) {
        sum = 0u; cnt = 0u; mine = 0u;
#pragma unroll
        for (unsigned j = 0; j < 16; ++j) { const unsigned c = xb_ld(&bar[XB_XCNT(j)]); sum += c; cnt += (c > 0u) ? 1u : 0u; mine = (j == x) ? c : mine; }
        if (sum == G) break;
        __builtin_amdgcn_s_sleep(1);
        if ((++sp & 255u) == 0u) { if (xb_ld(&bar[XB_TMO])) break; if (sp > XB_SPIN_CAP) { atomicAdd(&bar[XB_TMO], 1u); break; } }
    }
    nloc = mine > 0u ? mine : 1u; nx = cnt > 0u ? cnt : 1u;
}

__device__ __forceinline__ void xcd_barrier(const XcdBarrier& b) {
    asm volatile("s_waitcnt vmcnt(0)" ::: "memory");
    __syncthreads();
    if (threadIdx.x == 0) {
        unsigned* bar = b.bar;
        __builtin_amdgcn_s_waitcnt(0);
        unsigned nloc = b.st[0], nx = b.st[1];
        if (nloc == 0u) { xcd_barrier_complete(bar, b.x, nloc, nx); b.st[0] = nloc; b.st[1] = nx; }
        const unsigned old = xb_add(&bar[XB_XSUB(b.x)], 1u);
        const unsigned gen = old / nloc;
        if (old + 1u == (gen + 1u) * nloc) {
            __builtin_amdgcn_fence(__ATOMIC_RELEASE, "agent");
            asm volatile("s_waitcnt vmcnt(0)" ::: "memory");
            const unsigned og = xb_add(&bar[XB_TOP], 1u);
            const unsigned tg = og / nx;
            if (og + 1u == (tg + 1u) * nx) xb_add(&bar[XB_TOPGEN], 1u);
            else XB_SPIN(xb_ld(&bar[XB_TOPGEN]) == tg, bar);
            __builtin_amdgcn_fence(__ATOMIC_ACQUIRE, "agent");
            xb_add(&bar[XB_XGEN(b.x)], 1u);
            asm volatile("s_waitcnt vmcnt(0)" ::: "memory");
        } else {
            XB_SPIN(xb_ld(&bar[XB_XGEN(b.x)]) == gen, bar);
            __builtin_amdgcn_fence(__ATOMIC_ACQUIRE, "agent");
            asm volatile("s_waitcnt vmcnt(0)" ::: "memory");
        }
    }
    __syncthreads();
}

constexpr int NWAVES = 8;
constexpr int BATCH = 4, SEQ = 8192, DM = 1024, NH = 8, HD = 128, FF = 2816, MROWS = BATCH * SEQ;
constexpr int BS = 256, NBLK = SEQ / BS;
constexpr float QSCALE = 0.08838834764831845f * 1.4426950408889634f;
constexpr float EPS = 1e-6f;

constexpr size_t MiB = 1u << 20;
constexpr size_t WS_CTL = 0, CTL_ZERO_BYTES = 1 * MiB;
constexpr size_t WS_KSUM = 1 * MiB;
constexpr size_t WS_SS = 1 * MiB + 512 * 1024;
constexpr size_t WS_SS0 = 2 * MiB;
constexpr size_t WS_WQKV = 4 * MiB, WS_WO = 10 * MiB, WS_WF1 = 12 * MiB  , WS_WF2 = 34 * MiB  , WS_WCI = 45 * MiB, WS_WCO = 51 * MiB;
constexpr size_t WS_Q = 56 * MiB, WS_K = 120 * MiB, WS_V = 184 * MiB;
constexpr size_t WS_XB = 248 * MiB;
constexpr size_t WS_H = 312 * MiB;
constexpr size_t WS_END = 504 * MiB;
static_assert(WS_H + (size_t)MROWS * FF * 2 <= WS_END, "ws map");
constexpr int CW_TMO = 0, CW_CODE = 1, CW_BAR = 4096;

constexpr int RING_OFF = 0, RING_BYTES = 131072;
constexpr int LDSCTL_OFF = RING_BYTES, MISC_OFF = LDSCTL_OFF + 320;
constexpr int LDS_BYTES = 147456;

__device__ __forceinline__ float wave_sum(float v) {
#pragma unroll
    for (int o = 1; o < 64; o <<= 1) v += __shfl_xor(v, o);
    return v;
}
__device__ __forceinline__ float bf_lo(unsigned w) { return __uint_as_float(w << 16); }
__device__ __forceinline__ float bf_hi(unsigned w) { return __uint_as_float(w & 0xffff0000u); }
__device__ __forceinline__ unsigned pk2(float lo, float hi) { return pg8::cvt_pk_bf16(lo, hi); }

__device__ __forceinline__ void p0_item(const float* W, int N, int K, int k0, int n_src0, bf16* WT, int n_dst0, const float* gain, LAS float* scr, int lane) {
#pragma unroll 8
    for (int i = 0; i < 32; ++i) { const int kk = 2 * i + (lane >> 5); float v = W[(size_t)(k0 + kk) * N + n_src0 + (lane & 31)]; if (gain) v *= gain[k0 + kk]; scr[kk * 33 + (lane & 31)] = v; }
    LDS_WAIT(); asm volatile("" ::: "memory");
    const int c = lane & 7;
#pragma unroll
    for (int j = 0; j < 4; ++j) { const int n = (lane >> 3) + 8 * j; const LAS float* s = scr + (8 * c) * 33 + n;
        v4u o; o.x = pk2(s[0 * 33], s[1 * 33]); o.y = pk2(s[2 * 33], s[3 * 33]); o.z = pk2(s[4 * 33], s[5 * 33]); o.w = pk2(s[6 * 33], s[7 * 33]);
        *(v4u*)(WT + (size_t)(n_dst0 + n) * K + k0 + 8 * c) = o; }
    LDS_WAIT(); asm volatile("" ::: "memory");
}
__device__ __forceinline__ int interleave128(int n, int half_cols) { const int hsel = n >= half_cols ? 1 : 0, nn = n - hsel * half_cols; return 256 * (nn >> 7) + 128 * hsel + (nn & 127); }

struct Args { const float* in[12]; float* out; unsigned char* ws; };

__device__ __forceinline__ void naive_attn_item(bf16* Q, const bf16* Kb, const bf16* Vb, const float* ksum, int m, int h, int lane) {
    const int t = m & (SEQ - 1), b = m / SEQ, ib = t / BS;
    const size_t qoff = (size_t)m * DM + h * HD + 2 * lane;
    const unsigned qq = *(const unsigned*)(Q + qoff); const float q0 = bf_lo(qq), q1 = bf_hi(qq);
    int s0 = -1, s1 = -1, s2 = -1; float g0 = -3.0e38f, g1 = -3.0e38f, g2 = -3.0e38f;
    for (int j = 0; j < ib; ++j) {
        const float2 km = *(const float2*)(ksum + (size_t)(b * NBLK + j) * DM + h * HD + 2 * lane);
        const float g = wave_sum(q0 * km.x + q1 * km.y);
        if (g > g0) { g2 = g1; s2 = s1; g1 = g0; s1 = s0; g0 = g; s0 = j; }
        else if (g > g1) { g2 = g1; s2 = s1; g1 = g; s1 = j; }
        else if (g > g2) { g2 = g; s2 = j; }
    }
    float mr = -1.0e30f, l = 0.f, o0 = 0.f, o1 = 0.f;
    for (int sidx = 0; sidx < 4; ++sidx) {
        const int blk = sidx == 0 ? s0 : sidx == 1 ? s1 : sidx == 2 ? s2 : ib;
        if (blk < 0) continue;
        const int nk = (sidx == 3) ? (t & (BS - 1)) + 1 : BS;
        const size_t rbase = ((size_t)b * SEQ + (size_t)blk * BS) * DM + h * HD + 2 * lane;
        for (int k0 = 0; k0 < nk; k0 += 4) {
            float d[4]; unsigned vv[4];
#pragma unroll
            for (int u = 0; u < 4; ++u) { const unsigned kk = *(const unsigned*)(Kb + rbase + (size_t)(k0 + u) * DM); vv[u] = *(const unsigned*)(Vb + rbase + (size_t)(k0 + u) * DM); d[u] = q0 * bf_lo(kk) + q1 * bf_hi(kk); }
#pragma unroll
            for (int o = 1; o < 64; o <<= 1) {
#pragma unroll
                for (int u = 0; u < 4; ++u) d[u] += __shfl_xor(d[u], o);
            }
#pragma unroll
            for (int u = 0; u < 4; ++u) if (k0 + u >= nk) d[u] = -1.0e30f;
            const float mn = fmaxf(fmaxf(mr, fmaxf(d[0], d[1])), fmaxf(d[2], d[3]));
            const float a = __builtin_amdgcn_exp2f(mr - mn); l *= a; o0 *= a; o1 *= a; mr = mn;
#pragma unroll
            for (int u = 0; u < 4; ++u) { const float p = __builtin_amdgcn_exp2f(d[u] - mn); l += p; o0 += p * bf_lo(vv[u]); o1 += p * bf_hi(vv[u]); }
        }
    }
    const float il = 1.0f / l;
    *(unsigned*)(Q + qoff) = pk2(o0 * il, o1 * il);
}

__global__ void __launch_bounds__(NWAVES * 64, 2) moba_fwd(Args args) {
    extern __shared__ __attribute__((aligned(16))) unsigned char lds_raw[];
    LAS unsigned char* lds = (LAS unsigned char*)lds_raw;
    volatile LAS unsigned* MISC = (volatile LAS unsigned*)(lds + MISC_OFF);
    const int tid = threadIdx.x, lane = tid & 63, wave = __builtin_amdgcn_readfirstlane(tid >> 6);
    const int G = gridDim.x; const int bx = blockIdx.x; const int vcu = (G % 8 == 0) ? (bx % 8) * (G / 8) + bx / 8 : bx;
    unsigned char* ws = args.ws;
    gu32* ctl = (gu32*)(ws + WS_CTL);
    const float* x = args.in[0]; const float* attn_norm = args.in[1]; const float* w_qkv = args.in[2]; const float* w_o = args.in[3];
    const float* conv_norm = args.in[4]; const float* w_ci = args.in[5]; const float* conv_w = args.in[6]; const float* w_co = args.in[7];
    const float* ffn_norm = args.in[8]; const float* w_f1 = args.in[9]; const float* w_f2 = args.in[10]; const float* final_norm = args.in[11];
    float* out = args.out;
    bf16* Wqkv_t = (bf16*)(ws + WS_WQKV); bf16* Wo_t = (bf16*)(ws + WS_WO); bf16* Wf1_t = (bf16*)(ws + WS_WF1); bf16* Wf2_t = (bf16*)(ws + WS_WF2); bf16* Wci_t = (bf16*)(ws + WS_WCI); bf16* Wco_t = (bf16*)(ws + WS_WCO);
    bf16* Qb = (bf16*)(ws + WS_Q); bf16* Kb = (bf16*)(ws + WS_K); bf16* Vb = (bf16*)(ws + WS_V); bf16* XB = (bf16*)(ws + WS_XB); bf16* Hb = (bf16*)(ws + WS_H);
    float* ksum = (float*)(ws + WS_KSUM); float* ss0 = (float*)(ws + WS_SS0);
    float* ss1 = (float*)(ws + WS_SS); float* ss2 = ss1 + MROWS; float* ss3 = ss2 + MROWS;
    for (int u = tid; u < (LDS_BYTES - LDSCTL_OFF) / 4; u += NWAVES * 64) ((LAS unsigned*)(lds + LDSCTL_OFF))[u] = 0u;
    __syncthreads();
    XcdBarrier bar = xcd_barrier_post((unsigned*)(ctl + CW_BAR), MISC + 8);
    const int gw = vcu * NWAVES + wave, NGW = G * NWAVES;
    const int gt = vcu * NWAVES * 64 + tid, NGT = G * NWAVES * 64;

    {
        LAS float* scr = (LAS float*)(lds + RING_OFF + wave * 16384);
        constexpr int I_QKV = (DM / 64) * (3 * DM / 32), I_O = (DM / 64) * (DM / 32), I_F1 = (DM / 64) * (2 * FF / 32), I_F2 = (FF / 64) * (DM / 32);
        constexpr int NITEMS = I_QKV + I_O + 2 * I_F1 + 2 * I_F2 + I_QKV + I_O;
        for (int it = gw; it < NITEMS; it += NGW) {
            int r = it;
            if (r < I_QKV) { const int nb = 3 * DM / 32, k0 = 64 * (r / nb), n0 = 32 * (r % nb); p0_item(w_qkv, 3 * DM, DM, k0, n0, Wqkv_t, n0, attn_norm, scr, lane); continue; } r -= I_QKV;
            if (r < I_O) { const int nb = DM / 32, k0 = 64 * (r / nb), n0 = 32 * (r % nb); p0_item(w_o, DM, DM, k0, n0, Wo_t, n0, nullptr, scr, lane); continue; } r -= I_O;
            if (r < 2 * I_F1) { const int L = r / I_F1; r -= L * I_F1; const int nb = 2 * FF / 32, k0 = 64 * (r / nb), n0 = 32 * (r % nb);
                p0_item(w_f1 + (size_t)L * DM * 2 * FF, 2 * FF, DM, k0, n0, Wf1_t + (size_t)L * 2 * FF * DM, interleave128(n0, FF), ffn_norm + L * DM, scr, lane); continue; } r -= 2 * I_F1;
            if (r < 2 * I_F2) { const int L = r / I_F2; r -= L * I_F2; const int nb = DM / 32, k0 = 64 * (r / nb), n0 = 32 * (r % nb);
                p0_item(w_f2 + (size_t)L * FF * DM, DM, FF, k0, n0, Wf2_t + (size_t)L * DM * FF, n0, nullptr, scr, lane); continue; } r -= 2 * I_F2;
            if (r < I_QKV) { const int nb = 3 * DM / 32, k0 = 64 * (r / nb), n0 = 32 * (r % nb);
                const int nd = n0 < DM ? 2 * DM + n0 : interleave128(n0 - DM, DM);
                p0_item(w_ci, 3 * DM, DM, k0, n0, Wci_t, nd, conv_norm, scr, lane); continue; } r -= I_QKV;
            { const int nb = DM / 32, k0 = 64 * (r / nb), n0 = 32 * (r % nb); p0_item(w_co, DM, DM, k0, n0, Wco_t, n0, nullptr, scr, lane); }
        }
        for (int i = gt; i < (int)(MiB / 16); i += NGT) ((v4u*)(ws + WS_KSUM))[i] = (v4u){0u, 0u, 0u, 0u};
        for (int m = gw; m < MROWS; m += NGW) {
            const f32x4* xr = (const f32x4*)(x + (size_t)m * DM) + lane; f32x4 v[4]; float s = 0.f;
#pragma unroll
            for (int j = 0; j < 4; ++j) { v[j] = xr[64 * j]; s += (v[j].x * v[j].x + v[j].y * v[j].y) + (v[j].z * v[j].z + v[j].w * v[j].w); }
            s = wave_sum(s); if (lane == 0) ss0[m] = s;
            unsigned long long* o8 = (unsigned long long*)(XB + (size_t)m * DM) + lane;
#pragma unroll
            for (int j = 0; j < 4; ++j) o8[64 * j] = (unsigned long long)pk2(v[j].x, v[j].y) | ((unsigned long long)pk2(v[j].z, v[j].w) << 32);
        }
    }
    xcd_barrier(bar);

    {
        pg8::Gemm g{XB, Wqkv_t, MROWS, 3 * DM, DM}; pg8::StaticOrder S; S.init(MROWS, 3 * DM, G, bx);
        pg8::EpiQKV E{Qb, (size_t)MROWS * DM, ss0, ksum, QSCALE};
        pg8::gemm_phase<pg8::EpiQKV, pg8::StaticOrder, PG8_ALIGN, PG8_SP2>(lds + RING_OFF, g, S, E);
    }
    xcd_barrier(bar);

    for (int it = gw; it < MROWS * NH; it += NGW) naive_attn_item(Qb, Kb, Vb, ksum, it >> 3, it & 7, lane);
    xcd_barrier(bar);

    {
        pg8::Gemm g{Qb, Wo_t, MROWS, DM, DM}; pg8::StaticOrder S; S.init(MROWS, DM, G, bx);
        pg8::EpiRes<true> E{x, out, XB, ss1};
        pg8::gemm_phase<pg8::EpiRes<true>, pg8::StaticOrder, PG8_ALIGN, PG8_SP2>(lds + RING_OFF, g, S, E);
    }
    xcd_barrier(bar);

    {
        pg8::Gemm g{XB, Wf1_t, MROWS, 2 * FF, DM}; pg8::StaticOrder S; S.init(MROWS, 2 * FF, G, bx);
        pg8::EpiSwiglu E{Hb, FF, ss1};
        pg8::gemm_phase<pg8::EpiSwiglu, pg8::StaticOrder, PG8_ALIGN, PG8_SP2>(lds + RING_OFF, g, S, E);
    }
    xcd_barrier(bar);
    {
        pg8::Gemm g{Hb, Wf2_t, MROWS, DM, FF}; pg8::StaticOrder S; S.init(MROWS, DM, G, bx);
        pg8::EpiRes<true> E{out, out, XB, ss2};
        pg8::gemm_phase<pg8::EpiRes<true>, pg8::StaticOrder, PG8_ALIGN, PG8_SP2>(lds + RING_OFF, g, S, E);
    }
    xcd_barrier(bar);

    {
        pg8::Gemm g{XB, Wci_t, MROWS, 3 * DM, DM}; pg8::StaticOrder S; S.init(MROWS, 3 * DM, G, bx);
        pg8::EpiConvIn E{Qb, Kb, ss2};
        pg8::gemm_phase<pg8::EpiConvIn, pg8::StaticOrder, PG8_ALIGN, PG8_SP2>(lds + RING_OFF, g, S, E);
    }
    xcd_barrier(bar);

    for (int idx = gt; idx < MROWS * (DM / 8); idx += NGT) {
        const int m = idx >> 7, c8 = (idx & 127) * 8, t = m & (SEQ - 1);
        const size_t off = (size_t)m * DM + c8;
        const v4u u2 = *(const v4u*)(Qb + off), bb = *(const v4u*)(Kb + off);
        v4u u1 = (v4u){0u, 0u, 0u, 0u}, u0 = (v4u){0u, 0u, 0u, 0u};
        if (t >= 1) u1 = *(const v4u*)(Qb + off - DM);
        if (t >= 2) u0 = *(const v4u*)(Qb + off - 2 * DM);
        const f32x4 w0a = *(const f32x4*)(conv_w + c8), w0b = *(const f32x4*)(conv_w + c8 + 4), w1a = *(const f32x4*)(conv_w + DM + c8), w1b = *(const f32x4*)(conv_w + DM + c8 + 4),
                    w2a = *(const f32x4*)(conv_w + 2 * DM + c8), w2b = *(const f32x4*)(conv_w + 2 * DM + c8 + 4);
        v4u y;
#pragma unroll
        for (int e = 0; e < 4; ++e) {
            const float wl0 = e < 2 ? w0a[2 * e] : w0b[2 * e - 4], wh0 = e < 2 ? w0a[2 * e + 1] : w0b[2 * e - 3];
            const float wl1 = e < 2 ? w1a[2 * e] : w1b[2 * e - 4], wh1 = e < 2 ? w1a[2 * e + 1] : w1b[2 * e - 3];
            const float wl2 = e < 2 ? w2a[2 * e] : w2b[2 * e - 4], wh2 = e < 2 ? w2a[2 * e + 1] : w2b[2 * e - 3];
            const float lo = bf_lo(bb[e]) * (wl0 * bf_lo(u0[e]) + wl1 * bf_lo(u1[e]) + wl2 * bf_lo(u2[e]));
            const float hi = bf_hi(bb[e]) * (wh0 * bf_hi(u0[e]) + wh1 * bf_hi(u1[e]) + wh2 * bf_hi(u2[e]));
            y[e] = pk2(lo, hi);
        }
        *(v4u*)(Vb + off) = y;
    }
    xcd_barrier(bar);

    {
        pg8::Gemm g{Vb, Wco_t, MROWS, DM, DM}; pg8::StaticOrder S; S.init(MROWS, DM, G, bx);
        pg8::EpiRes<true> E{out, out, XB, ss3};
        pg8::gemm_phase<pg8::EpiRes<true>, pg8::StaticOrder, PG8_ALIGN, PG8_SP2>(lds + RING_OFF, g, S, E);
    }
    xcd_barrier(bar);

    {
        pg8::Gemm g{XB, Wf1_t + (size_t)2 * FF * DM, MROWS, 2 * FF, DM}; pg8::StaticOrder S; S.init(MROWS, 2 * FF, G, bx);
        pg8::EpiSwiglu E{Hb, FF, ss3};
        pg8::gemm_phase<pg8::EpiSwiglu, pg8::StaticOrder, PG8_ALIGN, PG8_SP2>(lds + RING_OFF, g, S, E);
    }
    xcd_barrier(bar);
    {
        pg8::Gemm g{Hb, Wf2_t + (size_t)DM * FF, MROWS, DM, FF}; pg8::StaticOrder S; S.init(MROWS, DM, G, bx);
        pg8::EpiRes<false> E{out, out, nullptr, nullptr};
        pg8::gemm_phase<pg8::EpiRes<false>, pg8::StaticOrder, PG8_ALIGN, PG8_SP2>(lds + RING_OFF, g, S, E);
    }
    xcd_barrier(bar);

    for (int m = gw; m < MROWS; m += NGW) {
        f32x4* xr = (f32x4*)(out + (size_t)m * DM) + lane; const f32x4* gr = (const f32x4*)final_norm + lane; f32x4 v[4]; float s = 0.f;
#pragma unroll
        for (int j = 0; j < 4; ++j) { v[j] = xr[64 * j]; s += (v[j].x * v[j].x + v[j].y * v[j].y) + (v[j].z * v[j].z + v[j].w * v[j].w); }
        const float r = __builtin_amdgcn_rsqf(wave_sum(s) * (1.0f / DM) + EPS);
#pragma unroll
        for (int j = 0; j < 4; ++j) xr[64 * j] = v[j] * r * gr[64 * j];
    }
}

extern "C" void kernel_launch(void* const* d_in, const int* in_sizes, int n_in, void* d_out, int out_size, void* d_ws, size_t ws_size, hipStream_t stream) {
    static int grid = 0;
    if (grid == 0) {
        if (n_in != 12 || in_sizes[0] != MROWS * DM || out_size != MROWS * DM || ws_size < WS_END) {
            fprintf(stderr, "kernel_launch: unexpected shapes (n_in %d, in0 %d, out %d, ws %zu); nothing launched\n", n_in, n_in > 0 ? in_sizes[0] : -1, out_size, ws_size); grid = -1; return; }
        int dev = 0, cus = 0, per_cu = 0;
        if (hipGetDevice(&dev) != hipSuccess || hipDeviceGetAttribute(&cus, hipDeviceAttributeMultiprocessorCount, dev) != hipSuccess) { grid = -1; return; }
        if (hipFuncSetAttribute((const void*)moba_fwd, hipFuncAttributeMaxDynamicSharedMemorySize, LDS_BYTES) != hipSuccess) { fprintf(stderr, "kernel_launch: hipFuncSetAttribute failed\n"); grid = -1; return; }
        if (hipOccupancyMaxActiveBlocksPerMultiprocessor(&per_cu, (const void*)moba_fwd, NWAVES * 64, LDS_BYTES) != hipSuccess || per_cu < 1) {
            fprintf(stderr, "kernel_launch: occupancy query reports %d blocks per CU; nothing launched\n", per_cu); (void)hipGetLastError(); grid = -1; return; }
        grid = cus;
    }
    if (grid < 0) return;
    if (hipMemsetAsync((char*)d_ws + WS_CTL, 0, CTL_ZERO_BYTES, stream) != hipSuccess) return;
    Args a{};
    for (int i = 0; i < 12; ++i) a.in[i] = (const float*)d_in[i];
    a.out = (float*)d_out; a.ws = (unsigned char*)d_ws;
    hipLaunchKernelGGL(moba_fwd, dim3(grid), dim3(NWAVES * 64), LDS_BYTES, stream, a);
}
```

```cpp
#include <hip/hip_runtime.h>
#include <cstdio>
#include <cstdint>
namespace pg8 {
#define PG8_LAS __attribute__((address_space(3)))
typedef unsigned short bf16_t;
typedef short bf16x8 __attribute__((ext_vector_type(8)));
typedef float f32x4 __attribute__((ext_vector_type(4)));
typedef unsigned u32x4 __attribute__((ext_vector_type(4)));
constexpr int BM = 256, BK = 64, HALF = 128, HTB = HALF * BK * 2  , STAGE_BYTES = 8 * HTB, NXCD = 8, WGM = 8;

__host__ __device__ __forceinline__ int lds_byte(int r, int c) { const int st = (r >> 4) * 2 + (c >> 5), rr = r & 15, cc = c & 31, ob = rr * 64 + cc * 2; return st * 1024 + (ob ^ (((ob >> 9) & 1) << 5)); }
__host__ __device__ __forceinline__ void stage_rc(int b, int& R, int& C) { const int st = b / 1024, sb = b % 1024, swz = sb ^ (((sb >> 9) & 1) << 5); R = (st >> 1) * 16 + swz / 64; C = (st & 1) * 32 + (swz % 64) / 2; }
__host__ __device__ __forceinline__ int perm32(int rho) { const int n = rho >> 4, i = rho & 15; return 8 * (i >> 2) + 4 * n + (i & 3); }

struct Unit { int pm, pn; };
struct Gemm { const bf16_t* A; const bf16_t* Bt; int M, N, K; };

struct StaticOrder {
    int nM, nN, nwg, G, c;
    __host__ __device__ void init(int M, int N, int G_, int c_) { nM = M / BM; nN = N / BM; nwg = nM * nN; G = G_; c = c_; }
    __host__ __device__ bool next(int i, Unit& u) const {
        const long L = (long)i * G + c; if (L >= nwg) return false;
        int wgid = (int)L; { const int q = nwg / NXCD, r = nwg % NXCD, xcd = wgid % NXCD, off = wgid / NXCD; wgid = (xcd < r ? xcd * (q + 1) : r * (q + 1) + (xcd - r) * q) + off; }
        const int nig = WGM * nN, gid = wgid / nig, fm = gid * WGM, gsz = (nM - fm) < WGM ? (nM - fm) : WGM;
        u.pm = fm + ((wgid % nig) % gsz); u.pn = (wgid % nig) / gsz; return true;
    }
    __device__ __forceinline__ void a_ready(const Unit&) const {}
    __device__ __forceinline__ void done(const Unit&) const {}
};

__device__ __forceinline__ unsigned cvt_pk_bf16(float lo, float hi) { unsigned r; asm volatile("v_cvt_pk_bf16_f32 %0, %1, %2" : "=v"(r) : "v"(lo), "v"(hi)); return r; }
constexpr int   ROWLEN = 1024;
constexpr float RMS_EPS = 1e-6f, INV_D = 1.0f / 1024.0f;
__device__ __forceinline__ u32x4 pack8(const f32x4 a, const f32x4 b) { u32x4 w; w.x = cvt_pk_bf16(a[0], a[1]); w.y = cvt_pk_bf16(a[2], a[3]); w.z = cvt_pk_bf16(b[0], b[1]); w.w = cvt_pk_bf16(b[2], b[3]); return w; }
__device__ __forceinline__ float rowscale(const float* ss, int row) { return __builtin_amdgcn_rsqf(ss[row] * INV_D + RMS_EPS); }

struct EpiQKV {
    static constexpr bool PERM = true, AFTER_DRAIN = false;
    bf16_t* Q; size_t tstride; const float* ss; float* ksum; float qscale;
    __device__ __forceinline__ void operator()(const f32x4 (&acc)[2][2][4][2], const Unit& u, int wr, int wc, int fr, int fq) const {
        const int t = u.pn >> 2, colt = (u.pn & 3) * BM + wc * 32 + 8 * fq;
        bf16_t* base = Q + (size_t)t * tstride;
        const float sc = (t == 0) ? qscale : 1.0f;
        f32x4 cs[2][2];
#pragma unroll
        for (int bj = 0; bj < 2; ++bj)
#pragma unroll
            for (int n = 0; n < 2; ++n) cs[bj][n] = (f32x4){0.f, 0.f, 0.f, 0.f};
#pragma unroll
        for (int ai = 0; ai < 2; ++ai)
#pragma unroll
            for (int m = 0; m < 4; ++m) {
                const int row = u.pm * BM + ai * HALF + wr * 64 + m * 16 + fr;
                const float r = rowscale(ss, row) * sc;
#pragma unroll
                for (int bj = 0; bj < 2; ++bj) {
                    const f32x4 v0 = acc[ai][bj][m][0] * r, v1 = acc[ai][bj][m][1] * r;
                    cs[bj][0] += v0; cs[bj][1] += v1;
                    *(u32x4*)(base + (size_t)row * ROWLEN + colt + bj * HALF) = pack8(v0, v1);
                }
            }
        if (t == 1) {
#pragma unroll
            for (int bj = 0; bj < 2; ++bj)
#pragma unroll
                for (int n = 0; n < 2; ++n)
#pragma unroll
                    for (int e = 0; e < 4; ++e) {
                        float s = cs[bj][n][e];
                        s += __shfl_xor(s, 1); s += __shfl_xor(s, 2); s += __shfl_xor(s, 4); s += __shfl_xor(s, 8);
                        if (fr == 0) atomicAdd(ksum + (size_t)u.pm * ROWLEN + colt + bj * HALF + 4 * n + e, s);
                    }
        }
    }
};

template <bool WANT_NEXT> struct EpiRes {
    static constexpr bool PERM = true, AFTER_DRAIN = false;
    const float* xin; float* xout; bf16_t* xb; float* ss;
    __device__ __forceinline__ void operator()(const f32x4 (&acc)[2][2][4][2], const Unit& u, int wr, int wc, int fr, int fq) const {
        const int col0 = u.pn * BM + wc * 32 + 8 * fq;
#pragma unroll
        for (int ai = 0; ai < 2; ++ai)
#pragma unroll
            for (int m = 0; m < 4; ++m) {
                const int row = u.pm * BM + ai * HALF + wr * 64 + m * 16 + fr;
                float sq = 0.f;
#pragma unroll
                for (int bj = 0; bj < 2; ++bj) {
                    const size_t off = (size_t)row * ROWLEN + col0 + bj * HALF;
                    const f32x4 v0 = *(const f32x4*)(xin + off) + acc[ai][bj][m][0], v1 = *(const f32x4*)(xin + off + 4) + acc[ai][bj][m][1];
                    *(f32x4*)(xout + off) = v0; *(f32x4*)(xout + off + 4) = v1;
                    if (WANT_NEXT) {
                        *(u32x4*)(xb + off) = pack8(v0, v1);
                        sq += (v0[0] * v0[0] + v0[1] * v0[1]) + (v0[2] * v0[2] + v0[3] * v0[3]) + (v1[0] * v1[0] + v1[1] * v1[1]) + (v1[2] * v1[2] + v1[3] * v1[3]);
                    }
                }
                if (WANT_NEXT) { sq += __shfl_xor(sq, 16); sq += __shfl_xor(sq, 32); if (fq == 0) atomicAdd(ss + row, sq); }
            }
    }
};

struct EpiSwiglu {
    static constexpr bool PERM = true, AFTER_DRAIN = false;
    bf16_t* Hh; int ldh; const float* ss;
    __device__ __forceinline__ void operator()(const f32x4 (&acc)[2][2][4][2], const Unit& u, int wr, int wc, int fr, int fq) const {
        const int col0 = u.pn * HALF + wc * 32 + 8 * fq;
#pragma unroll
        for (int ai = 0; ai < 2; ++ai)
#pragma unroll
            for (int m = 0; m < 4; ++m) {
                const int row = u.pm * BM + ai * HALF + wr * 64 + m * 16 + fr;
                const float r = rowscale(ss, row);
                f32x4 hv[2];
#pragma unroll
                for (int n = 0; n < 2; ++n) {
                    const f32x4 g = acc[ai][0][m][n] * r, uu = acc[ai][1][m][n] * r;
#pragma unroll
                    for (int e = 0; e < 4; ++e) hv[n][e] = g[e] * uu[e] * __builtin_amdgcn_rcpf(1.0f + __builtin_amdgcn_exp2f(g[e] * -1.4426950408889634f));
                }
                *(u32x4*)(Hh + (size_t)row * ldh + col0) = pack8(hv[0], hv[1]);
            }
    }
};

struct EpiConvIn {
    static constexpr bool PERM = true, AFTER_DRAIN = false;
    bf16_t* U; bf16_t* Bb; const float* ss;
    __device__ __forceinline__ void operator()(const f32x4 (&acc)[2][2][4][2], const Unit& u, int wr, int wc, int fr, int fq) const {
#pragma unroll
        for (int ai = 0; ai < 2; ++ai)
#pragma unroll
            for (int m = 0; m < 4; ++m) {
                const int row = u.pm * BM + ai * HALF + wr * 64 + m * 16 + fr;
                const float r = rowscale(ss, row);
                if (u.pn < 8) {
                    const float r2 = r * r;
                    const f32x4 a = acc[ai][0][m][0] * acc[ai][1][m][0] * r2, b = acc[ai][0][m][1] * acc[ai][1][m][1] * r2;
                    *(u32x4*)(U + (size_t)row * ROWLEN + u.pn * HALF + wc * 32 + 8 * fq) = pack8(a, b);
                } else {
#pragma unroll
                    for (int bj = 0; bj < 2; ++bj)
                        *(u32x4*)(Bb + (size_t)row * ROWLEN + (u.pn - 8) * BM + bj * HALF + wc * 32 + 8 * fq) = pack8(acc[ai][bj][m][0] * r, acc[ai][bj][m][1] * r);
                }
            }
    }
};

template <class Epi, class Sched, bool ALIGN_EPI = false, bool SP2 = false>
__device__ __forceinline__ void gemm_phase(PG8_LAS unsigned char* lds, const Gemm g, const Sched& S, const Epi& E) {
    int tid_ = threadIdx.x; asm volatile("" : "+v"(tid_));
    const int tid = tid_, wid = __builtin_amdgcn_readfirstlane(tid >> 6), lane = tid & 63, wr = wid >> 2, wc = wid & 3, fr = lane & 15, fq = lane >> 4;
    const int K = g.K, nt = K / BK;
    unsigned voffA[2], voffB[2];
#pragma unroll
    for (int i = 0; i < 2; ++i) { int R, C; stage_rc(tid * 16 + i * 8192, R, C); const int Rb = Epi::PERM ? ((R & ~31) + perm32(R & 31)) : R;
        voffA[i] = (unsigned)(R * K + C) * 2u; voffB[i] = (unsigned)(Rb * K + C) * 2u; }
    const size_t kstep = (size_t)(BK * 2);
    const size_t hstep = (size_t)HALF * K * 2;
    const size_t tstep = 2 * hstep;
    const unsigned ldsw = (unsigned)wid * 1024u;
    const int aoff = lds_byte(wr * 64 + fr, fq * 8), boff = lds_byte(wc * 32 + fr, fq * 8);
#define PG8_SA(b, h) (((b) * 2 + (h)) * HTB)
#define PG8_SB(b, h) ((4 + (b) * 2 + (h)) * HTB)
#define PG8_STAGE(bufoff, gbase, voff) do { _Pragma("unroll") for (int _i = 0; _i < 2; ++_i) \
        __builtin_amdgcn_global_load_lds((const unsigned*)((const char*)(gbase) + (voff)[_i]), (PG8_LAS unsigned*)(lds + (bufoff) + ldsw + _i * 8192), 16, 0, 0); } while (0)
#define PG8_LDA(dst, b, h) do { _Pragma("unroll") for (int m = 0; m < 4; ++m) _Pragma("unroll") for (int k = 0; k < 2; ++k) dst[m][k] = *(const PG8_LAS bf16x8*)(lds + PG8_SA(b, h) + aoff + m * 2048 + k * 1024); } while (0)
#define PG8_LDB(dst, b, h) do { _Pragma("unroll") for (int n = 0; n < 2; ++n) _Pragma("unroll") for (int k = 0; k < 2; ++k) dst[n][k] = *(const PG8_LAS bf16x8*)(lds + PG8_SB(b, h) + boff + n * 2048 + k * 1024); } while (0)
#define PG8_MMA(ai, bj, At, Bt) do { __builtin_amdgcn_s_setprio(1); _Pragma("unroll") for (int m = 0; m < 4; ++m) _Pragma("unroll") for (int n = 0; n < 2; ++n) _Pragma("unroll") for (int k = 0; k < 2; ++k) \
        acc[ai][bj][m][n] = __builtin_amdgcn_mfma_f32_16x16x32_bf16(Bt[n][k], At[m][k], acc[ai][bj][m][n], 0, 0, 0); __builtin_amdgcn_s_setprio(0); } while (0)
#define PG8_WAIT_V(n) asm volatile("s_waitcnt vmcnt(" #n ")" ::: "memory")
#define PG8_WAIT_L(n) asm volatile("s_waitcnt lgkmcnt(" #n ")" ::: "memory")
#define PG8_BAR __builtin_amdgcn_s_barrier()
#define PG8_SCHED __builtin_amdgcn_sched_barrier(0)
    Unit cur, nxt; int ui = 0;
    if (!S.next(0, cur)) return;
    f32x4 acc[2][2][4][2];
#pragma unroll
    for (int a = 0; a < 2; ++a)
#pragma unroll
        for (int b = 0; b < 2; ++b)
#pragma unroll
            for (int m = 0; m < 4; ++m)
#pragma unroll
                for (int n = 0; n < 2; ++n) acc[a][b][m][n] = (f32x4){0.f, 0.f, 0.f, 0.f};
    bf16x8 At[4][2], B0[2][2], B1[2][2];
    const char* cA = (const char*)g.A + (size_t)cur.pm * tstep; const char* cB = (const char*)g.Bt + (size_t)cur.pn * tstep;
    S.a_ready(cur);
    if constexpr (SP2) {
        PG8_STAGE(PG8_SB(0, 0), cB, voffB); PG8_STAGE(PG8_SB(0, 1), cB + hstep, voffB); PG8_STAGE(PG8_SA(0, 0), cA, voffA); PG8_STAGE(PG8_SA(0, 1), cA + hstep, voffA);
        if (wr == 1) PG8_BAR;
        PG8_WAIT_V(2); PG8_BAR;
        PG8_STAGE(PG8_SB(1, 0), cB + kstep, voffB); PG8_STAGE(PG8_SA(1, 0), cA + kstep, voffA); PG8_STAGE(PG8_SB(1, 1), cB + hstep + kstep, voffB);
        PG8_WAIT_V(6); PG8_BAR;
    } else {
        PG8_STAGE(PG8_SB(0, 0), cB, voffB); PG8_STAGE(PG8_SA(0, 0), cA, voffA); PG8_STAGE(PG8_SB(0, 1), cB + hstep, voffB); PG8_STAGE(PG8_SA(0, 1), cA + hstep, voffA);
        if (wr == 1) PG8_BAR;
        PG8_WAIT_V(4); PG8_BAR;
        PG8_STAGE(PG8_SB(1, 0), cB + kstep, voffB); PG8_STAGE(PG8_SA(1, 0), cA + kstep, voffA); PG8_STAGE(PG8_SB(1, 1), cB + hstep + kstep, voffB);
        PG8_WAIT_V(6); PG8_BAR;
    }
    for (;;) {
        const bool has_next = S.next(ui + 1, nxt);
        const char* nA = has_next ? (const char*)g.A + (size_t)nxt.pm * tstep : cA; const char* nB = has_next ? (const char*)g.Bt + (size_t)nxt.pn * tstep : cB;
        for (int t = 0; t < nt; t += 2) {
            const bool last = (t == nt - 2);
            const char* a1 = cA + (size_t)(t + 1) * kstep;
            const char* a2 = last ? nA : cA + (size_t)(t + 2) * kstep; const char* b2 = last ? nB : cB + (size_t)(t + 2) * kstep;
            const char* a3 = a2 + kstep; const char* b3 = b2 + kstep;
            if (last && has_next) S.a_ready(nxt);
            if constexpr (SP2) {
            PG8_LDB(B0, 0, 0); PG8_LDB(B1, 0, 1); PG8_SCHED; PG8_LDA(At, 0, 0); PG8_STAGE(PG8_SA(1, 1), a1 + hstep, voffA);
            PG8_WAIT_V(8); PG8_WAIT_L(0); PG8_BAR; PG8_MMA(0, 0, At, B0); PG8_MMA(0, 1, At, B1); PG8_BAR; PG8_SCHED;
            PG8_LDA(At, 0, 1); PG8_STAGE(PG8_SB(0, 0), b2, voffB); PG8_STAGE(PG8_SB(0, 1), b2 + hstep, voffB); PG8_STAGE(PG8_SA(0, 0), a2, voffA);
            PG8_WAIT_V(8); PG8_WAIT_L(0); PG8_BAR; PG8_MMA(1, 0, At, B0); PG8_MMA(1, 1, At, B1); PG8_BAR; PG8_SCHED;
            PG8_LDB(B0, 1, 0); PG8_LDB(B1, 1, 1); PG8_SCHED; PG8_LDA(At, 1, 0); PG8_STAGE(PG8_SA(0, 1), a2 + hstep, voffA);
            PG8_WAIT_V(8); PG8_WAIT_L(0); PG8_BAR; PG8_MMA(0, 0, At, B0); PG8_MMA(0, 1, At, B1); PG8_BAR; PG8_SCHED;
            PG8_LDA(At, 1, 1); PG8_STAGE(PG8_SB(1, 0), b3, voffB); PG8_STAGE(PG8_SB(1, 1), b3 + hstep, voffB); PG8_STAGE(PG8_SA(1, 0), a3, voffA);
            PG8_WAIT_V(8); PG8_WAIT_L(0); PG8_BAR; PG8_MMA(1, 0, At, B0); PG8_MMA(1, 1, At, B1); PG8_BAR; PG8_SCHED;
            } else {
            PG8_LDB(B0, 0, 0); PG8_SCHED; PG8_LDA(At, 0, 0); PG8_STAGE(PG8_SA(1, 1), a1 + hstep, voffA);
            PG8_WAIT_L(8); PG8_BAR; PG8_WAIT_L(0); PG8_MMA(0, 0, At, B0); PG8_BAR; PG8_SCHED;
            PG8_LDB(B1, 0, 1); PG8_STAGE(PG8_SB(0, 0), b2, voffB);
            PG8_BAR; PG8_WAIT_L(0); PG8_MMA(0, 1, At, B1); PG8_BAR;
            PG8_LDA(At, 0, 1); PG8_STAGE(PG8_SA(0, 0), a2, voffA);
            PG8_BAR; PG8_WAIT_L(0); PG8_MMA(1, 0, At, B0); PG8_BAR; PG8_SCHED;
            PG8_STAGE(PG8_SB(0, 1), b2 + hstep, voffB);
            PG8_WAIT_V(6); PG8_BAR; PG8_MMA(1, 1, At, B1); PG8_BAR;
            PG8_LDB(B0, 1, 0); PG8_SCHED; PG8_LDA(At, 1, 0); PG8_STAGE(PG8_SA(0, 1), a2 + hstep, voffA);
            PG8_WAIT_L(8); PG8_BAR; PG8_WAIT_L(0); PG8_MMA(0, 0, At, B0); PG8_BAR; PG8_SCHED;
            PG8_LDB(B1, 1, 1); PG8_STAGE(PG8_SB(1, 0), b3, voffB);
            PG8_BAR; PG8_WAIT_L(0); PG8_MMA(0, 1, At, B1); PG8_BAR;
            PG8_LDA(At, 1, 1); PG8_STAGE(PG8_SA(1, 0), a3, voffA);
            PG8_BAR; PG8_WAIT_L(0); PG8_MMA(1, 0, At, B0); PG8_BAR; PG8_SCHED;
            PG8_STAGE(PG8_SB(1, 1), b3 + hstep, voffB);
            PG8_WAIT_V(6); PG8_BAR; PG8_MMA(1, 1, At, B1); PG8_BAR;
            }
        }
        if constexpr (ALIGN_EPI) { if (wr == 0) PG8_BAR; }
        if constexpr (!Epi::AFTER_DRAIN) { E(acc, cur, wr, wc, fr, fq); S.done(cur); }
        if (!has_next) break;
#pragma unroll
        for (int a = 0; a < 2; ++a)
#pragma unroll
            for (int b = 0; b < 2; ++b)
#pragma unroll
                for (int m = 0; m < 4; ++m)
#pragma unroll
                    for (int n = 0; n < 2; ++n) acc[a][b][m][n] = (f32x4){0.f, 0.f, 0.f, 0.f};
        cur = nxt; cA = nA; cB = nB; ++ui;
        if constexpr (ALIGN_EPI) { if (wr == 1) PG8_BAR; }
    }
    PG8_WAIT_V(0);
    if constexpr (!ALIGN_EPI) { if (wr == 0) PG8_BAR; }
    PG8_BAR;
    if constexpr (Epi::AFTER_DRAIN) { E.fused(acc, cur, wr, wc, fr, fq, lds, wid, lane); S.done(cur); }
#undef PG8_SA
#undef PG8_SB
#undef PG8_STAGE
#undef PG8_LDA
#undef PG8_LDB
#undef PG8_MMA
#undef PG8_WAIT_V
#undef PG8_WAIT_L
#undef PG8_BAR
#undef PG8_SCHED
}
}

#ifndef PG8_SP2
#define PG8_SP2 true
#endif
#ifndef PG8_ALIGN
#define PG8_ALIGN true
#endif
#define GAS __attribute__((address_space(1)))
#define LAS __attribute__((address_space(3)))
typedef unsigned short bf16;
typedef unsigned v4u __attribute__((ext_vector_type(4)));
typedef float f32x4 __attribute__((ext_vector_type(4)));
typedef short bf16x8 __attribute__((ext_vector_type(8)));
typedef GAS unsigned gu32;
typedef GAS unsigned long long gu64;
#define RLX_AGENT __ATOMIC_RELAXED, __HIP_MEMORY_SCOPE_AGENT
#define LDS_WAIT() asm volatile("s_waitcnt lgkmcnt(0)" ::: "memory")
#define VM_WAIT() asm volatile("s_waitcnt vmcnt(0)" ::: "memory")
__device__ __forceinline__ unsigned long long rt() { return __builtin_amdgcn_s_memrealtime(); }

#define XB_TMO      128
#define XB_XCNT(j)  (256  + 64 * (j))
#define XB_XSUB(j)  (1280 + 64 * (j))
#define XB_XGEN(j)  (2304 + 64 * (j))
#define XB_TOP      3328
#define XB_TOPGEN   3392
#define XCD_BAR_WORDS 3456
#define XB_SPIN_CAP (1u << 18)

__device__ __forceinline__ unsigned xb_ld(unsigned* p)              { return __hip_atomic_load(p, __ATOMIC_RELAXED, __HIP_MEMORY_SCOPE_AGENT); }
__device__ __forceinline__ unsigned xb_add(unsigned* p, unsigned v) { return __hip_atomic_fetch_add(p, v, __ATOMIC_RELAXED, __HIP_MEMORY_SCOPE_AGENT); }
__device__ __forceinline__ unsigned xb_xcc_id() { return (unsigned)__builtin_amdgcn_s_getreg((3 << 11) | 20) & 0xFu; }
#define XB_SPIN(cond, bar) do { unsigned _sp = 0; while (cond) { __builtin_amdgcn_s_sleep(1); \
    if ((++_sp & 255u) == 0u) { if (xb_ld(&(bar)[XB_TMO])) break; if (_sp > XB_SPIN_CAP) { atomicAdd(&(bar)[XB_TMO], 1u); break; } } } } while (0)

struct XcdBarrier {
    unsigned* bar; unsigned x;
    volatile LAS unsigned* st;
};

__device__ __forceinline__ XcdBarrier xcd_barrier_post(unsigned* bar, volatile LAS unsigned* st) {
    XcdBarrier b; b.bar = bar; b.x = xb_xcc_id(); b.st = st;
    if (threadIdx.x == 0) (void)xb_add(&bar[XB_XCNT(b.x)], 1u);
    return b;
}
__device__ __forceinline__ void xcd_barrier_complete(unsigned* bar, unsigned x, unsigned& nloc, unsigned& nx) {
    const unsigned G = gridDim.x * gridDim.y * gridDim.z;
    unsigned sum, cnt, mine, sp = 0u;
    for (;;) {
        sum = 0u; cnt = 0u; mine = 0u;
#pragma unroll
        for (unsigned j = 0; j < 16; ++j) { const unsigned c = xb_ld(&bar[XB_XCNT(j)]); sum += c; cnt += (c > 0u) ? 1u : 0u; mine = (j == x) ? c : mine; }
        if (sum == G) break;
        __builtin_amdgcn_s_sleep(1);
        if ((++sp & 255u) == 0u) { if (xb_ld(&bar[XB_TMO])) break; if (sp > XB_SPIN_CAP) { atomicAdd(&bar[XB_TMO], 1u); break; } }
    }
    nloc = mine > 0u ? mine : 1u; nx = cnt > 0u ? cnt : 1u;
}

__device__ __forceinline__ void xcd_barrier(const XcdBarrier& b) {
    asm volatile("s_waitcnt vmcnt(0)" ::: "memory");
    __syncthreads();
    if (threadIdx.x == 0) {
        unsigned* bar = b.bar;
        __builtin_amdgcn_s_waitcnt(0);
        unsigned nloc = b.st[0], nx = b.st[1];
        if (nloc == 0u) { xcd_barrier_complete(bar, b.x, nloc, nx); b.st[0] = nloc; b.st[1] = nx; }
        const unsigned old = xb_add(&bar[XB_XSUB(b.x)], 1u);
        const unsigned gen = old / nloc;
        if (old + 1u == (gen + 1u) * nloc) {
            __builtin_amdgcn_fence(__ATOMIC_RELEASE, "agent");
            asm volatile("s_waitcnt vmcnt(0)" ::: "memory");
            const unsigned og = xb_add(&bar[XB_TOP], 1u);
            const unsigned tg = og / nx;
            if (og + 1u == (tg + 1u) * nx) xb_add(&bar[XB_TOPGEN], 1u);
            else XB_SPIN(xb_ld(&bar[XB_TOPGEN]) == tg, bar);
            __builtin_amdgcn_fence(__ATOMIC_ACQUIRE, "agent");
            xb_add(&bar[XB_XGEN(b.x)], 1u);
            asm volatile("s_waitcnt vmcnt(0)" ::: "memory");
        } else {
            XB_SPIN(xb_ld(&bar[XB_XGEN(b.x)]) == gen, bar);
            __builtin_amdgcn_fence(__ATOMIC_ACQUIRE, "agent");
            asm volatile("s_waitcnt vmcnt(0)" ::: "memory");
        }
    }
    __syncthreads();
}

constexpr int NWAVES = 8;
constexpr int BATCH = 4, SEQ = 8192, DM = 1024, NH = 8, HD = 128, FF = 2816, MROWS = BATCH * SEQ;
constexpr int BS = 256, NBLK = SEQ / BS;
constexpr float QSCALE = 0.08838834764831845f * 1.4426950408889634f;
constexpr float EPS = 1e-6f;

constexpr size_t MiB = 1u << 20;
constexpr size_t WS_CTL = 0, CTL_ZERO_BYTES = 1 * MiB;
constexpr size_t WS_KSUM = 1 * MiB;
constexpr size_t WS_SS = 1 * MiB + 512 * 1024;
constexpr size_t WS_SS0 = 2 * MiB;
constexpr size_t WS_WQKV = 4 * MiB, WS_WO = 10 * MiB, WS_WF1 = 12 * MiB  , WS_WF2 = 34 * MiB  , WS_WCI = 45 * MiB, WS_WCO = 51 * MiB;
constexpr size_t WS_Q = 56 * MiB, WS_K = 120 * MiB, WS_V = 184 * MiB;
constexpr size_t WS_XB = 248 * MiB;
constexpr size_t WS_H = 312 * MiB;
constexpr size_t WS_END = 504 * MiB;
static_assert(WS_H + (size_t)MROWS * FF * 2 <= WS_END, "ws map");
constexpr int CW_TMO = 0, CW_CODE = 1, CW_BAR = 4096;

constexpr int RING_OFF = 0, RING_BYTES = 131072;
constexpr int LDSCTL_OFF = RING_BYTES, MISC_OFF = LDSCTL_OFF + 320;
constexpr int LDS_BYTES = 147456;

__device__ __forceinline__ float wave_sum(float v) {
#pragma unroll
    for (int o = 1; o < 64; o <<= 1) v += __shfl_xor(v, o);
    return v;
}
__device__ __forceinline__ float bf_lo(unsigned w) { return __uint_as_float(w << 16); }
__device__ __forceinline__ float bf_hi(unsigned w) { return __uint_as_float(w & 0xffff0000u); }
__device__ __forceinline__ unsigned pk2(float lo, float hi) { return pg8::cvt_pk_bf16(lo, hi); }

__device__ __forceinline__ void p0_item(const float* W, int N, int K, int k0, int n_src0, bf16* WT, int n_dst0, const float* gain, LAS float* scr, int lane) {
#pragma unroll 8
    for (int i = 0; i < 32; ++i) { const int kk = 2 * i + (lane >> 5); float v = W[(size_t)(k0 + kk) * N + n_src0 + (lane & 31)]; if (gain) v *= gain[k0 + kk]; scr[kk * 33 + (lane & 31)] = v; }
    LDS_WAIT(); asm volatile("" ::: "memory");
    const int c = lane & 7;
#pragma unroll
    for (int j = 0; j < 4; ++j) { const int n = (lane >> 3) + 8 * j; const LAS float* s = scr + (8 * c) * 33 + n;
        v4u o; o.x = pk2(s[0 * 33], s[1 * 33]); o.y = pk2(s[2 * 33], s[3 * 33]); o.z = pk2(s[4 * 33], s[5 * 33]); o.w = pk2(s[6 * 33], s[7 * 33]);
        *(v4u*)(WT + (size_t)(n_dst0 + n) * K + k0 + 8 * c) = o; }
    LDS_WAIT(); asm volatile("" ::: "memory");
}
__device__ __forceinline__ int interleave128(int n, int half_cols) { const int hsel = n >= half_cols ? 1 : 0, nn = n - hsel * half_cols; return 256 * (nn >> 7) + 128 * hsel + (nn & 127); }

struct Args { const float* in[12]; float* out; unsigned char* ws; };

__device__ __forceinline__ void naive_attn_item(bf16* Q, const bf16* Kb, const bf16* Vb, const float* ksum, int m, int h, int lane) {
    const int t = m & (SEQ - 1), b = m / SEQ, ib = t / BS;
    const size_t qoff = (size_t)m * DM + h * HD + 2 * lane;
    const unsigned qq = *(const unsigned*)(Q + qoff); const float q0 = bf_lo(qq), q1 = bf_hi(qq);
    int s0 = -1, s1 = -1, s2 = -1; float g0 = -3.0e38f, g1 = -3.0e38f, g2 = -3.0e38f;
    for (int j = 0; j < ib; ++j) {
        const float2 km = *(const float2*)(ksum + (size_t)(b * NBLK + j) * DM + h * HD + 2 * lane);
        const float g = wave_sum(q0 * km.x + q1 * km.y);
        if (g > g0) { g2 = g1; s2 = s1; g1 = g0; s1 = s0; g0 = g; s0 = j; }
        else if (g > g1) { g2 = g1; s2 = s1; g1 = g; s1 = j; }
        else if (g > g2) { g2 = g; s2 = j; }
    }
    float mr = -1.0e30f, l = 0.f, o0 = 0.f, o1 = 0.f;
    for (int sidx = 0; sidx < 4; ++sidx) {
        const int blk = sidx == 0 ? s0 : sidx == 1 ? s1 : sidx == 2 ? s2 : ib;
        if (blk < 0) continue;
        const int nk = (sidx == 3) ? (t & (BS - 1)) + 1 : BS;
        const size_t rbase = ((size_t)b * SEQ + (size_t)blk * BS) * DM + h * HD + 2 * lane;
        for (int k0 = 0; k0 < nk; k0 += 4) {
            float d[4]; unsigned vv[4];
#pragma unroll
            for (int u = 0; u < 4; ++u) { const unsigned kk = *(const unsigned*)(Kb + rbase + (size_t)(k0 + u) * DM); vv[u] = *(const unsigned*)(Vb + rbase + (size_t)(k0 + u) * DM); d[u] = q0 * bf_lo(kk) + q1 * bf_hi(kk); }
#pragma unroll
            for (int o = 1; o < 64; o <<= 1) {
#pragma unroll
                for (int u = 0; u < 4; ++u) d[u] += __shfl_xor(d[u], o);
            }
#pragma unroll
            for (int u = 0; u < 4; ++u) if (k0 + u >= nk) d[u] = -1.0e30f;
            const float mn = fmaxf(fmaxf(mr, fmaxf(d[0], d[1])), fmaxf(d[2], d[3]));
            const float a = __builtin_amdgcn_exp2f(mr - mn); l *= a; o0 *= a; o1 *= a; mr = mn;
#pragma unroll
            for (int u = 0; u < 4; ++u) { const float p = __builtin_amdgcn_exp2f(d[u] - mn); l += p; o0 += p * bf_lo(vv[u]); o1 += p * bf_hi(vv[u]); }
        }
    }
    const float il = 1.0f / l;
    *(unsigned*)(Q + qoff) = pk2(o0 * il, o1 * il);
}


typedef float f32x16 __attribute__((ext_vector_type(16)));
typedef short v4i16_t __attribute__((ext_vector_type(4)));
#define MFMA32(a, b, c) __builtin_amdgcn_mfma_f32_32x32x16_bf16((a), (b), (c), 0, 0, 0)
__device__ __forceinline__ int crow(int r, int hi) { return (r & 3) + 8 * (r >> 2) + 4 * hi; }
constexpr int CW_QUEUE = 8192, CW_CNT = 12288;
constexpr int LIST_PER_BH = 256 * 496;
__device__ __forceinline__ int list_off(int j) { return 256 * (31 * j - (j * (j - 1)) / 2); }
constexpr size_t OUT_LSE_OFF = 0, OUT_LIST_OFF = 2u << 20;
constexpr float NEG_BIG = -1.0e30f;
#define GT_(va, ia, vb, ib_) ((va) > (vb) || ((va) == (vb) && (ia) < (ib_)))
#define TOP3_INSERT(v, i) do { const float v_ = (v); const int i_ = (i); \
    if (GT_(v_, i_, v0, i0)) { v2 = v1; i2 = i1; v1 = v0; i1 = i0; v0 = v_; i0 = i_; } \
    else if (GT_(v_, i_, v1, i1)) { v2 = v1; i2 = i1; v1 = v_; i1 = i_; } \
    else if (GT_(v_, i_, v2, i2)) { v2 = v_; i2 = i_; } } while (0)

__device__ __forceinline__ void gate_unit(int b, int ib, int hd, const bf16* Qb, const float* ksum, gu32* gcount, unsigned* lists, LAS unsigned char* lds, int tid, int lane, int wave) {
    const int r32 = lane & 31, hi = lane >> 5, bh = b * NH + hd;
    const int t = ib * BS + wave * 32 + r32;
    LAS unsigned* cnt = (LAS unsigned*)lds; LAS unsigned* basel = cnt + 32;
    if (tid < 32) cnt[tid] = 0u;
    f32x16 acc;
#pragma unroll
    for (int i = 0; i < 16; ++i) acc[i] = 0.f;
    const bf16* qp = Qb + ((size_t)b * SEQ + t) * DM + hd * HD + 8 * hi;
    const float* kp = ksum + (size_t)(b * NBLK + r32) * DM + hd * HD + 8 * hi;
#pragma unroll
    for (int s = 0; s < 8; ++s) {
        const bf16x8 qf = *(const bf16x8*)(qp + 16 * s);
        const f32x4 k0 = *(const f32x4*)(kp + 16 * s), k1 = *(const f32x4*)(kp + 16 * s + 4);
        v4u wh, wl;
        wh.x = pk2(k0[0], k0[1]); wh.y = pk2(k0[2], k0[3]); wh.z = pk2(k1[0], k1[1]); wh.w = pk2(k1[2], k1[3]);
        wl.x = pk2(k0[0] - bf_lo(wh.x), k0[1] - bf_hi(wh.x)); wl.y = pk2(k0[2] - bf_lo(wh.y), k0[3] - bf_hi(wh.y));
        wl.z = pk2(k1[0] - bf_lo(wh.z), k1[1] - bf_hi(wh.z)); wl.w = pk2(k1[2] - bf_lo(wh.w), k1[3] - bf_hi(wh.w));
        acc = MFMA32(__builtin_bit_cast(bf16x8, wh), qf, acc);
        acc = MFMA32(__builtin_bit_cast(bf16x8, wl), qf, acc);
    }
    float v0 = -3.0e38f, v1 = -3.0e38f, v2 = -3.0e38f; int i0 = 99, i1 = 99, i2 = 99;
#pragma unroll
    for (int i = 0; i < 16; ++i) { const int blk = crow(i, hi); const float g = blk < ib ? acc[i] : -3.0e38f; TOP3_INSERT(g, blk); }
    { const float p0 = __shfl_xor(v0, 32), p1 = __shfl_xor(v1, 32), p2 = __shfl_xor(v2, 32); const int q0 = __shfl_xor(i0, 32), q1 = __shfl_xor(i1, 32), q2 = __shfl_xor(i2, 32);
      TOP3_INSERT(p0, q0); TOP3_INSERT(p1, q1); TOP3_INSERT(p2, q2); }
    const bool ok0 = hi == 0 && v0 > -1.0e38f, ok1 = hi == 0 && v1 > -1.0e38f, ok2 = hi == 0 && v2 > -1.0e38f;
    __syncthreads();
    unsigned r0 = 0, r1 = 0, r2 = 0;
    if (ok0) r0 = __hip_atomic_fetch_add(cnt + i0, 1u, __ATOMIC_RELAXED, __HIP_MEMORY_SCOPE_WORKGROUP);
    if (ok1) r1 = __hip_atomic_fetch_add(cnt + i1, 1u, __ATOMIC_RELAXED, __HIP_MEMORY_SCOPE_WORKGROUP);
    if (ok2) r2 = __hip_atomic_fetch_add(cnt + i2, 1u, __ATOMIC_RELAXED, __HIP_MEMORY_SCOPE_WORKGROUP);
    __syncthreads();
    if (tid < 32) { const unsigned c = cnt[tid]; basel[tid] = c ? __hip_atomic_fetch_add(gcount + bh * 32 + tid, c, RLX_AGENT) : 0u; }
    __syncthreads();
    unsigned* lb = lists + (size_t)bh * LIST_PER_BH;
    if (ok0) lb[list_off(i0) + basel[i0] + r0] = (unsigned)t;
    if (ok1) lb[list_off(i1) + basel[i1] + r1] = (unsigned)t | (1u << 13);
    if (ok2) lb[list_off(i2) + basel[i2] + r2] = (unsigned)t | (2u << 13);
    __syncthreads();
}

__device__ __forceinline__ void attn_wave_item(LAS unsigned char* Kimg, LAS unsigned char* Vimg, const bf16* Qb, bf16* Opart, float* lse, size_t mrow, int hd, int slot, bool valid, int kmax, bool own, int lane) {
    const int r32 = lane & 31, hi = lane >> 5;
    const bf16* qp = Qb + mrow * DM + hd * HD + 8 * hi;
    bf16x8 qf[8];
#pragma unroll
    for (int s = 0; s < 8; ++s) qf[s] = *(const bf16x8*)(qp + 16 * s);
    const int xr = ((r32 & 3) << 2) | ((r32 >> 2) & 3);
    const LAS unsigned char* kb = Kimg + 256 * r32;
    f32x16 S[8];
#pragma unroll
    for (int kt = 0; kt < 8; ++kt) {
        if (kt <= kmax) {
            f32x16 a;
#pragma unroll
            for (int i = 0; i < 16; ++i) a[i] = 0.f;
#pragma unroll
            for (int s = 0; s < 8; ++s) { const bf16x8 kf = *(const LAS bf16x8*)(kb + 16 * ((2 * s + hi) ^ xr) + 8192 * kt); a = MFMA32(kf, qf[s], a); }
            if (own && kt == kmax) {
#pragma unroll
                for (int i = 0; i < 16; ++i) if (crow(i, hi) > r32) a[i] = NEG_BIG;
            }
            S[kt] = a;
        } else {
#pragma unroll
            for (int i = 0; i < 16; ++i) S[kt][i] = NEG_BIG;
        }
    }
    float mx = NEG_BIG;
#pragma unroll
    for (int kt = 0; kt < 8; ++kt)
#pragma unroll
        for (int i = 0; i < 16; ++i) mx = fmaxf(mx, S[kt][i]);
    mx = fmaxf(mx, __shfl_xor(mx, 32));
    float lsum = 0.f; v4u pw[8][2];
#pragma unroll
    for (int kt = 0; kt < 8; ++kt) {
        float p[16];
#pragma unroll
        for (int i = 0; i < 16; ++i) { p[i] = __builtin_amdgcn_exp2f(S[kt][i] - mx); lsum += p[i]; }
#pragma unroll
        for (int s2 = 0; s2 < 2; ++s2) { pw[kt][s2].x = pk2(p[8 * s2], p[8 * s2 + 1]); pw[kt][s2].y = pk2(p[8 * s2 + 2], p[8 * s2 + 3]); pw[kt][s2].z = pk2(p[8 * s2 + 4], p[8 * s2 + 5]); pw[kt][s2].w = pk2(p[8 * s2 + 6], p[8 * s2 + 7]); }
    }
    lsum += __shfl_xor(lsum, 32);
    const int blk = (lane >> 4) & 1, q4 = (lane & 15) >> 2, p4 = lane & 3;
    int vb[2][4];
#pragma unroll
    for (int t = 0; t < 2; ++t)
#pragma unroll
        for (int c4 = 0; c4 < 4; ++c4) vb[t][c4] = 256 * (8 * t + 4 * hi + q4) + 64 * (c4 ^ q4) + 16 * ((2 * blk + (p4 >> 1)) ^ ((2 * t + hi) & 3)) + 8 * (p4 & 1);
    f32x16 O[4];
#pragma unroll
    for (int c4 = 0; c4 < 4; ++c4)
#pragma unroll
        for (int i = 0; i < 16; ++i) O[c4][i] = 0.f;
#pragma unroll
    for (int kt = 0; kt < 8; ++kt) {
        if (kt <= kmax) {
#pragma unroll
            for (int s2 = 0; s2 < 2; ++s2) {
                const bf16x8 pf = __builtin_bit_cast(bf16x8, pw[kt][s2]);
#pragma unroll
                for (int c4 = 0; c4 < 4; ++c4) {
                    const v4i16_t lo = __builtin_amdgcn_ds_read_tr16_b64_v4i16((LAS v4i16_t*)(Vimg + vb[0][c4] + 8192 * kt + 4096 * s2));
                    const v4i16_t hh = __builtin_amdgcn_ds_read_tr16_b64_v4i16((LAS v4i16_t*)(Vimg + vb[1][c4] + 8192 * kt + 4096 * s2));
                    const bf16x8 vf = (bf16x8){lo[0], lo[1], lo[2], lo[3], hh[0], hh[1], hh[2], hh[3]};
                    O[c4] = MFMA32(vf, pf, O[c4]);
                }
            }
        }
    }
    if (valid) {
        const float il = 1.0f / lsum;
        const size_t rec = (mrow * NH + hd) * 4 + slot;
        bf16* op = Opart + rec * HD + 4 * hi;
#pragma unroll
        for (int c4 = 0; c4 < 4; ++c4)
#pragma unroll
            for (int g = 0; g < 4; ++g) {
                uint2 w; w.x = pk2(O[c4][4 * g] * il, O[c4][4 * g + 1] * il); w.y = pk2(O[c4][4 * g + 2] * il, O[c4][4 * g + 3] * il);
                *(uint2*)(op + 32 * c4 + 8 * g) = w;
            }
        if (hi == 0) lse[rec] = mx + __builtin_log2f(lsum);
    }
}

__device__ __forceinline__ void attn_phase(LAS unsigned char* lds, volatile LAS unsigned* qslot, gu32* ctl, const bf16* Qb, const bf16* Kb, const bf16* Vb, bf16* Opart, float* lse, const unsigned* lists, int tid, int lane, int wave) {
    LAS unsigned char* Kimg = lds; LAS unsigned char* Vimg = lds + 65536;
    for (;;) {
        if (tid == 0) *qslot = __hip_atomic_fetch_add(ctl + CW_QUEUE, 1u, RLX_AGENT);
        __syncthreads();
        const int it = (int)*qslot;
        if (it >= NBLK * BATCH * NH) break;
        const int j = it >> 5, bh = it & 31, b = bh >> 3, hd = bh & 7;
        const size_t kvrow0 = (size_t)b * SEQ + (size_t)j * BS;
#pragma unroll
        for (int i = 0; i < 8; ++i) {
            const int pc = i * 8 + wave, row = 4 * pc + (lane >> 4), ch = (lane & 15) ^ (((lane >> 4) << 2) | (pc & 3));
            const size_t src = (kvrow0 + row) * DM + hd * HD + ch * 8;
            __builtin_amdgcn_global_load_lds((const unsigned*)(Kb + src), (LAS unsigned*)(Kimg + pc * 1024), 16, 0, 0);
            __builtin_amdgcn_global_load_lds((const unsigned*)(Vb + src), (LAS unsigned*)(Vimg + pc * 1024), 16, 0, 0);
        }
        const int n = (int)__hip_atomic_load(ctl + CW_CNT + bh * 32 + j, RLX_AGENT);
        const unsigned* lb = lists + (size_t)bh * LIST_PER_BH + list_off(j);
        asm volatile("s_waitcnt vmcnt(0)" ::: "memory");
        __syncthreads();
        const int nch = 8 + ((n + 31) >> 5);
        for (int c = wave; c < nch; c += NWAVES) {
            int tq, slot, kmax; bool valid, own;
            if (c < 8) { tq = j * BS + c * 32 + (lane & 31); slot = 3; valid = true; kmax = c; own = true; }
            else { const int e = (c - 8) * 32 + (lane & 31); valid = e < n; const unsigned ent = valid ? lb[e] : (unsigned)(j * BS); tq = (int)(ent & 8191u); slot = (int)(ent >> 13); kmax = 7; own = false; }
            attn_wave_item(Kimg, Vimg, Qb, Opart, lse, (size_t)b * SEQ + tq, hd, slot, valid, kmax, own, lane);
        }
        __syncthreads();
    }
}


typedef const __attribute__((address_space(4))) Args* KArgs;
__device__ __forceinline__ KArgs get_args() { const __attribute__((address_space(4))) void* p = (const __attribute__((address_space(4))) void*)__builtin_amdgcn_kernarg_segment_ptr(); asm volatile("" : "+s"(p)); return (KArgs)p; }
#define GRID_BAR() do { XcdBarrier b_; b_.bar = (unsigned*)(get_args()->ws + WS_CTL) + CW_BAR; b_.x = xb_xcc_id(); b_.st = MISC + 8; xcd_barrier(b_); } while (0)
#define WSP(T, off) ((T*)(ws + (off)))
__global__ void __launch_bounds__(NWAVES * 64, 2) moba_fwd(Args args_unused) {
    extern __shared__ __attribute__((aligned(16))) unsigned char lds_raw[];
    LAS unsigned char* lds = (LAS unsigned char*)lds_raw;
    volatile LAS unsigned* MISC = (volatile LAS unsigned*)(lds + MISC_OFF);
    const int tid = threadIdx.x, lane = tid & 63, wave = __builtin_amdgcn_readfirstlane(tid >> 6);
    const int G = gridDim.x; const int bx = blockIdx.x; const int vcu = (G % 8 == 0) ? (bx % 8) * (G / 8) + bx / 8 : bx;
    for (int u = tid; u < (LDS_BYTES - LDSCTL_OFF) / 4; u += NWAVES * 64) ((LAS unsigned*)(lds + LDSCTL_OFF))[u] = 0u;
    __syncthreads();
    (void)xcd_barrier_post((unsigned*)(get_args()->ws + WS_CTL) + CW_BAR, MISC + 8);
    const int gw = vcu * NWAVES + wave, NGW = G * NWAVES;
    const int gt = vcu * NWAVES * 64 + tid, NGT = G * NWAVES * 64;

    {
        KArgs A = get_args(); unsigned char* ws = A->ws;
        const float* x = A->in[0]; const float* attn_norm = A->in[1]; const float* w_qkv = A->in[2]; const float* w_o = A->in[3];
        const float* conv_norm = A->in[4]; const float* w_ci = A->in[5]; const float* w_co = A->in[7];
        const float* ffn_norm = A->in[8]; const float* w_f1 = A->in[9]; const float* w_f2 = A->in[10];
        bf16* Wqkv_t = WSP(bf16, WS_WQKV); bf16* Wo_t = WSP(bf16, WS_WO); bf16* Wf1_t = WSP(bf16, WS_WF1); bf16* Wf2_t = WSP(bf16, WS_WF2); bf16* Wci_t = WSP(bf16, WS_WCI); bf16* Wco_t = WSP(bf16, WS_WCO);
        bf16* XB = WSP(bf16, WS_XB); float* ss0 = WSP(float, WS_SS0);
        LAS float* scr = (LAS float*)(lds + RING_OFF + wave * 16384);
        constexpr int I_QKV = (DM / 64) * (3 * DM / 32), I_O = (DM / 64) * (DM / 32), I_F1 = (DM / 64) * (2 * FF / 32), I_F2 = (FF / 64) * (DM / 32);
        constexpr int NITEMS = I_QKV + I_O + 2 * I_F1 + 2 * I_F2 + I_QKV + I_O;
        for (int it = gw; it < NITEMS; it += NGW) {
            int r = it;
            if (r < I_QKV) { const int nb = 3 * DM / 32, k0 = 64 * (r / nb), n0 = 32 * (r % nb); p0_item(w_qkv, 3 * DM, DM, k0, n0, Wqkv_t, n0, attn_norm, scr, lane); continue; } r -= I_QKV;
            if (r < I_O) { const int nb = DM / 32, k0 = 64 * (r / nb), n0 = 32 * (r % nb); p0_item(w_o, DM, DM, k0, n0, Wo_t, n0, nullptr, scr, lane); continue; } r -= I_O;
            if (r < 2 * I_F1) { const int L = r / I_F1; r -= L * I_F1; const int nb = 2 * FF / 32, k0 = 64 * (r / nb), n0 = 32 * (r % nb);
                p0_item(w_f1 + (size_t)L * DM * 2 * FF, 2 * FF, DM, k0, n0, Wf1_t + (size_t)L * 2 * FF * DM, interleave128(n0, FF), ffn_norm + L * DM, scr, lane); continue; } r -= 2 * I_F1;
            if (r < 2 * I_F2) { const int L = r / I_F2; r -= L * I_F2; const int nb = DM / 32, k0 = 64 * (r / nb), n0 = 32 * (r % nb);
                p0_item(w_f2 + (size_t)L * FF * DM, DM, FF, k0, n0, Wf2_t + (size_t)L * DM * FF, n0, nullptr, scr, lane); continue; } r -= 2 * I_F2;
            if (r < I_QKV) { const int nb = 3 * DM / 32, k0 = 64 * (r / nb), n0 = 32 * (r % nb);
                const int nd = n0 < DM ? 2 * DM + n0 : interleave128(n0 - DM, DM);
                p0_item(w_ci, 3 * DM, DM, k0, n0, Wci_t, nd, conv_norm, scr, lane); continue; } r -= I_QKV;
            { const int nb = DM / 32, k0 = 64 * (r / nb), n0 = 32 * (r % nb); p0_item(w_co, DM, DM, k0, n0, Wco_t, n0, nullptr, scr, lane); }
        }
        for (int i = gt; i < (int)(MiB / 16); i += NGT) ((v4u*)(ws + WS_KSUM))[i] = (v4u){0u, 0u, 0u, 0u};
        for (int m = gw; m < MROWS; m += NGW) {
            const f32x4* xr = (const f32x4*)(x + (size_t)m * DM) + lane; f32x4 v[4]; float s = 0.f;
#pragma unroll
            for (int j = 0; j < 4; ++j) { v[j] = xr[64 * j]; s += (v[j].x * v[j].x + v[j].y * v[j].y) + (v[j].z * v[j].z + v[j].w * v[j].w); }
            s = wave_sum(s); if (lane == 0) ss0[m] = s;
            unsigned long long* o8 = (unsigned long long*)(XB + (size_t)m * DM) + lane;
#pragma unroll
            for (int j = 0; j < 4; ++j) o8[64 * j] = (unsigned long long)pk2(v[j].x, v[j].y) | ((unsigned long long)pk2(v[j].z, v[j].w) << 32);
        }
    }
    GRID_BAR();

    {
        unsigned char* ws = get_args()->ws;
        pg8::Gemm g{WSP(bf16, WS_XB), WSP(bf16, WS_WQKV), MROWS, 3 * DM, DM}; pg8::StaticOrder S; S.init(MROWS, 3 * DM, G, bx);
        pg8::EpiQKV E{WSP(bf16, WS_Q), (size_t)MROWS * DM, WSP(float, WS_SS0), WSP(float, WS_KSUM), QSCALE};
        pg8::gemm_phase<pg8::EpiQKV, pg8::StaticOrder, PG8_ALIGN, PG8_SP2>(lds + RING_OFF, g, S, E);
    }
    GRID_BAR();

    {
        KArgs A = get_args(); unsigned char* ws = A->ws;
        for (int u = vcu; u < BATCH * NBLK * NH; u += G) gate_unit(u >> 8, (u >> 3) & 31, u & 7, WSP(bf16, WS_Q), WSP(float, WS_KSUM), (gu32*)(ws + WS_CTL) + CW_CNT, (unsigned*)A->out + OUT_LIST_OFF, lds + RING_OFF, tid, lane, wave);
    }
    GRID_BAR();
    {
        KArgs A = get_args(); unsigned char* ws = A->ws;
        attn_phase(lds + RING_OFF, MISC + 16, (gu32*)(ws + WS_CTL), WSP(bf16, WS_Q), WSP(bf16, WS_K), WSP(bf16, WS_V), WSP(bf16, WS_XB), A->out + OUT_LSE_OFF, (const unsigned*)A->out + OUT_LIST_OFF, tid, lane, wave);
    }
    GRID_BAR();
    {
        KArgs A = get_args(); unsigned char* ws = A->ws;
        const float* lse = A->out + OUT_LSE_OFF; const bf16* Opart = WSP(bf16, WS_XB); bf16* Qb = WSP(bf16, WS_Q);
        for (int idx = gt; idx < MROWS * NH * 16; idx += NGT) {
            const int mh = idx >> 4, piece = idx & 15, m = mh >> 3, ib = (m & (SEQ - 1)) >> 8, nsel = ib < 3 ? ib : 3;
            const f32x4 L = *(const f32x4*)(lse + (size_t)mh * 4);
            float mx = L[3]; if (nsel > 0) mx = fmaxf(mx, L[0]); if (nsel > 1) mx = fmaxf(mx, L[1]); if (nsel > 2) mx = fmaxf(mx, L[2]);
            float w[4]; w[3] = __builtin_amdgcn_exp2f(L[3] - mx);
#pragma unroll
            for (int k = 0; k < 3; ++k) w[k] = nsel > k ? __builtin_amdgcn_exp2f(L[k] - mx) : 0.f;
            const bf16* op = Opart + (size_t)mh * 4 * HD + piece * 8;
            float a8[8];
#pragma unroll
            for (int e = 0; e < 8; ++e) a8[e] = 0.f;
#pragma unroll
            for (int k = 0; k < 4; ++k) if (k == 3 || nsel > k) { const v4u o = *(const v4u*)(op + k * HD);
#pragma unroll
                for (int e = 0; e < 4; ++e) { a8[2 * e] += w[k] * bf_lo(o[e]); a8[2 * e + 1] += w[k] * bf_hi(o[e]); } }
            const float inv = 1.0f / ((w[0] + w[1]) + (w[2] + w[3]));
            v4u y;
#pragma unroll
            for (int e = 0; e < 4; ++e) y[e] = pk2(a8[2 * e] * inv, a8[2 * e + 1] * inv);
            *(v4u*)(Qb + (size_t)m * DM + (mh & 7) * HD + piece * 8) = y;
        }
    }
    GRID_BAR();

    {
        KArgs A = get_args(); unsigned char* ws = A->ws;
        pg8::Gemm g{WSP(bf16, WS_Q), WSP(bf16, WS_WO), MROWS, DM, DM}; pg8::StaticOrder S; S.init(MROWS, DM, G, bx);
        pg8::EpiRes<true> E{A->in[0], A->out, WSP(bf16, WS_XB), WSP(float, WS_SS)};
        pg8::gemm_phase<pg8::EpiRes<true>, pg8::StaticOrder, PG8_ALIGN, PG8_SP2>(lds + RING_OFF, g, S, E);
    }
    GRID_BAR();

    {
        unsigned char* ws = get_args()->ws;
        pg8::Gemm g{WSP(bf16, WS_XB), WSP(bf16, WS_WF1), MROWS, 2 * FF, DM}; pg8::StaticOrder S; S.init(MROWS, 2 * FF, G, bx);
        pg8::EpiSwiglu E{WSP(bf16, WS_H), FF, WSP(float, WS_SS)};
        pg8::gemm_phase<pg8::EpiSwiglu, pg8::StaticOrder, PG8_ALIGN, PG8_SP2>(lds + RING_OFF, g, S, E);
    }
    GRID_BAR();
    {
        KArgs A = get_args(); unsigned char* ws = A->ws;
        pg8::Gemm g{WSP(bf16, WS_H), WSP(bf16, WS_WF2), MROWS, DM, FF}; pg8::StaticOrder S; S.init(MROWS, DM, G, bx);
        pg8::EpiRes<true> E{A->out, A->out, WSP(bf16, WS_XB), WSP(float, WS_SS) + MROWS};
        pg8::gemm_phase<pg8::EpiRes<true>, pg8::StaticOrder, PG8_ALIGN, PG8_SP2>(lds + RING_OFF, g, S, E);
    }
    GRID_BAR();

    {
        unsigned char* ws = get_args()->ws;
        pg8::Gemm g{WSP(bf16, WS_XB), WSP(bf16, WS_WCI), MROWS, 3 * DM, DM}; pg8::StaticOrder S; S.init(MROWS, 3 * DM, G, bx);
        pg8::EpiConvIn E{WSP(bf16, WS_Q), WSP(bf16, WS_K), WSP(float, WS_SS) + MROWS};
        pg8::gemm_phase<pg8::EpiConvIn, pg8::StaticOrder, PG8_ALIGN, PG8_SP2>(lds + RING_OFF, g, S, E);
    }
    GRID_BAR();

    {
        KArgs A = get_args(); unsigned char* ws = A->ws; const float* conv_w = A->in[6];
        const bf16* Qb = WSP(bf16, WS_Q); const bf16* Kb = WSP(bf16, WS_K); bf16* Vb = WSP(bf16, WS_V);
        for (int idx = gt; idx < MROWS * (DM / 8); idx += NGT) {
            const int m = idx >> 7, c8 = (idx & 127) * 8, t = m & (SEQ - 1);
            const size_t off = (size_t)m * DM + c8;
            const v4u u2 = *(const v4u*)(Qb + off), bb = *(const v4u*)(Kb + off);
            v4u u1 = (v4u){0u, 0u, 0u, 0u}, u0 = (v4u){0u, 0u, 0u, 0u};
            if (t >= 1) u1 = *(const v4u*)(Qb + off - DM);
            if (t >= 2) u0 = *(const v4u*)(Qb + off - 2 * DM);
            const f32x4 w0a = *(const f32x4*)(conv_w + c8), w0b = *(const f32x4*)(conv_w + c8 + 4), w1a = *(const f32x4*)(conv_w + DM + c8), w1b = *(const f32x4*)(conv_w + DM + c8 + 4),
                        w2a = *(const f32x4*)(conv_w + 2 * DM + c8), w2b = *(const f32x4*)(conv_w + 2 * DM + c8 + 4);
            v4u y;
#pragma unroll
            for (int e = 0; e < 4; ++e) {
                const float wl0 = e < 2 ? w0a[2 * e] : w0b[2 * e - 4], wh0 = e < 2 ? w0a[2 * e + 1] : w0b[2 * e - 3];
                const float wl1 = e < 2 ? w1a[2 * e] : w1b[2 * e - 4], wh1 = e < 2 ? w1a[2 * e + 1] : w1b[2 * e - 3];
                const float wl2 = e < 2 ? w2a[2 * e] : w2b[2 * e - 4], wh2 = e < 2 ? w2a[2 * e + 1] : w2b[2 * e - 3];
                const float lo = bf_lo(bb[e]) * (wl0 * bf_lo(u0[e]) + wl1 * bf_lo(u1[e]) + wl2 * bf_lo(u2[e]));
                const float hi = bf_hi(bb[e]) * (wh0 * bf_hi(u0[e]) + wh1 * bf_hi(u1[e]) + wh2 * bf_hi(u2[e]));
                y[e] = pk2(lo, hi);
            }
            *(v4u*)(Vb + off) = y;
        }
    }
    GRID_BAR();

    {
        KArgs A = get_args(); unsigned char* ws = A->ws;
        pg8::Gemm g{WSP(bf16, WS_V), WSP(bf16, WS_WCO), MROWS, DM, DM}; pg8::StaticOrder S; S.init(MROWS, DM, G, bx);
        pg8::EpiRes<true> E{A->out, A->out, WSP(bf16, WS_XB), WSP(float, WS_SS) + 2 * MROWS};
        pg8::gemm_phase<pg8::EpiRes<true>, pg8::StaticOrder, PG8_ALIGN, PG8_SP2>(lds + RING_OFF, g, S, E);
    }
    GRID_BAR();

    {
        unsigned char* ws = get_args()->ws;
        pg8::Gemm g{WSP(bf16, WS_XB), WSP(bf16, WS_WF1) + (size_t)2 * FF * DM, MROWS, 2 * FF, DM}; pg8::StaticOrder S; S.init(MROWS, 2 * FF, G, bx);
        pg8::EpiSwiglu E{WSP(bf16, WS_H), FF, WSP(float, WS_SS) + 2 * MROWS};
        pg8::gemm_phase<pg8::EpiSwiglu, pg8::StaticOrder, PG8_ALIGN, PG8_SP2>(lds + RING_OFF, g, S, E);
    }
    GRID_BAR();
    {
        KArgs A = get_args(); unsigned char* ws = A->ws;
        pg8::Gemm g{WSP(bf16, WS_H), WSP(bf16, WS_WF2) + (size_t)DM * FF, MROWS, DM, FF}; pg8::StaticOrder S; S.init(MROWS, DM, G, bx);
        pg8::EpiRes<false> E{A->out, A->out, nullptr, nullptr};
        pg8::gemm_phase<pg8::EpiRes<false>, pg8::StaticOrder, PG8_ALIGN, PG8_SP2>(lds + RING_OFF, g, S, E);
    }
    GRID_BAR();

    {
        KArgs A = get_args(); float* out = A->out; const float* final_norm = A->in[11];
        for (int m = gw; m < MROWS; m += NGW) {
            f32x4* xr = (f32x4*)(out + (size_t)m * DM) + lane; const f32x4* gr = (const f32x4*)final_norm + lane; f32x4 v[4]; float s = 0.f;
#pragma unroll
            for (int j = 0; j < 4; ++j) { v[j] = xr[64 * j]; s += (v[j].x * v[j].x + v[j].y * v[j].y) + (v[j].z * v[j].z + v[j].w * v[j].w); }
            const float r = __builtin_amdgcn_rsqf(wave_sum(s) * (1.0f / DM) + EPS);
#pragma unroll
            for (int j = 0; j < 4; ++j) xr[64 * j] = v[j] * r * gr[64 * j];
        }
    }
}

extern "C" void kernel_launch(void* const* d_in, const int* in_sizes, int n_in, void* d_out, int out_size, void* d_ws, size_t ws_size, hipStream_t stream) {
    static int grid = 0;
    if (grid == 0) {
        if (n_in != 12 || in_sizes[0] != MROWS * DM || out_size != MROWS * DM || ws_size < WS_END) {
            fprintf(stderr, "kernel_launch: unexpected shapes (n_in %d, in0 %d, out %d, ws %zu); nothing launched\n", n_in, n_in > 0 ? in_sizes[0] : -1, out_size, ws_size); grid = -1; return; }
        int dev = 0, cus = 0, per_cu = 0;
        if (hipGetDevice(&dev) != hipSuccess || hipDeviceGetAttribute(&cus, hipDeviceAttributeMultiprocessorCount, dev) != hipSuccess) { grid = -1; return; }
        if (hipFuncSetAttribute((const void*)moba_fwd, hipFuncAttributeMaxDynamicSharedMemorySize, LDS_BYTES) != hipSuccess) { fprintf(stderr, "kernel_launch: hipFuncSetAttribute failed\n"); grid = -1; return; }
        if (hipOccupancyMaxActiveBlocksPerMultiprocessor(&per_cu, (const void*)moba_fwd, NWAVES * 64, LDS_BYTES) != hipSuccess || per_cu < 1) {
            fprintf(stderr, "kernel_launch: occupancy query reports %d blocks per CU; nothing launched\n", per_cu); (void)hipGetLastError(); grid = -1; return; }
        grid = cus;
    }
    if (grid < 0) return;
    if (hipMemsetAsync((char*)d_ws + WS_CTL, 0, CTL_ZERO_BYTES, stream) != hipSuccess) return;
    Args a{};
    for (int i = 0; i < 12; ++i) a.in[i] = (const float*)d_in[i];
    a.out = (float*)d_out; a.ws = (unsigned char*)d_ws;
    hipLaunchKernelGGL(moba_fwd, dim3(grid), dim3(NWAVES * 64), LDS_BYTES, stream, a);
}
```

```cpp
#include <hip/hip_runtime.h>
#include <cstdio>
#include <cstdint>
#define PROBE_MASK_V 0u
namespace pg8 {
#define PG8_LAS __attribute__((address_space(3)))
typedef unsigned short bf16_t;
typedef short bf16x8 __attribute__((ext_vector_type(8)));
typedef float f32x4 __attribute__((ext_vector_type(4)));
typedef unsigned u32x4 __attribute__((ext_vector_type(4)));
constexpr int BM = 256, BK = 64, HALF = 128, HTB = HALF * BK * 2  , STAGE_BYTES = 8 * HTB, NXCD = 8, WGM = 8;

__host__ __device__ __forceinline__ int lds_byte(int r, int c) { const int st = (r >> 4) * 2 + (c >> 5), rr = r & 15, cc = c & 31, ob = rr * 64 + cc * 2; return st * 1024 + (ob ^ (((ob >> 9) & 1) << 5)); }
__host__ __device__ __forceinline__ void stage_rc(int b, int& R, int& C) { const int st = b / 1024, sb = b % 1024, swz = sb ^ (((sb >> 9) & 1) << 5); R = (st >> 1) * 16 + swz / 64; C = (st & 1) * 32 + (swz % 64) / 2; }
__host__ __device__ __forceinline__ int perm32(int rho) { const int n = rho >> 4, i = rho & 15; return 8 * (i >> 2) + 4 * n + (i & 3); }

struct Unit { int pm, pn; };
struct Gemm { const bf16_t* A; const bf16_t* Bt; int M, N, K; };

struct StaticOrder {
    int nM, nN, nwg, G, c;
    __host__ __device__ void init(int M, int N, int G_, int c_) { nM = M / BM; nN = N / BM; nwg = nM * nN; G = G_; c = c_; }
    __host__ __device__ bool next(int i, Unit& u) const {
        const long L = (long)i * G + c; if (L >= nwg) return false;
        int wgid = (int)L; { const int q = nwg / NXCD, r = nwg % NXCD, xcd = wgid % NXCD, off = wgid / NXCD; wgid = (xcd < r ? xcd * (q + 1) : r * (q + 1) + (xcd - r) * q) + off; }
        const int nig = WGM * nN, gid = wgid / nig, fm = gid * WGM, gsz = (nM - fm) < WGM ? (nM - fm) : WGM;
        u.pm = fm + ((wgid % nig) % gsz); u.pn = (wgid % nig) / gsz; return true;
    }
    __device__ __forceinline__ void a_ready(const Unit&) const {}
    __device__ __forceinline__ void done(const Unit&) const {}
};

__device__ __forceinline__ unsigned cvt_pk_bf16(float lo, float hi) { unsigned r; asm volatile("v_cvt_pk_bf16_f32 %0, %1, %2" : "=v"(r) : "v"(lo), "v"(hi)); return r; }
constexpr int   ROWLEN = 1024;
constexpr float RMS_EPS = 1e-6f, INV_D = 1.0f / 1024.0f;
__device__ __forceinline__ u32x4 pack8(const f32x4 a, const f32x4 b) { u32x4 w; w.x = cvt_pk_bf16(a[0], a[1]); w.y = cvt_pk_bf16(a[2], a[3]); w.z = cvt_pk_bf16(b[0], b[1]); w.w = cvt_pk_bf16(b[2], b[3]); return w; }
__device__ __forceinline__ float rowscale(const float* ss, int row) { return __builtin_amdgcn_rsqf(ss[row] * INV_D + RMS_EPS); }

struct EpiQKV {
    static constexpr bool PERM = true, AFTER_DRAIN = false;
    bf16_t* Q; size_t tstride; const float* ss; float* ksum; float qscale;
    __device__ __forceinline__ void operator()(const f32x4 (&acc)[2][2][4][2], const Unit& u, int wr, int wc, int fr, int fq) const {
        const int t = u.pn >> 2, colt = (u.pn & 3) * BM + wc * 32 + 8 * fq;
        bf16_t* base = Q + (size_t)t * tstride;
        const float sc = (t == 0) ? qscale : 1.0f;
        f32x4 cs[2][2];
#pragma unroll
        for (int bj = 0; bj < 2; ++bj)
#pragma unroll
            for (int n = 0; n < 2; ++n) cs[bj][n] = (f32x4){0.f, 0.f, 0.f, 0.f};
        float rs[2][4];
#pragma unroll
        for (int ai = 0; ai < 2; ++ai)
#pragma unroll
            for (int m = 0; m < 4; ++m) rs[ai][m] = ss[u.pm * BM + ai * HALF + wr * 64 + m * 16 + fr];
#pragma unroll
        for (int ai = 0; ai < 2; ++ai)
#pragma unroll
            for (int m = 0; m < 4; ++m) {
                const int row = u.pm * BM + ai * HALF + wr * 64 + m * 16 + fr;
                const float r = __builtin_amdgcn_rsqf(rs[ai][m] * INV_D + RMS_EPS) * sc;
#pragma unroll
                for (int bj = 0; bj < 2; ++bj) {
                    const f32x4 v0 = acc[ai][bj][m][0] * r, v1 = acc[ai][bj][m][1] * r;
                    cs[bj][0] += v0; cs[bj][1] += v1;
                    *(u32x4*)(base + (size_t)row * ROWLEN + colt + bj * HALF) = pack8(v0, v1);
                }
            }
        if (t == 1) {
#pragma unroll
            for (int bj = 0; bj < 2; ++bj)
#pragma unroll
                for (int n = 0; n < 2; ++n)
#pragma unroll
                    for (int e = 0; e < 4; ++e) {
                        float s = cs[bj][n][e];
                        s += __shfl_xor(s, 1); s += __shfl_xor(s, 2); s += __shfl_xor(s, 4); s += __shfl_xor(s, 8);
                        if (fr == 0) atomicAdd(ksum + (size_t)u.pm * ROWLEN + colt + bj * HALF + 4 * n + e, s);
                    }
        }
    }
};

template <bool F32IN, bool WANT_SS> struct EpiRes {
    static constexpr bool PERM = true, AFTER_DRAIN = false;
    const float* xin; bf16_t* xb; float* ss;
    __device__ __forceinline__ void operator()(const f32x4 (&acc)[2][2][4][2], const Unit& u, int wr, int wc, int fr, int fq) const {
        const int col0 = u.pn * BM + wc * 32 + 8 * fq;
        if (F32IN) {
#pragma unroll
            for (int ai = 0; ai < 2; ++ai) {
                f32x4 pre[4][2][2];
#pragma unroll
                for (int m = 0; m < 4; ++m)
#pragma unroll
                    for (int bj = 0; bj < 2; ++bj) { const size_t off = (size_t)(u.pm * BM + ai * HALF + wr * 64 + m * 16 + fr) * ROWLEN + col0 + bj * HALF; pre[m][bj][0] = *(const f32x4*)(xin + off); pre[m][bj][1] = *(const f32x4*)(xin + off + 4); }
#pragma unroll
                for (int m = 0; m < 4; ++m) {
                    const int row = u.pm * BM + ai * HALF + wr * 64 + m * 16 + fr;
                    float sq = 0.f;
#pragma unroll
                    for (int bj = 0; bj < 2; ++bj) {
                        const size_t off = (size_t)row * ROWLEN + col0 + bj * HALF;
                        const f32x4 v0 = pre[m][bj][0] + acc[ai][bj][m][0], v1 = pre[m][bj][1] + acc[ai][bj][m][1];
                        *(u32x4*)(xb + off) = pack8(v0, v1);
                        if (WANT_SS) sq += (v0[0] * v0[0] + v0[1] * v0[1]) + (v0[2] * v0[2] + v0[3] * v0[3]) + (v1[0] * v1[0] + v1[1] * v1[1]) + (v1[2] * v1[2] + v1[3] * v1[3]);
                    }
                    if (WANT_SS) { sq += __shfl_xor(sq, 16); sq += __shfl_xor(sq, 32); if (fq == 0) atomicAdd(ss + row, sq); }
                }
            }
        } else {
#pragma unroll
            for (int ai = 0; ai < 2; ++ai) {
                u32x4 pre[4][2];
#pragma unroll
                for (int m = 0; m < 4; ++m)
#pragma unroll
                    for (int bj = 0; bj < 2; ++bj) pre[m][bj] = *(const u32x4*)(xb + (size_t)(u.pm * BM + ai * HALF + wr * 64 + m * 16 + fr) * ROWLEN + col0 + bj * HALF);
#pragma unroll
                for (int m = 0; m < 4; ++m) {
                    const int row = u.pm * BM + ai * HALF + wr * 64 + m * 16 + fr;
                    float sq = 0.f;
#pragma unroll
                    for (int bj = 0; bj < 2; ++bj) {
                        const size_t off = (size_t)row * ROWLEN + col0 + bj * HALF;
                        const u32x4 p = pre[m][bj];
                        const f32x4 x0 = (f32x4){__uint_as_float(p.x << 16), __uint_as_float(p.x & 0xffff0000u), __uint_as_float(p.y << 16), __uint_as_float(p.y & 0xffff0000u)};
                        const f32x4 x1 = (f32x4){__uint_as_float(p.z << 16), __uint_as_float(p.z & 0xffff0000u), __uint_as_float(p.w << 16), __uint_as_float(p.w & 0xffff0000u)};
                        const f32x4 v0 = x0 + acc[ai][bj][m][0], v1 = x1 + acc[ai][bj][m][1];
                        *(u32x4*)(xb + off) = pack8(v0, v1);
                        if (WANT_SS) sq += (v0[0] * v0[0] + v0[1] * v0[1]) + (v0[2] * v0[2] + v0[3] * v0[3]) + (v1[0] * v1[0] + v1[1] * v1[1]) + (v1[2] * v1[2] + v1[3] * v1[3]);
                    }
                    if (WANT_SS) { sq += __shfl_xor(sq, 16); sq += __shfl_xor(sq, 32); if (fq == 0) atomicAdd(ss + row, sq); }
                }
            }
        }
    }
};

struct EpiSwiglu {
    static constexpr bool PERM = true, AFTER_DRAIN = false;
    bf16_t* Hh; int ldh; const float* ss;
    __device__ __forceinline__ void operator()(const f32x4 (&acc)[2][2][4][2], const Unit& u, int wr, int wc, int fr, int fq) const {
        const int col0 = u.pn * HALF + wc * 32 + 8 * fq;
        float rs[2][4];
#pragma unroll
        for (int ai = 0; ai < 2; ++ai)
#pragma unroll
            for (int m = 0; m < 4; ++m) rs[ai][m] = ss[u.pm * BM + ai * HALF + wr * 64 + m * 16 + fr];
#pragma unroll
        for (int ai = 0; ai < 2; ++ai)
#pragma unroll
            for (int m = 0; m < 4; ++m) {
                const int row = u.pm * BM + ai * HALF + wr * 64 + m * 16 + fr;
                const float r = __builtin_amdgcn_rsqf(rs[ai][m] * INV_D + RMS_EPS);
                f32x4 hv[2];
#pragma unroll
                for (int n = 0; n < 2; ++n) {
                    const f32x4 g = acc[ai][0][m][n] * r, uu = acc[ai][1][m][n] * r;
#pragma unroll
                    for (int e = 0; e < 4; ++e) hv[n][e] = g[e] * uu[e] * __builtin_amdgcn_rcpf(1.0f + __builtin_amdgcn_exp2f(g[e] * -1.4426950408889634f));
                }
                *(u32x4*)(Hh + (size_t)row * ldh + col0) = pack8(hv[0], hv[1]);
            }
    }
};

struct EpiConvIn {
    static constexpr bool PERM = true, AFTER_DRAIN = false;
    bf16_t* U; bf16_t* Bb; const float* ss;
    __device__ __forceinline__ void operator()(const f32x4 (&acc)[2][2][4][2], const Unit& u, int wr, int wc, int fr, int fq) const {
        float rs[2][4];
#pragma unroll
        for (int ai = 0; ai < 2; ++ai)
#pragma unroll
            for (int m = 0; m < 4; ++m) rs[ai][m] = ss[u.pm * BM + ai * HALF + wr * 64 + m * 16 + fr];
#pragma unroll
        for (int ai = 0; ai < 2; ++ai)
#pragma unroll
            for (int m = 0; m < 4; ++m) {
                const int row = u.pm * BM + ai * HALF + wr * 64 + m * 16 + fr;
                const float r = __builtin_amdgcn_rsqf(rs[ai][m] * INV_D + RMS_EPS);
                if (u.pn < 8) {
                    const float r2 = r * r;
                    const f32x4 a = acc[ai][0][m][0] * acc[ai][1][m][0] * r2, b = acc[ai][0][m][1] * acc[ai][1][m][1] * r2;
                    *(u32x4*)(U + (size_t)row * ROWLEN + u.pn * HALF + wc * 32 + 8 * fq) = pack8(a, b);
                } else {
#pragma unroll
                    for (int bj = 0; bj < 2; ++bj)
                        *(u32x4*)(Bb + (size_t)row * ROWLEN + (u.pn - 8) * BM + bj * HALF + wc * 32 + 8 * fq) = pack8(acc[ai][bj][m][0] * r, acc[ai][bj][m][1] * r);
                }
            }
    }
};

template <class Epi, class Sched, bool ALIGN_EPI = false, bool SP2 = false>
__device__ __forceinline__ void gemm_phase(PG8_LAS unsigned char* lds, const Gemm g, const Sched& S, const Epi& E) {
    int tid_ = threadIdx.x; asm volatile("" : "+v"(tid_));
    const int tid = tid_, wid = __builtin_amdgcn_readfirstlane(tid >> 6), lane = tid & 63, wr = wid >> 2, wc = wid & 3, fr = lane & 15, fq = lane >> 4;
    const int K = g.K, nt = K / BK;
    unsigned voffA[2], voffB[2];
#pragma unroll
    for (int i = 0; i < 2; ++i) { int R, C; stage_rc(tid * 16 + i * 8192, R, C); const int Rb = Epi::PERM ? ((R & ~31) + perm32(R & 31)) : R;
        voffA[i] = (unsigned)(R * K + C) * 2u; voffB[i] = (unsigned)(Rb * K + C) * 2u; }
    const size_t kstep = (size_t)(BK * 2);
    const size_t hstep = (size_t)HALF * K * 2;
    const size_t tstep = 2 * hstep;
    const unsigned ldsw = (unsigned)wid * 1024u;
    const int aoff = lds_byte(wr * 64 + fr, fq * 8), boff = lds_byte(wc * 32 + fr, fq * 8);
#define PG8_SA(b, h) (((b) * 2 + (h)) * HTB)
#define PG8_SB(b, h) ((4 + (b) * 2 + (h)) * HTB)
#define PG8_STAGE(bufoff, gbase, voff) do { _Pragma("unroll") for (int _i = 0; _i < 2; ++_i) \
        __builtin_amdgcn_global_load_lds((const unsigned*)((const char*)(gbase) + (voff)[_i]), (PG8_LAS unsigned*)(lds + (bufoff) + ldsw + _i * 8192), 16, 0, 0); } while (0)
#define PG8_LDA(dst, b, h) do { _Pragma("unroll") for (int m = 0; m < 4; ++m) _Pragma("unroll") for (int k = 0; k < 2; ++k) dst[m][k] = *(const PG8_LAS bf16x8*)(lds + PG8_SA(b, h) + aoff + m * 2048 + k * 1024); } while (0)
#define PG8_LDB(dst, b, h) do { _Pragma("unroll") for (int n = 0; n < 2; ++n) _Pragma("unroll") for (int k = 0; k < 2; ++k) dst[n][k] = *(const PG8_LAS bf16x8*)(lds + PG8_SB(b, h) + boff + n * 2048 + k * 1024); } while (0)
#define PG8_MMA(ai, bj, At, Bt) do { __builtin_amdgcn_s_setprio(1); _Pragma("unroll") for (int m = 0; m < 4; ++m) _Pragma("unroll") for (int n = 0; n < 2; ++n) _Pragma("unroll") for (int k = 0; k < 2; ++k) \
        acc[ai][bj][m][n] = __builtin_amdgcn_mfma_f32_16x16x32_bf16(Bt[n][k], At[m][k], acc[ai][bj][m][n], 0, 0, 0); __builtin_amdgcn_s_setprio(0); } while (0)
#define PG8_WAIT_V(n) asm volatile("s_waitcnt vmcnt(" #n ")" ::: "memory")
#define PG8_WAIT_L(n) asm volatile("s_waitcnt lgkmcnt(" #n ")" ::: "memory")
#define PG8_BAR __builtin_amdgcn_s_barrier()
#define PG8_SCHED __builtin_amdgcn_sched_barrier(0)
    Unit cur, nxt; int ui = 0;
    if (!S.next(0, cur)) return;
    f32x4 acc[2][2][4][2];
#pragma unroll
    for (int a = 0; a < 2; ++a)
#pragma unroll
        for (int b = 0; b < 2; ++b)
#pragma unroll
            for (int m = 0; m < 4; ++m)
#pragma unroll
                for (int n = 0; n < 2; ++n) acc[a][b][m][n] = (f32x4){0.f, 0.f, 0.f, 0.f};
    bf16x8 At[4][2], B0[2][2], B1[2][2];
    const char* cA = (const char*)g.A + (size_t)cur.pm * tstep; const char* cB = (const char*)g.Bt + (size_t)cur.pn * tstep;
    S.a_ready(cur);
    if constexpr (SP2) {
        PG8_STAGE(PG8_SB(0, 0), cB, voffB); PG8_STAGE(PG8_SB(0, 1), cB + hstep, voffB); PG8_STAGE(PG8_SA(0, 0), cA, voffA); PG8_STAGE(PG8_SA(0, 1), cA + hstep, voffA);
        if (wr == 1) PG8_BAR;
        PG8_WAIT_V(2); PG8_BAR;
        PG8_STAGE(PG8_SB(1, 0), cB + kstep, voffB); PG8_STAGE(PG8_SA(1, 0), cA + kstep, voffA); PG8_STAGE(PG8_SB(1, 1), cB + hstep + kstep, voffB);
        PG8_WAIT_V(6); PG8_BAR;
    } else {
        PG8_STAGE(PG8_SB(0, 0), cB, voffB); PG8_STAGE(PG8_SA(0, 0), cA, voffA); PG8_STAGE(PG8_SB(0, 1), cB + hstep, voffB); PG8_STAGE(PG8_SA(0, 1), cA + hstep, voffA);
        if (wr == 1) PG8_BAR;
        PG8_WAIT_V(4); PG8_BAR;
        PG8_STAGE(PG8_SB(1, 0), cB + kstep, voffB); PG8_STAGE(PG8_SA(1, 0), cA + kstep, voffA); PG8_STAGE(PG8_SB(1, 1), cB + hstep + kstep, voffB);
        PG8_WAIT_V(6); PG8_BAR;
    }
    for (;;) {
        const bool has_next = S.next(ui + 1, nxt);
        const char* nA = has_next ? (const char*)g.A + (size_t)nxt.pm * tstep : cA; const char* nB = has_next ? (const char*)g.Bt + (size_t)nxt.pn * tstep : cB;
        for (int t = 0; t < nt; t += 2) {
            const bool last = (t == nt - 2);
            const char* a1 = cA + (size_t)(t + 1) * kstep;
            const char* a2 = last ? nA : cA + (size_t)(t + 2) * kstep; const char* b2 = last ? nB : cB + (size_t)(t + 2) * kstep;
            const char* a3 = a2 + kstep; const char* b3 = b2 + kstep;
            if (last && has_next) S.a_ready(nxt);
            if constexpr (SP2) {
            PG8_LDB(B0, 0, 0); PG8_LDB(B1, 0, 1); PG8_SCHED; PG8_LDA(At, 0, 0); PG8_STAGE(PG8_SA(1, 1), a1 + hstep, voffA);
            PG8_WAIT_V(8); PG8_WAIT_L(0); PG8_BAR; PG8_MMA(0, 0, At, B0); PG8_MMA(0, 1, At, B1); PG8_BAR; PG8_SCHED;
            PG8_LDA(At, 0, 1); PG8_STAGE(PG8_SB(0, 0), b2, voffB); PG8_STAGE(PG8_SB(0, 1), b2 + hstep, voffB); PG8_STAGE(PG8_SA(0, 0), a2, voffA);
            PG8_WAIT_V(8); PG8_WAIT_L(0); PG8_BAR; PG8_MMA(1, 0, At, B0); PG8_MMA(1, 1, At, B1); PG8_BAR; PG8_SCHED;
            PG8_LDB(B0, 1, 0); PG8_LDB(B1, 1, 1); PG8_SCHED; PG8_LDA(At, 1, 0); PG8_STAGE(PG8_SA(0, 1), a2 + hstep, voffA);
            PG8_WAIT_V(8); PG8_WAIT_L(0); PG8_BAR; PG8_MMA(0, 0, At, B0); PG8_MMA(0, 1, At, B1); PG8_BAR; PG8_SCHED;
            PG8_LDA(At, 1, 1); PG8_STAGE(PG8_SB(1, 0), b3, voffB); PG8_STAGE(PG8_SB(1, 1), b3 + hstep, voffB); PG8_STAGE(PG8_SA(1, 0), a3, voffA);
            PG8_WAIT_V(8); PG8_WAIT_L(0); PG8_BAR; PG8_MMA(1, 0, At, B0); PG8_MMA(1, 1, At, B1); PG8_BAR; PG8_SCHED;
            } else {
            PG8_LDB(B0, 0, 0); PG8_SCHED; PG8_LDA(At, 0, 0); PG8_STAGE(PG8_SA(1, 1), a1 + hstep, voffA);
            PG8_WAIT_L(8); PG8_BAR; PG8_WAIT_L(0); PG8_MMA(0, 0, At, B0); PG8_BAR; PG8_SCHED;
            PG8_LDB(B1, 0, 1); PG8_STAGE(PG8_SB(0, 0), b2, voffB);
            PG8_BAR; PG8_WAIT_L(0); PG8_MMA(0, 1, At, B1); PG8_BAR;
            PG8_LDA(At, 0, 1); PG8_STAGE(PG8_SA(0, 0), a2, voffA);
            PG8_BAR; PG8_WAIT_L(0); PG8_MMA(1, 0, At, B0); PG8_BAR; PG8_SCHED;
            PG8_STAGE(PG8_SB(0, 1), b2 + hstep, voffB);
            PG8_WAIT_V(6); PG8_BAR; PG8_MMA(1, 1, At, B1); PG8_BAR;
            PG8_LDB(B0, 1, 0); PG8_SCHED; PG8_LDA(At, 1, 0); PG8_STAGE(PG8_SA(0, 1), a2 + hstep, voffA);
            PG8_WAIT_L(8); PG8_BAR; PG8_WAIT_L(0); PG8_MMA(0, 0, At, B0); PG8_BAR; PG8_SCHED;
            PG8_LDB(B1, 1, 1); PG8_STAGE(PG8_SB(1, 0), b3, voffB);
            PG8_BAR; PG8_WAIT_L(0); PG8_MMA(0, 1, At, B1); PG8_BAR;
            PG8_LDA(At, 1, 1); PG8_STAGE(PG8_SA(1, 0), a3, voffA);
            PG8_BAR; PG8_WAIT_L(0); PG8_MMA(1, 0, At, B0); PG8_BAR; PG8_SCHED;
            PG8_STAGE(PG8_SB(1, 1), b3 + hstep, voffB);
            PG8_WAIT_V(6); PG8_BAR; PG8_MMA(1, 1, At, B1); PG8_BAR;
            }
        }
        if constexpr (ALIGN_EPI) { if (wr == 0) PG8_BAR; }
        if constexpr (!Epi::AFTER_DRAIN) { E(acc, cur, wr, wc, fr, fq); S.done(cur); }
        if (!has_next) break;
#pragma unroll
        for (int a = 0; a < 2; ++a)
#pragma unroll
            for (int b = 0; b < 2; ++b)
#pragma unroll
                for (int m = 0; m < 4; ++m)
#pragma unroll
                    for (int n = 0; n < 2; ++n) acc[a][b][m][n] = (f32x4){0.f, 0.f, 0.f, 0.f};
        cur = nxt; cA = nA; cB = nB; ++ui;
        if constexpr (ALIGN_EPI) { if (wr == 1) PG8_BAR; }
    }
    PG8_WAIT_V(0);
    if constexpr (!ALIGN_EPI) { if (wr == 0) PG8_BAR; }
    PG8_BAR;
    if constexpr (Epi::AFTER_DRAIN) { E.fused(acc, cur, wr, wc, fr, fq, lds, wid, lane); S.done(cur); }
#undef PG8_SA
#undef PG8_SB
#undef PG8_STAGE
#undef PG8_LDA
#undef PG8_LDB
#undef PG8_MMA
#undef PG8_WAIT_V
#undef PG8_WAIT_L
#undef PG8_BAR
#undef PG8_SCHED
}
}

#ifndef PG8_SP2
#define PG8_SP2 true
#endif
#ifndef PG8_ALIGN
#define PG8_ALIGN true
#endif
#define GAS __attribute__((address_space(1)))
#define LAS __attribute__((address_space(3)))
typedef unsigned short bf16;
typedef unsigned v4u __attribute__((ext_vector_type(4)));
typedef float f32x4 __attribute__((ext_vector_type(4)));
typedef short bf16x8 __attribute__((ext_vector_type(8)));
typedef GAS unsigned gu32;
typedef GAS unsigned long long gu64;
#define RLX_AGENT __ATOMIC_RELAXED, __HIP_MEMORY_SCOPE_AGENT
#define LDS_WAIT() asm volatile("s_waitcnt lgkmcnt(0)" ::: "memory")
#define VM_WAIT() asm volatile("s_waitcnt vmcnt(0)" ::: "memory")
__device__ __forceinline__ unsigned long long rt() { return __builtin_amdgcn_s_memrealtime(); }

#define XB_TMO      128
#define XB_XCNT(j)  (256  + 64 * (j))
#define XB_XSUB(j)  (1280 + 64 * (j))
#define XB_XGEN(j)  (2304 + 64 * (j))
#define XB_TOP      3328
#define XB_TOPGEN   3392
#define XCD_BAR_WORDS 3456
#define XB_SPIN_CAP (1u << 18)

__device__ __forceinline__ unsigned xb_ld(unsigned* p)              { return __hip_atomic_load(p, __ATOMIC_RELAXED, __HIP_MEMORY_SCOPE_AGENT); }
__device__ __forceinline__ unsigned xb_add(unsigned* p, unsigned v) { return __hip_atomic_fetch_add(p, v, __ATOMIC_RELAXED, __HIP_MEMORY_SCOPE_AGENT); }
__device__ __forceinline__ unsigned xb_xcc_id() { return (unsigned)__builtin_amdgcn_s_getreg((3 << 11) | 20) & 0xFu; }
#define XB_SPIN(cond, bar) do { unsigned _sp = 0; while (cond) { __builtin_amdgcn_s_sleep(1); \
    if ((++_sp & 255u) == 0u) { if (xb_ld(&(bar)[XB_TMO])) break; if (_sp > XB_SPIN_CAP) { atomicAdd(&(bar)[XB_TMO], 1u); break; } } } } while (0)

struct XcdBarrier {
    unsigned* bar; unsigned x;
    volatile LAS unsigned* st;
};

__device__ __forceinline__ XcdBarrier xcd_barrier_post(unsigned* bar, volatile LAS unsigned* st) {
    XcdBarrier b; b.bar = bar; b.x = xb_xcc_id(); b.st = st;
    if (threadIdx.x == 0) (void)xb_add(&bar[XB_XCNT(b.x)], 1u);
    return b;
}
__device__ __forceinline__ void xcd_barrier_complete(unsigned* bar, unsigned x, unsigned& nloc, unsigned& nx) {
    const unsigned G = gridDim.x * gridDim.y * gridDim.z;
    unsigned sum, cnt, mine, sp = 0u;
    for (;;) {
        sum = 0u; cnt = 0u; mine = 0u;
#pragma unroll
        for (unsigned j = 0; j < 16; ++j) { const unsigned c = xb_ld(&bar[XB_XCNT(j)]); sum += c; cnt += (c > 0u) ? 1u : 0u; mine = (j == x) ? c : mine; }
        if (sum == G) break;
        __builtin_amdgcn_s_sleep(1);
        if ((++sp & 255u) == 0u) { if (xb_ld(&bar[XB_TMO])) break; if (sp > XB_SPIN_CAP) { atomicAdd(&bar[XB_TMO], 1u); break; } }
    }
    nloc = mine > 0u ? mine : 1u; nx = cnt > 0u ? cnt : 1u;
}

__device__ __forceinline__ void xcd_barrier(const XcdBarrier& b) {
    asm volatile("s_waitcnt vmcnt(0)" ::: "memory");
    __syncthreads();
    if (threadIdx.x == 0) {
        unsigned* bar = b.bar;
        __builtin_amdgcn_s_waitcnt(0);
        unsigned nloc = b.st[0], nx = b.st[1];
        if (nloc == 0u) { xcd_barrier_complete(bar, b.x, nloc, nx); b.st[0] = nloc; b.st[1] = nx; }
        const unsigned old = xb_add(&bar[XB_XSUB(b.x)], 1u);
        const unsigned gen = old / nloc;
        if (old + 1u == (gen + 1u) * nloc) {
            __builtin_amdgcn_fence(__ATOMIC_RELEASE, "agent");
            asm volatile("s_waitcnt vmcnt(0)" ::: "memory");
            const unsigned og = xb_add(&bar[XB_TOP], 1u);
            const unsigned tg = og / nx;
            if (og + 1u == (tg + 1u) * nx) xb_add(&bar[XB_TOPGEN], 1u);
            else XB_SPIN(xb_ld(&bar[XB_TOPGEN]) == tg, bar);
            __builtin_amdgcn_fence(__ATOMIC_ACQUIRE, "agent");
            xb_add(&bar[XB_XGEN(b.x)], 1u);
            asm volatile("s_waitcnt vmcnt(0)" ::: "memory");
        } else {
            XB_SPIN(xb_ld(&bar[XB_XGEN(b.x)]) == gen, bar);
            __builtin_amdgcn_fence(__ATOMIC_ACQUIRE, "agent");
            asm volatile("s_waitcnt vmcnt(0)" ::: "memory");
        }
    }
    __syncthreads();
}

constexpr int NWAVES = 8;
constexpr int BATCH = 4, SEQ = 8192, DM = 1024, NH = 8, HD = 128, FF = 2816, MROWS = BATCH * SEQ;
constexpr int BS = 256, NBLK = SEQ / BS;
constexpr float QSCALE = 0.08838834764831845f * 1.4426950408889634f;
constexpr float EPS = 1e-6f;

constexpr size_t MiB = 1u << 20;
constexpr size_t WS_CTL = 0, CTL_ZERO_BYTES = 1 * MiB;
constexpr size_t WS_KSUM = 1 * MiB;
constexpr size_t WS_SS = 1 * MiB + 512 * 1024;
constexpr size_t WS_SS0 = 2 * MiB;
constexpr size_t WS_WQKV = 4 * MiB, WS_WO = 10 * MiB, WS_WF1 = 12 * MiB  , WS_WF2 = 34 * MiB  , WS_WCI = 45 * MiB, WS_WCO = 51 * MiB;
constexpr size_t WS_Q = 56 * MiB, WS_K = 120 * MiB, WS_V = 184 * MiB;
constexpr size_t WS_XB = 248 * MiB;
constexpr size_t WS_H = 312 * MiB;
constexpr size_t WS_END = 504 * MiB;
static_assert(WS_H + (size_t)MROWS * FF * 2 <= WS_END, "ws map");
constexpr int CW_TMO = 0, CW_CODE = 1, CW_BAR = 4096;

constexpr int RING_OFF = 0, RING_BYTES = 131072;
constexpr int LDSCTL_OFF = RING_BYTES, MISC_OFF = LDSCTL_OFF + 320;
constexpr int LDS_BYTES = 147456;

__device__ __forceinline__ float wave_sum(float v) {
#pragma unroll
    for (int o = 1; o < 64; o <<= 1) v += __shfl_xor(v, o);
    return v;
}
__device__ __forceinline__ float bf_lo(unsigned w) { return __uint_as_float(w << 16); }
__device__ __forceinline__ float bf_hi(unsigned w) { return __uint_as_float(w & 0xffff0000u); }
__device__ __forceinline__ unsigned pk2(float lo, float hi) { return pg8::cvt_pk_bf16(lo, hi); }

__device__ __forceinline__ void p0_item(const float* W, int N, int K, int k0, int n_src0, bf16* WT, int n_dst0, const float* gain, LAS unsigned char* scr, int lane) {
    const int lq = lane >> 4, ln = lane & 15;
    const float gv = gain ? gain[k0 + lane] : 1.0f;
    f32x4 v[16];
    const float* src = W + (size_t)(k0 + 2 * lq) * N + n_src0 + 4 * ln;
#pragma unroll
    for (int i = 0; i < 16; ++i) v[i] = *(const f32x4*)(src + (size_t)(8 * (i >> 1) + (i & 1)) * N);
#pragma unroll
    for (int p = 0; p < 8; ++p) {
        const float g0 = __shfl(gv, 8 * p + 2 * lq), g1 = __shfl(gv, 8 * p + 2 * lq + 1);
#pragma unroll
        for (int e = 0; e < 4; ++e) *(LAS unsigned*)(scr + (4 * ln + e) * 144 + (8 * p + 2 * lq) * 2) = pk2(v[2 * p][e] * g0, v[2 * p + 1][e] * g1);
    }
    LDS_WAIT(); asm volatile("" ::: "memory");
#pragma unroll
    for (int r = 0; r < 8; ++r) { const int row = 8 * r + (lane >> 3), c = lane & 7;
        const v4u o = *(const LAS v4u*)(scr + row * 144 + c * 16);
        *(v4u*)(WT + (size_t)(n_dst0 + row) * K + k0 + 8 * c) = o; }
    LDS_WAIT(); asm volatile("" ::: "memory");
}
__device__ __forceinline__ int interleave128(int n, int half_cols) { const int hsel = n >= half_cols ? 1 : 0, nn = n - hsel * half_cols; return 256 * (nn >> 7) + 128 * hsel + (nn & 127); }

struct Args { const float* in[12]; float* out; unsigned char* ws; };

__device__ __forceinline__ void naive_attn_item(bf16* Q, const bf16* Kb, const bf16* Vb, const float* ksum, int m, int h, int lane) {
    const int t = m & (SEQ - 1), b = m / SEQ, ib = t / BS;
    const size_t qoff = (size_t)m * DM + h * HD + 2 * lane;
    const unsigned qq = *(const unsigned*)(Q + qoff); const float q0 = bf_lo(qq), q1 = bf_hi(qq);
    int s0 = -1, s1 = -1, s2 = -1; float g0 = -3.0e38f, g1 = -3.0e38f, g2 = -3.0e38f;
    for (int j = 0; j < ib; ++j) {
        const float2 km = *(const float2*)(ksum + (size_t)(b * NBLK + j) * DM + h * HD + 2 * lane);
        const float g = wave_sum(q0 * km.x + q1 * km.y);
        if (g > g0) { g2 = g1; s2 = s1; g1 = g0; s1 = s0; g0 = g; s0 = j; }
        else if (g > g1) { g2 = g1; s2 = s1; g1 = g; s1 = j; }
        else if (g > g2) { g2 = g; s2 = j; }
    }
    float mr = -1.0e30f, l = 0.f, o0 = 0.f, o1 = 0.f;
    for (int sidx = 0; sidx < 4; ++sidx) {
        const int blk = sidx == 0 ? s0 : sidx == 1 ? s1 : sidx == 2 ? s2 : ib;
        if (blk < 0) continue;
        const int nk = (sidx == 3) ? (t & (BS - 1)) + 1 : BS;
        const size_t rbase = ((size_t)b * SEQ + (size_t)blk * BS) * DM + h * HD + 2 * lane;
        for (int k0 = 0; k0 < nk; k0 += 4) {
            float d[4]; unsigned vv[4];
#pragma unroll
            for (int u = 0; u < 4; ++u) { const unsigned kk = *(const unsigned*)(Kb + rbase + (size_t)(k0 + u) * DM); vv[u] = *(const unsigned*)(Vb + rbase + (size_t)(k0 + u) * DM); d[u] = q0 * bf_lo(kk) + q1 * bf_hi(kk); }
#pragma unroll
            for (int o = 1; o < 64; o <<= 1) {
#pragma unroll
                for (int u = 0; u < 4; ++u) d[u] += __shfl_xor(d[u], o);
            }
#pragma unroll
            for (int u = 0; u < 4; ++u) if (k0 + u >= nk) d[u] = -1.0e30f;
            const float mn = fmaxf(fmaxf(mr, fmaxf(d[0], d[1])), fmaxf(d[2], d[3]));
            const float a = __builtin_amdgcn_exp2f(mr - mn); l *= a; o0 *= a; o1 *= a; mr = mn;
#pragma unroll
            for (int u = 0; u < 4; ++u) { const float p = __builtin_amdgcn_exp2f(d[u] - mn); l += p; o0 += p * bf_lo(vv[u]); o1 += p * bf_hi(vv[u]); }
        }
    }
    const float il = 1.0f / l;
    *(unsigned*)(Q + qoff) = pk2(o0 * il, o1 * il);
}


typedef float f32x16 __attribute__((ext_vector_type(16)));
typedef short v4i16_t __attribute__((ext_vector_type(4)));
#define MFMA32(a, b, c) __builtin_amdgcn_mfma_f32_32x32x16_bf16((a), (b), (c), 0, 0, 0)
__device__ __forceinline__ int crow(int r, int hi) { return (r & 3) + 8 * (r >> 2) + 4 * hi; }
constexpr int CW_QUEUE = 8192, CW_CNT = 12288;
constexpr int LIST_PER_BH = 256 * 496;
__device__ __forceinline__ int list_off(int j) { return 256 * (31 * j - (j * (j - 1)) / 2); }
constexpr size_t OUT_LSE_OFF = 0, OUT_LIST_OFF = 2u << 20;
constexpr float NEG_BIG = -1.0e30f;
#define GT_(va, ia, vb, ib_) ((va) > (vb) || ((va) == (vb) && (ia) < (ib_)))
#define TOP3_INSERT(v, i) do { const float v_ = (v); const int i_ = (i); \
    if (GT_(v_, i_, v0, i0)) { v2 = v1; i2 = i1; v1 = v0; i1 = i0; v0 = v_; i0 = i_; } \
    else if (GT_(v_, i_, v1, i1)) { v2 = v1; i2 = i1; v1 = v_; i1 = i_; } \
    else if (GT_(v_, i_, v2, i2)) { v2 = v_; i2 = i_; } } while (0)

__device__ __forceinline__ void gate_unit(int b, int ib, int hd, const bf16* Qb, const float* ksum, gu32* gcount, unsigned* lists, LAS unsigned char* lds, int tid, int lane, int wave) {
    const int r32 = lane & 31, hi = lane >> 5, bh = b * NH + hd;
    const int t = ib * BS + wave * 32 + r32;
    LAS unsigned* cnt = (LAS unsigned*)lds; LAS unsigned* basel = cnt + 32;
    if (tid < 32) cnt[tid] = 0u;
    f32x16 acc;
#pragma unroll
    for (int i = 0; i < 16; ++i) acc[i] = 0.f;
    const bf16* qp = Qb + ((size_t)b * SEQ + t) * DM + hd * HD + 8 * hi;
    const float* kp = ksum + (size_t)(b * NBLK + r32) * DM + hd * HD + 8 * hi;
#pragma unroll
    for (int s = 0; s < 8; ++s) {
        const bf16x8 qf = *(const bf16x8*)(qp + 16 * s);
        const f32x4 k0 = *(const f32x4*)(kp + 16 * s), k1 = *(const f32x4*)(kp + 16 * s + 4);
        v4u wh, wl;
        wh.x = pk2(k0[0], k0[1]); wh.y = pk2(k0[2], k0[3]); wh.z = pk2(k1[0], k1[1]); wh.w = pk2(k1[2], k1[3]);
        wl.x = pk2(k0[0] - bf_lo(wh.x), k0[1] - bf_hi(wh.x)); wl.y = pk2(k0[2] - bf_lo(wh.y), k0[3] - bf_hi(wh.y));
        wl.z = pk2(k1[0] - bf_lo(wh.z), k1[1] - bf_hi(wh.z)); wl.w = pk2(k1[2] - bf_lo(wh.w), k1[3] - bf_hi(wh.w));
        acc = MFMA32(__builtin_bit_cast(bf16x8, wh), qf, acc);
        acc = MFMA32(__builtin_bit_cast(bf16x8, wl), qf, acc);
    }
    float v0 = -3.0e38f, v1 = -3.0e38f, v2 = -3.0e38f; int i0 = 99, i1 = 99, i2 = 99;
#pragma unroll
    for (int i = 0; i < 16; ++i) { const int blk = crow(i, hi); const float g = blk < ib ? acc[i] : -3.0e38f; TOP3_INSERT(g, blk); }
    { const float p0 = __shfl_xor(v0, 32), p1 = __shfl_xor(v1, 32), p2 = __shfl_xor(v2, 32); const int q0 = __shfl_xor(i0, 32), q1 = __shfl_xor(i1, 32), q2 = __shfl_xor(i2, 32);
      TOP3_INSERT(p0, q0); TOP3_INSERT(p1, q1); TOP3_INSERT(p2, q2); }
    const bool ok0 = hi == 0 && v0 > -1.0e38f, ok1 = hi == 0 && v1 > -1.0e38f, ok2 = hi == 0 && v2 > -1.0e38f;
    __syncthreads();
    unsigned r0 = 0, r1 = 0, r2 = 0;
    if (ok0) r0 = __hip_atomic_fetch_add(cnt + i0, 1u, __ATOMIC_RELAXED, __HIP_MEMORY_SCOPE_WORKGROUP);
    if (ok1) r1 = __hip_atomic_fetch_add(cnt + i1, 1u, __ATOMIC_RELAXED, __HIP_MEMORY_SCOPE_WORKGROUP);
    if (ok2) r2 = __hip_atomic_fetch_add(cnt + i2, 1u, __ATOMIC_RELAXED, __HIP_MEMORY_SCOPE_WORKGROUP);
    __syncthreads();
    if (tid < 32) { const unsigned c = cnt[tid]; basel[tid] = c ? __hip_atomic_fetch_add(gcount + bh * 32 + tid, c, RLX_AGENT) : 0u; }
    __syncthreads();
    unsigned* lb = lists + (size_t)bh * LIST_PER_BH;
    if (ok0) lb[list_off(i0) + basel[i0] + r0] = (unsigned)t;
    if (ok1) lb[list_off(i1) + basel[i1] + r1] = (unsigned)t | (1u << 13);
    if (ok2) lb[list_off(i2) + basel[i2] + r2] = (unsigned)t | (2u << 13);
    __syncthreads();
}

__device__ __forceinline__ void attn_wave_item(LAS unsigned char* Kimg, LAS unsigned char* Vimg, const bf16* Qb, bf16* Opart, float* lse, size_t mrow, int hd, int slot, bool valid, int kmax, bool own, int lane) {
    const int r32 = lane & 31, hi = lane >> 5;
    const bf16* qp = Qb + mrow * DM + hd * HD + 8 * hi;
    bf16x8 qf[8];
#pragma unroll
    for (int s = 0; s < 8; ++s) qf[s] = *(const bf16x8*)(qp + 16 * s);
    const int xr = ((r32 & 3) << 2) | ((r32 >> 2) & 3);
    const LAS unsigned char* kb = Kimg + 256 * r32;
    f32x16 S[8];
#pragma unroll
    for (int kt = 0; kt < 8; ++kt) {
        if (kt <= kmax) {
            f32x16 a;
#pragma unroll
            for (int i = 0; i < 16; ++i) a[i] = 0.f;
#pragma unroll
            for (int s = 0; s < 8; ++s) { const bf16x8 kf = *(const LAS bf16x8*)(kb + 16 * ((2 * s + hi) ^ xr) + 8192 * kt); a = MFMA32(kf, qf[s], a); }
            if (own && kt == kmax) {
#pragma unroll
                for (int i = 0; i < 16; ++i) if (crow(i, hi) > r32) a[i] = NEG_BIG;
            }
            S[kt] = a;
        } else {
#pragma unroll
            for (int i = 0; i < 16; ++i) S[kt][i] = NEG_BIG;
        }
    }
    float mx = NEG_BIG;
#pragma unroll
    for (int kt = 0; kt < 8; ++kt)
#pragma unroll
        for (int i = 0; i < 16; ++i) mx = fmaxf(mx, S[kt][i]);
    mx = fmaxf(mx, __shfl_xor(mx, 32));
    float lsum = 0.f; v4u pw[8][2];
#pragma unroll
    for (int kt = 0; kt < 8; ++kt) {
        float p[16];
#pragma unroll
        for (int i = 0; i < 16; ++i) { p[i] = __builtin_amdgcn_exp2f(S[kt][i] - mx); lsum += p[i]; }
#pragma unroll
        for (int s2 = 0; s2 < 2; ++s2) { pw[kt][s2].x = pk2(p[8 * s2], p[8 * s2 + 1]); pw[kt][s2].y = pk2(p[8 * s2 + 2], p[8 * s2 + 3]); pw[kt][s2].z = pk2(p[8 * s2 + 4], p[8 * s2 + 5]); pw[kt][s2].w = pk2(p[8 * s2 + 6], p[8 * s2 + 7]); }
    }
    lsum += __shfl_xor(lsum, 32);
    const int blk = (lane >> 4) & 1, q4 = (lane & 15) >> 2, p4 = lane & 3;
    int vb[2][4];
#pragma unroll
    for (int t = 0; t < 2; ++t)
#pragma unroll
        for (int c4 = 0; c4 < 4; ++c4) vb[t][c4] = 256 * (8 * t + 4 * hi + q4) + 64 * (c4 ^ q4) + 16 * ((2 * blk + (p4 >> 1)) ^ ((2 * t + hi) & 3)) + 8 * (p4 & 1);
    f32x16 O[4];
#pragma unroll
    for (int c4 = 0; c4 < 4; ++c4)
#pragma unroll
        for (int i = 0; i < 16; ++i) O[c4][i] = 0.f;
#pragma unroll
    for (int kt = 0; kt < 8; ++kt) {
        if (kt <= kmax) {
#pragma unroll
            for (int s2 = 0; s2 < 2; ++s2) {
                const bf16x8 pf = __builtin_bit_cast(bf16x8, pw[kt][s2]);
#pragma unroll
                for (int c4 = 0; c4 < 4; ++c4) {
                    const v4i16_t lo = __builtin_amdgcn_ds_read_tr16_b64_v4i16((LAS v4i16_t*)(Vimg + vb[0][c4] + 8192 * kt + 4096 * s2));
                    const v4i16_t hh = __builtin_amdgcn_ds_read_tr16_b64_v4i16((LAS v4i16_t*)(Vimg + vb[1][c4] + 8192 * kt + 4096 * s2));
                    const bf16x8 vf = (bf16x8){lo[0], lo[1], lo[2], lo[3], hh[0], hh[1], hh[2], hh[3]};
                    O[c4] = MFMA32(vf, pf, O[c4]);
                }
            }
        }
    }
    if (valid) {
        const float il = 1.0f / lsum;
        const size_t rec = (mrow * NH + hd) * 4 + slot;
        bf16* op = Opart + rec * HD + 4 * hi;
#pragma unroll
        for (int c4 = 0; c4 < 4; ++c4)
#pragma unroll
            for (int g = 0; g < 4; ++g) {
                uint2 w; w.x = pk2(O[c4][4 * g] * il, O[c4][4 * g + 1] * il); w.y = pk2(O[c4][4 * g + 2] * il, O[c4][4 * g + 3] * il);
                *(uint2*)(op + 32 * c4 + 8 * g) = w;
            }
        if (hi == 0) lse[rec] = mx + __builtin_log2f(lsum);
    }
}

__device__ __forceinline__ void attn_phase(LAS unsigned char* lds, volatile LAS unsigned* qslot, gu32* ctl, const bf16* Qb, const bf16* Kb, const bf16* Vb, bf16* Opart, float* lse, const unsigned* lists, int tid, int lane, int wave) {
    LAS unsigned char* Kimg = lds; LAS unsigned char* Vimg = lds + 65536;
    for (;;) {
        if (tid == 0) *qslot = __hip_atomic_fetch_add(ctl + CW_QUEUE, 1u, RLX_AGENT);
        __syncthreads();
        const int it = (int)*qslot;
        if (it >= NBLK * BATCH * NH) break;
        const int j = it >> 5, bh = it & 31, b = bh >> 3, hd = bh & 7;
        const size_t kvrow0 = (size_t)b * SEQ + (size_t)j * BS;
#pragma unroll
        for (int i = 0; i < 8; ++i) {
            const int pc = i * 8 + wave, row = 4 * pc + (lane >> 4), ch = (lane & 15) ^ (((lane >> 4) << 2) | (pc & 3));
            const size_t src = (kvrow0 + row) * DM + hd * HD + ch * 8;
            __builtin_amdgcn_global_load_lds((const unsigned*)(Kb + src), (LAS unsigned*)(Kimg + pc * 1024), 16, 0, 0);
            __builtin_amdgcn_global_load_lds((const unsigned*)(Vb + src), (LAS unsigned*)(Vimg + pc * 1024), 16, 0, 0);
        }
        const int n = (int)__hip_atomic_load(ctl + CW_CNT + bh * 32 + j, RLX_AGENT);
        const unsigned* lb = lists + (size_t)bh * LIST_PER_BH + list_off(j);
        asm volatile("s_waitcnt vmcnt(0)" ::: "memory");
        __syncthreads();
        const int nch = 8 + ((n + 31) >> 5);
        for (int c = wave; c < nch; c += NWAVES) {
            int tq, slot, kmax; bool valid, own;
            if (c < 8) { tq = j * BS + c * 32 + (lane & 31); slot = 3; valid = true; kmax = c; own = true; }
            else { const int e = (c - 8) * 32 + (lane & 31); valid = e < n; const unsigned ent = valid ? lb[e] : (unsigned)(j * BS); tq = (int)(ent & 8191u); slot = (int)(ent >> 13); kmax = 7; own = false; }
            attn_wave_item(Kimg, Vimg, Qb, Opart, lse, (size_t)b * SEQ + tq, hd, slot, valid, kmax, own, lane);
        }
        __syncthreads();
    }
}


typedef const __attribute__((address_space(4))) Args* KArgs;
__device__ __forceinline__ KArgs get_args() { const __attribute__((address_space(4))) void* p = (const __attribute__((address_space(4))) void*)__builtin_amdgcn_kernarg_segment_ptr(); asm volatile("" : "+s"(p)); return (KArgs)p; }
#define GRID_BAR() do { XcdBarrier b_; b_.bar = (unsigned*)(get_args()->ws + WS_CTL) + CW_BAR; b_.x = xb_xcc_id(); b_.st = MISC + 8; xcd_barrier(b_); if (PROBE_MASK_V & (1u << 14)) xcd_barrier(b_); } while (0)

#ifndef PROBE_MASK_V
#define PROBE_MASK_V 0u
#endif
constexpr unsigned PROBE_MASK = PROBE_MASK_V;
#define PH_BEGIN() const unsigned long long t0_ = PROBE_MASK ? __builtin_amdgcn_s_memrealtime() : 0ull
#define PH_END(p) do { if (PROBE_MASK & (1u << (p))) { const unsigned long long t1_ = __builtin_amdgcn_s_memrealtime(); while (__builtin_amdgcn_s_memrealtime() - t1_ < t1_ - t0_) __builtin_amdgcn_s_sleep(8); } } while (0)
#define WSP(T, off) ((T*)(ws + (off)))
__global__ void __launch_bounds__(NWAVES * 64, 2) moba_fwd(Args args_unused) {
    extern __shared__ __attribute__((aligned(16))) unsigned char lds_raw[];
    LAS unsigned char* lds = (LAS unsigned char*)lds_raw;
    volatile LAS unsigned* MISC = (volatile LAS unsigned*)(lds + MISC_OFF);
    const int tid = threadIdx.x, lane = tid & 63, wave = __builtin_amdgcn_readfirstlane(tid >> 6);
    const int G = gridDim.x; const int bx = blockIdx.x; const int vcu = (G % 8 == 0) ? (bx % 8) * (G / 8) + bx / 8 : bx;
    for (int u = tid; u < (LDS_BYTES - LDSCTL_OFF) / 4; u += NWAVES * 64) ((LAS unsigned*)(lds + LDSCTL_OFF))[u] = 0u;
    __syncthreads();
    (void)xcd_barrier_post((unsigned*)(get_args()->ws + WS_CTL) + CW_BAR, MISC + 8);
    const int gw = vcu * NWAVES + wave, NGW = G * NWAVES;
    const int gt = vcu * NWAVES * 64 + tid, NGT = G * NWAVES * 64;

    {
        PH_BEGIN();
        KArgs A = get_args(); unsigned char* ws = A->ws;
        const float* x = A->in[0]; const float* attn_norm = A->in[1]; const float* w_qkv = A->in[2]; const float* w_o = A->in[3];
        const float* conv_norm = A->in[4]; const float* w_ci = A->in[5]; const float* w_co = A->in[7];
        const float* ffn_norm = A->in[8]; const float* w_f1 = A->in[9]; const float* w_f2 = A->in[10];
        bf16* Wqkv_t = WSP(bf16, WS_WQKV); bf16* Wo_t = WSP(bf16, WS_WO); bf16* Wf1_t = WSP(bf16, WS_WF1); bf16* Wf2_t = WSP(bf16, WS_WF2); bf16* Wci_t = WSP(bf16, WS_WCI); bf16* Wco_t = WSP(bf16, WS_WCO);
        bf16* XB = WSP(bf16, WS_XB); float* ss0 = WSP(float, WS_SS0);
        LAS unsigned char* scr = lds + RING_OFF + wave * 16384;
        constexpr int I_QKV = (DM / 64) * (3 * DM / 64), I_O = (DM / 64) * (DM / 64), I_F1 = (DM / 64) * (2 * FF / 64), I_F2 = (FF / 64) * (DM / 64);
        constexpr int NITEMS = I_QKV + I_O + 2 * I_F1 + 2 * I_F2 + I_QKV + I_O;
        for (int it = gw; it < NITEMS; it += NGW) {
            int r = it;
            if (r < I_QKV) { const int nb = 3 * DM / 64, k0 = 64 * (r / nb), n0 = 64 * (r % nb); p0_item(w_qkv, 3 * DM, DM, k0, n0, Wqkv_t, n0, attn_norm, scr, lane); continue; } r -= I_QKV;
            if (r < I_O) { const int nb = DM / 64, k0 = 64 * (r / nb), n0 = 64 * (r % nb); p0_item(w_o, DM, DM, k0, n0, Wo_t, n0, nullptr, scr, lane); continue; } r -= I_O;
            if (r < 2 * I_F1) { const int L = r / I_F1; r -= L * I_F1; const int nb = 2 * FF / 64, k0 = 64 * (r / nb), n0 = 64 * (r % nb);
                p0_item(w_f1 + (size_t)L * DM * 2 * FF, 2 * FF, DM, k0, n0, Wf1_t + (size_t)L * 2 * FF * DM, interleave128(n0, FF), ffn_norm + L * DM, scr, lane); continue; } r -= 2 * I_F1;
            if (r < 2 * I_F2) { const int L = r / I_F2; r -= L * I_F2; const int nb = DM / 64, k0 = 64 * (r / nb), n0 = 64 * (r % nb);
                p0_item(w_f2 + (size_t)L * FF * DM, DM, FF, k0, n0, Wf2_t + (size_t)L * DM * FF, n0, nullptr, scr, lane); continue; } r -= 2 * I_F2;
            if (r < I_QKV) { const int nb = 3 * DM / 64, k0 = 64 * (r / nb), n0 = 64 * (r % nb);
                const int nd = n0 < DM ? 2 * DM + n0 : interleave128(n0 - DM, DM);
                p0_item(w_ci, 3 * DM, DM, k0, n0, Wci_t, nd, conv_norm, scr, lane); continue; } r -= I_QKV;
            { const int nb = DM / 64, k0 = 64 * (r / nb), n0 = 64 * (r % nb); p0_item(w_co, DM, DM, k0, n0, Wco_t, n0, nullptr, scr, lane); }
        }
        for (int i = gt; i < (int)(MiB / 16); i += NGT) ((v4u*)(ws + WS_KSUM))[i] = (v4u){0u, 0u, 0u, 0u};
        for (int m = gw; m < MROWS; m += 2 * NGW) {
            const int m2 = m + NGW;
            const bool has2 = m2 < MROWS; const int mb = has2 ? m2 : m;
            const f32x4* xa = (const f32x4*)(x + (size_t)m * DM) + lane; const f32x4* xc = (const f32x4*)(x + (size_t)mb * DM) + lane; f32x4 va[4], vc[4]; float sa = 0.f, sc = 0.f;
#pragma unroll
            for (int j = 0; j < 4; ++j) { va[j] = xa[64 * j]; vc[j] = xc[64 * j]; }
#pragma unroll
            for (int j = 0; j < 4; ++j) { sa += (va[j].x * va[j].x + va[j].y * va[j].y) + (va[j].z * va[j].z + va[j].w * va[j].w); sc += (vc[j].x * vc[j].x + vc[j].y * vc[j].y) + (vc[j].z * vc[j].z + vc[j].w * vc[j].w); }
            sa = wave_sum(sa); sc = wave_sum(sc);
            if (lane == 0) { ss0[m] = sa; if (has2) ss0[m2] = sc; }
            unsigned long long* oa = (unsigned long long*)(XB + (size_t)m * DM) + lane; unsigned long long* oc = (unsigned long long*)(XB + (size_t)mb * DM) + lane;
#pragma unroll
            for (int j = 0; j < 4; ++j) oa[64 * j] = (unsigned long long)pk2(va[j].x, va[j].y) | ((unsigned long long)pk2(va[j].z, va[j].w) << 32);
            if (has2) {
#pragma unroll
                for (int j = 0; j < 4; ++j) oc[64 * j] = (unsigned long long)pk2(vc[j].x, vc[j].y) | ((unsigned long long)pk2(vc[j].z, vc[j].w) << 32);
            }
        }
        PH_END(0);
    }
    GRID_BAR();

    {
        PH_BEGIN();
        unsigned char* ws = get_args()->ws;
        pg8::Gemm g{WSP(bf16, WS_XB), WSP(bf16, WS_WQKV), MROWS, 3 * DM, DM}; pg8::StaticOrder S; S.init(MROWS, 3 * DM, G, bx);
        pg8::EpiQKV E{WSP(bf16, WS_Q), (size_t)MROWS * DM, WSP(float, WS_SS0), WSP(float, WS_KSUM), QSCALE};
        pg8::gemm_phase<pg8::EpiQKV, pg8::StaticOrder, PG8_ALIGN, PG8_SP2>(lds + RING_OFF, g, S, E);
        PH_END(1);
    }
    GRID_BAR();

    {
        PH_BEGIN();
        KArgs A = get_args(); unsigned char* ws = A->ws;
        for (int u = vcu; u < BATCH * NBLK * NH; u += G) gate_unit(u >> 8, (u >> 3) & 31, u & 7, WSP(bf16, WS_Q), WSP(float, WS_KSUM), (gu32*)(ws + WS_CTL) + CW_CNT, (unsigned*)A->out + OUT_LIST_OFF, lds + RING_OFF, tid, lane, wave);
        PH_END(2);
    }
    GRID_BAR();
    {
        PH_BEGIN();
        KArgs A = get_args(); unsigned char* ws = A->ws;
        attn_phase(lds + RING_OFF, MISC + 16, (gu32*)(ws + WS_CTL), WSP(bf16, WS_Q), WSP(bf16, WS_K), WSP(bf16, WS_V), WSP(bf16, WS_XB), A->out + OUT_LSE_OFF, (const unsigned*)A->out + OUT_LIST_OFF, tid, lane, wave);
        PH_END(3);
    }
    GRID_BAR();
    {
        PH_BEGIN();
        KArgs A = get_args(); unsigned char* ws = A->ws;
        const float* lse = A->out + OUT_LSE_OFF; const bf16* Opart = WSP(bf16, WS_XB); bf16* Qb = WSP(bf16, WS_Q);
        for (int base = gt; base < MROWS * NH * 16; base += 4 * NGT) {
            f32x4 L[4]; v4u o[4][4]; int mhv[4];
#pragma unroll
            for (int q = 0; q < 4; ++q) { const int idx = base + q * NGT; mhv[q] = (idx < MROWS * NH * 16 ? idx : base) >> 4; L[q] = *(const f32x4*)(lse + (size_t)mhv[q] * 4); }
#pragma unroll
            for (int q = 0; q < 4; ++q) { const bf16* op = Opart + (size_t)mhv[q] * 4 * HD + (gt & 15) * 8;
#pragma unroll
                for (int k = 0; k < 4; ++k) o[q][k] = *(const v4u*)(op + k * HD); }
#pragma unroll
            for (int q = 0; q < 4; ++q) {
                const int idx = base + q * NGT; if (idx >= MROWS * NH * 16) break;
                const int mh = mhv[q], piece = gt & 15, m = mh >> 3, ib = (m & (SEQ - 1)) >> 8, nsel = ib < 3 ? ib : 3;
                float mx = L[q][3]; if (nsel > 0) mx = fmaxf(mx, L[q][0]); if (nsel > 1) mx = fmaxf(mx, L[q][1]); if (nsel > 2) mx = fmaxf(mx, L[q][2]);
                float w[4]; w[3] = __builtin_amdgcn_exp2f(L[q][3] - mx);
#pragma unroll
                for (int k = 0; k < 3; ++k) w[k] = nsel > k ? __builtin_amdgcn_exp2f(L[q][k] - mx) : 0.f;
                float a8[8];
#pragma unroll
                for (int e = 0; e < 8; ++e) a8[e] = 0.f;
#pragma unroll
                for (int k = 0; k < 4; ++k) { const bool ok = (k == 3 || nsel > k);
#pragma unroll
                    for (int e = 0; e < 4; ++e) { const unsigned wd = ok ? o[q][k][e] : 0u; a8[2 * e] += w[k] * bf_lo(wd); a8[2 * e + 1] += w[k] * bf_hi(wd); } }
                const float inv = 1.0f / ((w[0] + w[1]) + (w[2] + w[3]));
                v4u y;
#pragma unroll
                for (int e = 0; e < 4; ++e) y[e] = pk2(a8[2 * e] * inv, a8[2 * e + 1] * inv);
                *(v4u*)(Qb + (size_t)m * DM + (mh & 7) * HD + piece * 8) = y;
            }
        }
        PH_END(4);
    }
    GRID_BAR();

    {
        PH_BEGIN();
        KArgs A = get_args(); unsigned char* ws = A->ws;
        pg8::Gemm g{WSP(bf16, WS_Q), WSP(bf16, WS_WO), MROWS, DM, DM}; pg8::StaticOrder S; S.init(MROWS, DM, G, bx);
        pg8::EpiRes<true, true> E{A->in[0], WSP(bf16, WS_XB), WSP(float, WS_SS)};
        pg8::gemm_phase<pg8::EpiRes<true, true>, pg8::StaticOrder, PG8_ALIGN, PG8_SP2>(lds + RING_OFF, g, S, E);
        PH_END(5);
    }
    GRID_BAR();

    {
        PH_BEGIN();
        unsigned char* ws = get_args()->ws;
        pg8::Gemm g{WSP(bf16, WS_XB), WSP(bf16, WS_WF1), MROWS, 2 * FF, DM}; pg8::StaticOrder S; S.init(MROWS, 2 * FF, G, bx);
        pg8::EpiSwiglu E{WSP(bf16, WS_H), FF, WSP(float, WS_SS)};
        pg8::gemm_phase<pg8::EpiSwiglu, pg8::StaticOrder, PG8_ALIGN, PG8_SP2>(lds + RING_OFF, g, S, E);
        PH_END(6);
    }
    GRID_BAR();
    {
        PH_BEGIN();
        KArgs A = get_args(); unsigned char* ws = A->ws;
        pg8::Gemm g{WSP(bf16, WS_H), WSP(bf16, WS_WF2), MROWS, DM, FF}; pg8::StaticOrder S; S.init(MROWS, DM, G, bx);
        pg8::EpiRes<false, true> E{nullptr, WSP(bf16, WS_XB), WSP(float, WS_SS) + MROWS};
        pg8::gemm_phase<pg8::EpiRes<false, true>, pg8::StaticOrder, PG8_ALIGN, PG8_SP2>(lds + RING_OFF, g, S, E);
        PH_END(7);
    }
    GRID_BAR();

    {
        PH_BEGIN();
        unsigned char* ws = get_args()->ws;
        pg8::Gemm g{WSP(bf16, WS_XB), WSP(bf16, WS_WCI), MROWS, 3 * DM, DM}; pg8::StaticOrder S; S.init(MROWS, 3 * DM, G, bx);
        pg8::EpiConvIn E{WSP(bf16, WS_Q), WSP(bf16, WS_K), WSP(float, WS_SS) + MROWS};
        pg8::gemm_phase<pg8::EpiConvIn, pg8::StaticOrder, PG8_ALIGN, PG8_SP2>(lds + RING_OFF, g, S, E);
        PH_END(8);
    }
    GRID_BAR();

    {
        PH_BEGIN();
        KArgs A = get_args(); unsigned char* ws = A->ws; const float* conv_w = A->in[6];
        const bf16* Qb = WSP(bf16, WS_Q); const bf16* Kb = WSP(bf16, WS_K); bf16* Vb = WSP(bf16, WS_V);
        const int c8 = (gt & 127) * 8;
        const f32x4 w0a = *(const f32x4*)(conv_w + c8), w0b = *(const f32x4*)(conv_w + c8 + 4), w1a = *(const f32x4*)(conv_w + DM + c8), w1b = *(const f32x4*)(conv_w + DM + c8 + 4),
                    w2a = *(const f32x4*)(conv_w + 2 * DM + c8), w2b = *(const f32x4*)(conv_w + 2 * DM + c8 + 4);
        for (int base = gt; base < MROWS * (DM / 8); base += 4 * NGT) {
            v4u u2[4], u1[4], u0[4], bb[4]; size_t offs[4]; bool okq[4];
#pragma unroll
            for (int q = 0; q < 4; ++q) {
                const int idx = base + q * NGT; okq[q] = idx < MROWS * (DM / 8); const int m = (okq[q] ? idx : base) >> 7, t = m & (SEQ - 1);
                offs[q] = (size_t)m * DM + c8;
                u2[q] = *(const v4u*)(Qb + offs[q]); bb[q] = *(const v4u*)(Kb + offs[q]);
                u1[q] = (v4u){0u, 0u, 0u, 0u}; u0[q] = (v4u){0u, 0u, 0u, 0u};
                if (t >= 1) u1[q] = *(const v4u*)(Qb + offs[q] - DM);
                if (t >= 2) u0[q] = *(const v4u*)(Qb + offs[q] - 2 * DM);
            }
#pragma unroll
            for (int q = 0; q < 4; ++q) {
                v4u y;
#pragma unroll
                for (int e = 0; e < 4; ++e) {
                    const float wl0 = e < 2 ? w0a[2 * e] : w0b[2 * e - 4], wh0 = e < 2 ? w0a[2 * e + 1] : w0b[2 * e - 3];
                    const float wl1 = e < 2 ? w1a[2 * e] : w1b[2 * e - 4], wh1 = e < 2 ? w1a[2 * e + 1] : w1b[2 * e - 3];
                    const float wl2 = e < 2 ? w2a[2 * e] : w2b[2 * e - 4], wh2 = e < 2 ? w2a[2 * e + 1] : w2b[2 * e - 3];
                    const float lo = bf_lo(bb[q][e]) * (wl0 * bf_lo(u0[q][e]) + wl1 * bf_lo(u1[q][e]) + wl2 * bf_lo(u2[q][e]));
                    const float hi = bf_hi(bb[q][e]) * (wh0 * bf_hi(u0[q][e]) + wh1 * bf_hi(u1[q][e]) + wh2 * bf_hi(u2[q][e]));
                    y[e] = pk2(lo, hi);
                }
                if (okq[q]) *(v4u*)(Vb + offs[q]) = y;
            }
        }
        PH_END(9);
    }
    GRID_BAR();

    {
        PH_BEGIN();
        KArgs A = get_args(); unsigned char* ws = A->ws;
        pg8::Gemm g{WSP(bf16, WS_V), WSP(bf16, WS_WCO), MROWS, DM, DM}; pg8::StaticOrder S; S.init(MROWS, DM, G, bx);
        pg8::EpiRes<false, true> E{nullptr, WSP(bf16, WS_XB), WSP(float, WS_SS) + 2 * MROWS};
        pg8::gemm_phase<pg8::EpiRes<false, true>, pg8::StaticOrder, PG8_ALIGN, PG8_SP2>(lds + RING_OFF, g, S, E);
        PH_END(10);
    }
    GRID_BAR();

    {
        PH_BEGIN();
        unsigned char* ws = get_args()->ws;
        pg8::Gemm g{WSP(bf16, WS_XB), WSP(bf16, WS_WF1) + (size_t)2 * FF * DM, MROWS, 2 * FF, DM}; pg8::StaticOrder S; S.init(MROWS, 2 * FF, G, bx);
        pg8::EpiSwiglu E{WSP(bf16, WS_H), FF, WSP(float, WS_SS) + 2 * MROWS};
        pg8::gemm_phase<pg8::EpiSwiglu, pg8::StaticOrder, PG8_ALIGN, PG8_SP2>(lds + RING_OFF, g, S, E);
        PH_END(11);
    }
    GRID_BAR();
    {
        PH_BEGIN();
        KArgs A = get_args(); unsigned char* ws = A->ws;
        pg8::Gemm g{WSP(bf16, WS_H), WSP(bf16, WS_WF2) + (size_t)DM * FF, MROWS, DM, FF}; pg8::StaticOrder S; S.init(MROWS, DM, G, bx);
        pg8::EpiRes<false, false> E{nullptr, WSP(bf16, WS_XB), nullptr};
        pg8::gemm_phase<pg8::EpiRes<false, false>, pg8::StaticOrder, PG8_ALIGN, PG8_SP2>(lds + RING_OFF, g, S, E);
        PH_END(12);
    }
    GRID_BAR();

    {
        PH_BEGIN();
        KArgs A = get_args(); float* out = A->out; const float* final_norm = A->in[11]; const bf16* XB = (const bf16*)(A->ws + WS_XB);
        const f32x4* gr = (const f32x4*)final_norm + lane; f32x4 gg[4];
#pragma unroll
        for (int j = 0; j < 4; ++j) gg[j] = gr[64 * j];
        for (int m = gw; m < MROWS; m += 2 * NGW) {
            const int m2 = m + NGW; const bool has2 = m2 < MROWS; const int mb = has2 ? m2 : m;
            const uint2* xa = (const uint2*)(XB + (size_t)m * DM) + lane; const uint2* xc = (const uint2*)(XB + (size_t)mb * DM) + lane; uint2 pa[4], pc[4];
#pragma unroll
            for (int j = 0; j < 4; ++j) { pa[j] = xa[64 * j]; pc[j] = xc[64 * j]; }
            f32x4 va[4], vc[4]; float sa = 0.f, sc = 0.f;
#pragma unroll
            for (int j = 0; j < 4; ++j) { va[j] = (f32x4){bf_lo(pa[j].x), bf_hi(pa[j].x), bf_lo(pa[j].y), bf_hi(pa[j].y)}; vc[j] = (f32x4){bf_lo(pc[j].x), bf_hi(pc[j].x), bf_lo(pc[j].y), bf_hi(pc[j].y)};
                sa += (va[j].x * va[j].x + va[j].y * va[j].y) + (va[j].z * va[j].z + va[j].w * va[j].w); sc += (vc[j].x * vc[j].x + vc[j].y * vc[j].y) + (vc[j].z * vc[j].z + vc[j].w * vc[j].w); }
            const float ra = __builtin_amdgcn_rsqf(wave_sum(sa) * (1.0f / DM) + EPS), rc = __builtin_amdgcn_rsqf(wave_sum(sc) * (1.0f / DM) + EPS);
            f32x4* oa = (f32x4*)(out + (size_t)m * DM) + lane; f32x4* oc = (f32x4*)(out + (size_t)mb * DM) + lane;
#pragma unroll
            for (int j = 0; j < 4; ++j) oa[64 * j] = va[j] * ra * gg[j];
            if (has2) {
#pragma unroll
                for (int j = 0; j < 4; ++j) oc[64 * j] = vc[j] * rc * gg[j];
            }
        }
        PH_END(13);
    }
}

extern "C" void kernel_launch(void* const* d_in, const int* in_sizes, int n_in, void* d_out, int out_size, void* d_ws, size_t ws_size, hipStream_t stream) {
    static int grid = 0;
    if (grid == 0) {
        if (n_in != 12 || in_sizes[0] != MROWS * DM || out_size != MROWS * DM || ws_size < WS_END) {
            fprintf(stderr, "kernel_launch: unexpected shapes (n_in %d, in0 %d, out %d, ws %zu); nothing launched\n", n_in, n_in > 0 ? in_sizes[0] : -1, out_size, ws_size); grid = -1; return; }
        int dev = 0, cus = 0, per_cu = 0;
        if (hipGetDevice(&dev) != hipSuccess || hipDeviceGetAttribute(&cus, hipDeviceAttributeMultiprocessorCount, dev) != hipSuccess) { grid = -1; return; }
        if (hipFuncSetAttribute((const void*)moba_fwd, hipFuncAttributeMaxDynamicSharedMemorySize, LDS_BYTES) != hipSuccess) { fprintf(stderr, "kernel_launch: hipFuncSetAttribute failed\n"); grid = -1; return; }
        if (hipOccupancyMaxActiveBlocksPerMultiprocessor(&per_cu, (const void*)moba_fwd, NWAVES * 64, LDS_BYTES) != hipSuccess || per_cu < 1) {
            fprintf(stderr, "kernel_launch: occupancy query reports %d blocks per CU; nothing launched\n", per_cu); (void)hipGetLastError(); grid = -1; return; }
        grid = cus;
    }
    if (grid < 0) return;
    if (hipMemsetAsync((char*)d_ws + WS_CTL, 0, CTL_ZERO_BYTES, stream) != hipSuccess) return;
    Args a{};
    for (int i = 0; i < 12; ++i) a.in[i] = (const float*)d_in[i];
    a.out = (float*)d_out; a.ws = (unsigned char*)d_ws;
    hipLaunchKernelGGL(moba_fwd, dim3(grid), dim3(NWAVES * 64), LDS_BYTES, stream, a);
}
```

```cpp
#include <hip/hip_runtime.h>
#include <cstdio>
#include <cstdint>
#define PROBE_MASK_V 0u
namespace pg8 {
#define PG8_LAS __attribute__((address_space(3)))
typedef unsigned short bf16_t;
typedef short bf16x8 __attribute__((ext_vector_type(8)));
typedef float f32x4 __attribute__((ext_vector_type(4)));
typedef unsigned u32x4 __attribute__((ext_vector_type(4)));
constexpr int BM = 256, BK = 64, HALF = 128, HTB = HALF * BK * 2  , STAGE_BYTES = 8 * HTB, NXCD = 8, WGM = 8;

__host__ __device__ __forceinline__ int lds_byte(int r, int c) { const int st = (r >> 4) * 2 + (c >> 5), rr = r & 15, cc = c & 31, ob = rr * 64 + cc * 2; return st * 1024 + (ob ^ (((ob >> 9) & 1) << 5)); }
__host__ __device__ __forceinline__ void stage_rc(int b, int& R, int& C) { const int st = b / 1024, sb = b % 1024, swz = sb ^ (((sb >> 9) & 1) << 5); R = (st >> 1) * 16 + swz / 64; C = (st & 1) * 32 + (swz % 64) / 2; }
__host__ __device__ __forceinline__ int perm32(int rho) { const int n = rho >> 4, i = rho & 15; return 8 * (i >> 2) + 4 * n + (i & 3); }

struct Unit { int pm, pn; };
struct Gemm { const bf16_t* A; const bf16_t* Bt; int M, N, K; };

struct StaticOrder {
    int nM, nN, nwg, G, c;
    __host__ __device__ void init(int M, int N, int G_, int c_) { nM = M / BM; nN = N / BM; nwg = nM * nN; G = G_; c = c_; }
    __host__ __device__ bool next(int i, Unit& u) const {
        const long L = (long)i * G + c; if (L >= nwg) return false;
        int wgid = (int)L; { const int q = nwg / NXCD, r = nwg % NXCD, xcd = wgid % NXCD, off = wgid / NXCD; wgid = (xcd < r ? xcd * (q + 1) : r * (q + 1) + (xcd - r) * q) + off; }
        const int nig = WGM * nN, gid = wgid / nig, fm = gid * WGM, gsz = (nM - fm) < WGM ? (nM - fm) : WGM;
        u.pm = fm + ((wgid % nig) % gsz); u.pn = (wgid % nig) / gsz; return true;
    }
    __device__ __forceinline__ void a_ready(const Unit&) const {}
    __device__ __forceinline__ void done(const Unit&) const {}
};

__device__ __forceinline__ unsigned cvt_pk_bf16(float lo, float hi) { unsigned r; asm volatile("v_cvt_pk_bf16_f32 %0, %1, %2" : "=v"(r) : "v"(lo), "v"(hi)); return r; }
constexpr int   ROWLEN = 1024;
constexpr float RMS_EPS = 1e-6f, INV_D = 1.0f / 1024.0f;
__device__ __forceinline__ u32x4 pack8(const f32x4 a, const f32x4 b) { u32x4 w; w.x = cvt_pk_bf16(a[0], a[1]); w.y = cvt_pk_bf16(a[2], a[3]); w.z = cvt_pk_bf16(b[0], b[1]); w.w = cvt_pk_bf16(b[2], b[3]); return w; }
__device__ __forceinline__ float rowscale(const float* ss, int row) { return __builtin_amdgcn_rsqf(ss[row] * INV_D + RMS_EPS); }

struct EpiQKV {
    static constexpr bool PERM = true, AFTER_DRAIN = false;
    bf16_t* Q; size_t tstride; const float* ss; float* ksum; float qscale;
    __device__ __forceinline__ void prefetch(float (&pfr)[8], const Unit& u, int wr, int fr) const {
#pragma unroll
        for (int ai = 0; ai < 2; ++ai)
#pragma unroll
            for (int m = 0; m < 4; ++m) pfr[ai * 4 + m] = ss[u.pm * BM + ai * HALF + wr * 64 + m * 16 + fr];
    }
    __device__ __forceinline__ void operator()(const f32x4 (&acc)[2][2][4][2], const Unit& u, int wr, int wc, int fr, int fq) const {
        float pfr[8]; prefetch(pfr, u, wr, fr);
        const int t = u.pn >> 2, colt = (u.pn & 3) * BM + wc * 32 + 8 * fq;
        bf16_t* base = Q + (size_t)t * tstride;
        const float sc = (t == 0) ? qscale : 1.0f;
        f32x4 cs[2][2];
#pragma unroll
        for (int bj = 0; bj < 2; ++bj)
#pragma unroll
            for (int n = 0; n < 2; ++n) cs[bj][n] = (f32x4){0.f, 0.f, 0.f, 0.f};
#pragma unroll
        for (int ai = 0; ai < 2; ++ai)
#pragma unroll
            for (int m = 0; m < 4; ++m) {
                const int row = u.pm * BM + ai * HALF + wr * 64 + m * 16 + fr;
                const float r = __builtin_amdgcn_rsqf(pfr[ai * 4 + m] * INV_D + RMS_EPS) * sc;
#pragma unroll
                for (int bj = 0; bj < 2; ++bj) {
                    const f32x4 v0 = acc[ai][bj][m][0] * r, v1 = acc[ai][bj][m][1] * r;
                    cs[bj][0] += v0; cs[bj][1] += v1;
                    *(u32x4*)(base + (size_t)row * ROWLEN + colt + bj * HALF) = pack8(v0, v1);
                }
            }
        if (t == 1) {
#pragma unroll
            for (int bj = 0; bj < 2; ++bj)
#pragma unroll
                for (int n = 0; n < 2; ++n)
#pragma unroll
                    for (int e = 0; e < 4; ++e) {
                        float s = cs[bj][n][e];
                        s += __shfl_xor(s, 1); s += __shfl_xor(s, 2); s += __shfl_xor(s, 4); s += __shfl_xor(s, 8);
                        if (fr == 0) atomicAdd(ksum + (size_t)u.pm * ROWLEN + colt + bj * HALF + 4 * n + e, s);
                    }
        }
    }
};

template <bool F32IN, bool WANT_SS> struct EpiRes {
    static constexpr bool PERM = true, AFTER_DRAIN = false;
    const float* xin; bf16_t* xb; float* ss;
    __device__ __forceinline__ void prefetch(float (&pfr)[8], const Unit&, int, int) const {
#pragma unroll
        for (int i = 0; i < 8; ++i) pfr[i] = 0.f;
    }
    __device__ __forceinline__ void operator()(const f32x4 (&acc)[2][2][4][2], const Unit& u, int wr, int wc, int fr, int fq) const {
        float pfr[8]; prefetch(pfr, u, wr, fr);
        const int col0 = u.pn * BM + wc * 32 + 8 * fq;
        if (F32IN) {
#pragma unroll
            for (int ai = 0; ai < 2; ++ai) {
                f32x4 pre[4][2][2];
#pragma unroll
                for (int m = 0; m < 4; ++m)
#pragma unroll
                    for (int bj = 0; bj < 2; ++bj) { const size_t off = (size_t)(u.pm * BM + ai * HALF + wr * 64 + m * 16 + fr) * ROWLEN + col0 + bj * HALF; pre[m][bj][0] = *(const f32x4*)(xin + off); pre[m][bj][1] = *(const f32x4*)(xin + off + 4); }
#pragma unroll
                for (int m = 0; m < 4; ++m) {
                    const int row = u.pm * BM + ai * HALF + wr * 64 + m * 16 + fr;
                    float sq = 0.f;
#pragma unroll
                    for (int bj = 0; bj < 2; ++bj) {
                        const size_t off = (size_t)row * ROWLEN + col0 + bj * HALF;
                        const f32x4 v0 = pre[m][bj][0] + acc[ai][bj][m][0], v1 = pre[m][bj][1] + acc[ai][bj][m][1];
                        *(u32x4*)(xb + off) = pack8(v0, v1);
                        if (WANT_SS) sq += (v0[0] * v0[0] + v0[1] * v0[1]) + (v0[2] * v0[2] + v0[3] * v0[3]) + (v1[0] * v1[0] + v1[1] * v1[1]) + (v1[2] * v1[2] + v1[3] * v1[3]);
                    }
                    if (WANT_SS) { sq += __shfl_xor(sq, 16); sq += __shfl_xor(sq, 32); if (fq == 0) atomicAdd(ss + row, sq); }
                }
            }
        } else {
            u32x4 pre[2][4][2];
#pragma unroll
            for (int ai = 0; ai < 2; ++ai)
#pragma unroll
                for (int m = 0; m < 4; ++m)
#pragma unroll
                    for (int bj = 0; bj < 2; ++bj) pre[ai][m][bj] = *(const u32x4*)(xb + (size_t)(u.pm * BM + ai * HALF + wr * 64 + m * 16 + fr) * ROWLEN + col0 + bj * HALF);
#pragma unroll
            for (int ai = 0; ai < 2; ++ai)
#pragma unroll
                for (int m = 0; m < 4; ++m) {
                    const int row = u.pm * BM + ai * HALF + wr * 64 + m * 16 + fr;
                    float sq = 0.f;
#pragma unroll
                    for (int bj = 0; bj < 2; ++bj) {
                        const size_t off = (size_t)row * ROWLEN + col0 + bj * HALF;
                        const u32x4 p = pre[ai][m][bj];
                        const f32x4 x0 = (f32x4){__uint_as_float(p.x << 16), __uint_as_float(p.x & 0xffff0000u), __uint_as_float(p.y << 16), __uint_as_float(p.y & 0xffff0000u)};
                        const f32x4 x1 = (f32x4){__uint_as_float(p.z << 16), __uint_as_float(p.z & 0xffff0000u), __uint_as_float(p.w << 16), __uint_as_float(p.w & 0xffff0000u)};
                        const f32x4 v0 = x0 + acc[ai][bj][m][0], v1 = x1 + acc[ai][bj][m][1];
                        *(u32x4*)(xb + off) = pack8(v0, v1);
                        if (WANT_SS) sq += (v0[0] * v0[0] + v0[1] * v0[1]) + (v0[2] * v0[2] + v0[3] * v0[3]) + (v1[0] * v1[0] + v1[1] * v1[1]) + (v1[2] * v1[2] + v1[3] * v1[3]);
                    }
                    if (WANT_SS) { sq += __shfl_xor(sq, 16); sq += __shfl_xor(sq, 32); if (fq == 0) atomicAdd(ss + row, sq); }
                }
        }
    }
};

struct EpiSwiglu {
    static constexpr bool PERM = true, AFTER_DRAIN = false;
    bf16_t* Hh; int ldh; const float* ss;
    __device__ __forceinline__ void prefetch(float (&pfr)[8], const Unit& u, int wr, int fr) const {
#pragma unroll
        for (int ai = 0; ai < 2; ++ai)
#pragma unroll
            for (int m = 0; m < 4; ++m) pfr[ai * 4 + m] = ss[u.pm * BM + ai * HALF + wr * 64 + m * 16 + fr];
    }
    __device__ __forceinline__ void operator()(const f32x4 (&acc)[2][2][4][2], const Unit& u, int wr, int wc, int fr, int fq) const {
        float pfr[8]; prefetch(pfr, u, wr, fr);
        const int col0 = u.pn * HALF + wc * 32 + 8 * fq;
#pragma unroll
        for (int ai = 0; ai < 2; ++ai)
#pragma unroll
            for (int m = 0; m < 4; ++m) {
                const int row = u.pm * BM + ai * HALF + wr * 64 + m * 16 + fr;
                const float r = __builtin_amdgcn_rsqf(pfr[ai * 4 + m] * INV_D + RMS_EPS);
                f32x4 hv[2];
#pragma unroll
                for (int n = 0; n < 2; ++n) {
                    const f32x4 g = acc[ai][0][m][n] * r, uu = acc[ai][1][m][n] * r;
#pragma unroll
                    for (int e = 0; e < 4; ++e) hv[n][e] = g[e] * uu[e] * __builtin_amdgcn_rcpf(1.0f + __builtin_amdgcn_exp2f(g[e] * -1.4426950408889634f));
                }
                *(u32x4*)(Hh + (size_t)row * ldh + col0) = pack8(hv[0], hv[1]);
            }
    }
};

struct EpiConvIn {
    static constexpr bool PERM = true, AFTER_DRAIN = false;
    bf16_t* U; bf16_t* Bb; const float* ss;
    __device__ __forceinline__ void prefetch(float (&pfr)[8], const Unit& u, int wr, int fr) const {
#pragma unroll
        for (int ai = 0; ai < 2; ++ai)
#pragma unroll
            for (int m = 0; m < 4; ++m) pfr[ai * 4 + m] = ss[u.pm * BM + ai * HALF + wr * 64 + m * 16 + fr];
    }
    __device__ __forceinline__ void operator()(const f32x4 (&acc)[2][2][4][2], const Unit& u, int wr, int wc, int fr, int fq) const {
        float pfr[8]; prefetch(pfr, u, wr, fr);
#pragma unroll
        for (int ai = 0; ai < 2; ++ai)
#pragma unroll
            for (int m = 0; m < 4; ++m) {
                const int row = u.pm * BM + ai * HALF + wr * 64 + m * 16 + fr;
                const float r = __builtin_amdgcn_rsqf(pfr[ai * 4 + m] * INV_D + RMS_EPS);
                if (u.pn < 8) {
                    const float r2 = r * r;
                    const f32x4 a = acc[ai][0][m][0] * acc[ai][1][m][0] * r2, b = acc[ai][0][m][1] * acc[ai][1][m][1] * r2;
                    *(u32x4*)(U + (size_t)row * ROWLEN + u.pn * HALF + wc * 32 + 8 * fq) = pack8(a, b);
                } else {
#pragma unroll
                    for (int bj = 0; bj < 2; ++bj)
                        *(u32x4*)(Bb + (size_t)row * ROWLEN + (u.pn - 8) * BM + bj * HALF + wc * 32 + 8 * fq) = pack8(acc[ai][bj][m][0] * r, acc[ai][bj][m][1] * r);
                }
            }
    }
};

template <class Epi, class Sched, bool ALIGN_EPI = false, bool SP2 = false>
__device__ __forceinline__ void gemm_phase(PG8_LAS unsigned char* lds, const Gemm g, const Sched& S, const Epi& E, const int wave_id) {
    int lane_ = __builtin_amdgcn_mbcnt_hi(~0u, __builtin_amdgcn_mbcnt_lo(~0u, 0u)); asm volatile("" : "+v"(lane_));
    const int wid = wave_id, tid = wid * 64 + lane_, lane = lane_, wr = wid >> 2, wc = wid & 3, fr = lane & 15, fq = lane >> 4;
    const int K = g.K, nt = K / BK;
    unsigned voffA[2], voffB[2];
#pragma unroll
    for (int i = 0; i < 2; ++i) { int R, C; stage_rc(tid * 16 + i * 8192, R, C); const int Rb = Epi::PERM ? ((R & ~31) + perm32(R & 31)) : R;
        voffA[i] = (unsigned)(R * K + C) * 2u; voffB[i] = (unsigned)(Rb * K + C) * 2u; }
    const size_t kstep = (size_t)(BK * 2);
    const size_t hstep = (size_t)HALF * K * 2;
    const size_t tstep = 2 * hstep;
    const unsigned ldsw = (unsigned)wid * 1024u;
    const int aoff = lds_byte(wr * 64 + fr, fq * 8), boff = lds_byte(wc * 32 + fr, fq * 8);
#define PG8_SA(b, h) (((b) * 2 + (h)) * HTB)
#define PG8_SB(b, h) ((4 + (b) * 2 + (h)) * HTB)
#define PG8_STAGE(bufoff, gbase, voff) do { _Pragma("unroll") for (int _i = 0; _i < 2; ++_i) \
        __builtin_amdgcn_global_load_lds((const unsigned*)((const char*)(gbase) + (voff)[_i]), (PG8_LAS unsigned*)(lds + (bufoff) + ldsw + _i * 8192), 16, 0, 0); } while (0)
#define PG8_LDA(dst, b, h) do { _Pragma("unroll") for (int m = 0; m < 4; ++m) _Pragma("unroll") for (int k = 0; k < 2; ++k) dst[m][k] = *(const PG8_LAS bf16x8*)(lds + PG8_SA(b, h) + aoff + m * 2048 + k * 1024); } while (0)
#define PG8_LDB(dst, b, h) do { _Pragma("unroll") for (int n = 0; n < 2; ++n) _Pragma("unroll") for (int k = 0; k < 2; ++k) dst[n][k] = *(const PG8_LAS bf16x8*)(lds + PG8_SB(b, h) + boff + n * 2048 + k * 1024); } while (0)
#define PG8_MMA(ai, bj, At, Bt) do { __builtin_amdgcn_s_setprio(1); _Pragma("unroll") for (int m = 0; m < 4; ++m) _Pragma("unroll") for (int n = 0; n < 2; ++n) _Pragma("unroll") for (int k = 0; k < 2; ++k) \
        acc[ai][bj][m][n] = __builtin_amdgcn_mfma_f32_16x16x32_bf16(Bt[n][k], At[m][k], acc[ai][bj][m][n], 0, 0, 0); __builtin_amdgcn_s_setprio(0); } while (0)
#define PG8_WAIT_V(n) asm volatile("s_waitcnt vmcnt(" #n ")" ::: "memory")
#define PG8_WAIT_L(n) asm volatile("s_waitcnt lgkmcnt(" #n ")" ::: "memory")
#define PG8_BAR __builtin_amdgcn_s_barrier()
#define PG8_SCHED __builtin_amdgcn_sched_barrier(0)
    Unit cur, nxt; int ui = 0;
    if (!S.next(0, cur)) return;
    f32x4 acc[2][2][4][2];
#pragma unroll
    for (int a = 0; a < 2; ++a)
#pragma unroll
        for (int b = 0; b < 2; ++b)
#pragma unroll
            for (int m = 0; m < 4; ++m)
#pragma unroll
                for (int n = 0; n < 2; ++n) acc[a][b][m][n] = (f32x4){0.f, 0.f, 0.f, 0.f};
    bf16x8 At[4][2], B0[2][2], B1[2][2];
    const char* cA = (const char*)g.A + (size_t)cur.pm * tstep; const char* cB = (const char*)g.Bt + (size_t)cur.pn * tstep;
    S.a_ready(cur);
    if constexpr (SP2) {
        PG8_STAGE(PG8_SB(0, 0), cB, voffB); PG8_STAGE(PG8_SB(0, 1), cB + hstep, voffB); PG8_STAGE(PG8_SA(0, 0), cA, voffA); PG8_STAGE(PG8_SA(0, 1), cA + hstep, voffA);
        if (wr == 1) PG8_BAR;
        PG8_WAIT_V(2); PG8_BAR;
        PG8_STAGE(PG8_SB(1, 0), cB + kstep, voffB); PG8_STAGE(PG8_SA(1, 0), cA + kstep, voffA); PG8_STAGE(PG8_SB(1, 1), cB + hstep + kstep, voffB);
        PG8_WAIT_V(6); PG8_BAR;
    } else {
        PG8_STAGE(PG8_SB(0, 0), cB, voffB); PG8_STAGE(PG8_SA(0, 0), cA, voffA); PG8_STAGE(PG8_SB(0, 1), cB + hstep, voffB); PG8_STAGE(PG8_SA(0, 1), cA + hstep, voffA);
        if (wr == 1) PG8_BAR;
        PG8_WAIT_V(4); PG8_BAR;
        PG8_STAGE(PG8_SB(1, 0), cB + kstep, voffB); PG8_STAGE(PG8_SA(1, 0), cA + kstep, voffA); PG8_STAGE(PG8_SB(1, 1), cB + hstep + kstep, voffB);
        PG8_WAIT_V(6); PG8_BAR;
    }
    for (;;) {
        const bool has_next = S.next(ui + 1, nxt);
        const char* nA = has_next ? (const char*)g.A + (size_t)nxt.pm * tstep : cA; const char* nB = has_next ? (const char*)g.Bt + (size_t)nxt.pn * tstep : cB;
        for (int t = 0; t < nt; t += 2) {
            const bool last = (t == nt - 2);
            const char* a1 = cA + (size_t)(t + 1) * kstep;
            const char* a2 = last ? nA : cA + (size_t)(t + 2) * kstep; const char* b2 = last ? nB : cB + (size_t)(t + 2) * kstep;
            const char* a3 = a2 + kstep; const char* b3 = b2 + kstep;
            if (last && has_next) S.a_ready(nxt);
            if constexpr (SP2) {
            PG8_LDB(B0, 0, 0); PG8_LDB(B1, 0, 1); PG8_SCHED; PG8_LDA(At, 0, 0); PG8_STAGE(PG8_SA(1, 1), a1 + hstep, voffA);
            PG8_WAIT_V(8); PG8_WAIT_L(0); PG8_BAR; PG8_MMA(0, 0, At, B0); PG8_MMA(0, 1, At, B1); PG8_BAR; PG8_SCHED;
            PG8_LDA(At, 0, 1); PG8_STAGE(PG8_SB(0, 0), b2, voffB); PG8_STAGE(PG8_SB(0, 1), b2 + hstep, voffB); PG8_STAGE(PG8_SA(0, 0), a2, voffA);
            PG8_WAIT_V(8); PG8_WAIT_L(0); PG8_BAR; PG8_MMA(1, 0, At, B0); PG8_MMA(1, 1, At, B1); PG8_BAR; PG8_SCHED;
            PG8_LDB(B0, 1, 0); PG8_LDB(B1, 1, 1); PG8_SCHED; PG8_LDA(At, 1, 0); PG8_STAGE(PG8_SA(0, 1), a2 + hstep, voffA);
            PG8_WAIT_V(8); PG8_WAIT_L(0); PG8_BAR; PG8_MMA(0, 0, At, B0); PG8_MMA(0, 1, At, B1); PG8_BAR; PG8_SCHED;
            PG8_LDA(At, 1, 1); PG8_STAGE(PG8_SB(1, 0), b3, voffB); PG8_STAGE(PG8_SB(1, 1), b3 + hstep, voffB); PG8_STAGE(PG8_SA(1, 0), a3, voffA);
            PG8_WAIT_V(8); PG8_WAIT_L(0); PG8_BAR; PG8_MMA(1, 0, At, B0); PG8_MMA(1, 1, At, B1); PG8_BAR; PG8_SCHED;
            } else {
            PG8_LDB(B0, 0, 0); PG8_SCHED; PG8_LDA(At, 0, 0); PG8_STAGE(PG8_SA(1, 1), a1 + hstep, voffA);
            PG8_WAIT_L(8); PG8_BAR; PG8_WAIT_L(0); PG8_MMA(0, 0, At, B0); PG8_BAR; PG8_SCHED;
            PG8_LDB(B1, 0, 1); PG8_STAGE(PG8_SB(0, 0), b2, voffB);
            PG8_BAR; PG8_WAIT_L(0); PG8_MMA(0, 1, At, B1); PG8_BAR;
            PG8_LDA(At, 0, 1); PG8_STAGE(PG8_SA(0, 0), a2, voffA);
            PG8_BAR; PG8_WAIT_L(0); PG8_MMA(1, 0, At, B0); PG8_BAR; PG8_SCHED;
            PG8_STAGE(PG8_SB(0, 1), b2 + hstep, voffB);
            PG8_WAIT_V(6); PG8_BAR; PG8_MMA(1, 1, At, B1); PG8_BAR;
            PG8_LDB(B0, 1, 0); PG8_SCHED; PG8_LDA(At, 1, 0); PG8_STAGE(PG8_SA(0, 1), a2 + hstep, voffA);
            PG8_WAIT_L(8); PG8_BAR; PG8_WAIT_L(0); PG8_MMA(0, 0, At, B0); PG8_BAR; PG8_SCHED;
            PG8_LDB(B1, 1, 1); PG8_STAGE(PG8_SB(1, 0), b3, voffB);
            PG8_BAR; PG8_WAIT_L(0); PG8_MMA(0, 1, At, B1); PG8_BAR;
            PG8_LDA(At, 1, 1); PG8_STAGE(PG8_SA(1, 0), a3, voffA);
            PG8_BAR; PG8_WAIT_L(0); PG8_MMA(1, 0, At, B0); PG8_BAR; PG8_SCHED;
            PG8_STAGE(PG8_SB(1, 1), b3 + hstep, voffB);
            PG8_WAIT_V(6); PG8_BAR; PG8_MMA(1, 1, At, B1); PG8_BAR;
            }
        }
        if constexpr (ALIGN_EPI) { if (wr == 0) PG8_BAR; }
        if constexpr (!Epi::AFTER_DRAIN) {
            const bool epi_probe_ = (PROBE_MASK_V & (1u << 15)) || ((PROBE_MASK_V & (1u << 16)) && g.N == 5632) || ((PROBE_MASK_V & (1u << 17)) && g.N == 3072) || ((PROBE_MASK_V & (1u << 18)) && g.N == 1024);
            const unsigned long long te0_ = epi_probe_ ? __builtin_amdgcn_s_memrealtime() : 0ull;
            E(acc, cur, wr, wc, fr, fq); S.done(cur);
            if (epi_probe_) { const unsigned long long te1_ = __builtin_amdgcn_s_memrealtime(); while (__builtin_amdgcn_s_memrealtime() - te1_ < te1_ - te0_) __builtin_amdgcn_s_sleep(4); }
        }
        if (!has_next) break;
#pragma unroll
        for (int a = 0; a < 2; ++a)
#pragma unroll
            for (int b = 0; b < 2; ++b)
#pragma unroll
                for (int m = 0; m < 4; ++m)
#pragma unroll
                    for (int n = 0; n < 2; ++n) acc[a][b][m][n] = (f32x4){0.f, 0.f, 0.f, 0.f};
        cur = nxt; cA = nA; cB = nB; ++ui;
        if constexpr (ALIGN_EPI) { if (wr == 1) PG8_BAR; }
    }
    PG8_WAIT_V(0);
    if constexpr (!ALIGN_EPI) { if (wr == 0) PG8_BAR; }
    PG8_BAR;
    if constexpr (Epi::AFTER_DRAIN) { E.fused(acc, cur, wr, wc, fr, fq, lds, wid, lane); S.done(cur); }
#undef PG8_SA
#undef PG8_SB
#undef PG8_STAGE
#undef PG8_LDA
#undef PG8_LDB
#undef PG8_MMA
#undef PG8_WAIT_V
#undef PG8_WAIT_L
#undef PG8_BAR
#undef PG8_SCHED
}
}

#ifndef PG8_SP2
#define PG8_SP2 true
#endif
#ifndef PG8_ALIGN
#define PG8_ALIGN true
#endif
#define GAS __attribute__((address_space(1)))
#define LAS __attribute__((address_space(3)))
typedef unsigned short bf16;
typedef unsigned v4u __attribute__((ext_vector_type(4)));
typedef float f32x4 __attribute__((ext_vector_type(4)));
typedef short bf16x8 __attribute__((ext_vector_type(8)));
typedef GAS unsigned gu32;
typedef GAS unsigned long long gu64;
#define RLX_AGENT __ATOMIC_RELAXED, __HIP_MEMORY_SCOPE_AGENT
#define LDS_WAIT() asm volatile("s_waitcnt lgkmcnt(0)" ::: "memory")
#define VM_WAIT() asm volatile("s_waitcnt vmcnt(0)" ::: "memory")
__device__ __forceinline__ unsigned long long rt() { return __builtin_amdgcn_s_memrealtime(); }

#define XB_TMO      128
#define XB_XCNT(j)  (256  + 64 * (j))
#define XB_XSUB(j)  (1280 + 64 * (j))
#define XB_XGEN(j)  (2304 + 64 * (j))
#define XB_TOP      3328
#define XB_TOPGEN   3392
#define XCD_BAR_WORDS 3456
#define XB_SPIN_CAP (1u << 18)

__device__ __forceinline__ unsigned xb_ld(unsigned* p)              { return __hip_atomic_load(p, __ATOMIC_RELAXED, __HIP_MEMORY_SCOPE_AGENT); }
__device__ __forceinline__ unsigned xb_add(unsigned* p, unsigned v) { return __hip_atomic_fetch_add(p, v, __ATOMIC_RELAXED, __HIP_MEMORY_SCOPE_AGENT); }
__device__ __forceinline__ unsigned xb_xcc_id() { return (unsigned)__builtin_amdgcn_s_getreg((3 << 11) | 20) & 0xFu; }
#define XB_SPIN(cond, bar) do { unsigned _sp = 0; while (cond) { __builtin_amdgcn_s_sleep(1); \
    if ((++_sp & 255u) == 0u) { if (xb_ld(&(bar)[XB_TMO])) break; if (_sp > XB_SPIN_CAP) { atomicAdd(&(bar)[XB_TMO], 1u); break; } } } } while (0)

struct XcdBarrier {
    unsigned* bar; unsigned x;
    volatile LAS unsigned* st;
};

__device__ __forceinline__ XcdBarrier xcd_barrier_post(unsigned* bar, volatile LAS unsigned* st) {
    XcdBarrier b; b.bar = bar; b.x = xb_xcc_id(); b.st = st;
    if (threadIdx.x == 0) (void)xb_add(&bar[XB_XCNT(b.x)], 1u);
    return b;
}
__device__ __forceinline__ void xcd_barrier_complete(unsigned* bar, unsigned x, unsigned& nloc, unsigned& nx) {
    const unsigned G = gridDim.x * gridDim.y * gridDim.z;
    unsigned sum, cnt, mine, sp = 0u;
    for (;;) {
        sum = 0u; cnt = 0u; mine = 0u;
#pragma unroll
        for (unsigned j = 0; j < 16; ++j) { const unsigned c = xb_ld(&bar[XB_XCNT(j)]); sum += c; cnt += (c > 0u) ? 1u : 0u; mine = (j == x) ? c : mine; }
        if (sum == G) break;
        __builtin_amdgcn_s_sleep(1);
        if ((++sp & 255u) == 0u) { if (xb_ld(&bar[XB_TMO])) break; if (sp > XB_SPIN_CAP) { atomicAdd(&bar[XB_TMO], 1u); break; } }
    }
    nloc = mine > 0u ? mine : 1u; nx = cnt > 0u ? cnt : 1u;
}

__device__ __forceinline__ void xcd_barrier(const XcdBarrier& b, const bool lead) {
    asm volatile("s_waitcnt vmcnt(0)" ::: "memory");
    __syncthreads();
    if (lead) {
        unsigned* bar = b.bar;
        __builtin_amdgcn_s_waitcnt(0);
        unsigned nloc = b.st[0], nx = b.st[1];
        if (nloc == 0u) { xcd_barrier_complete(bar, b.x, nloc, nx); b.st[0] = nloc; b.st[1] = nx; }
        const unsigned old = xb_add(&bar[XB_XSUB(b.x)], 1u);
        const unsigned gen = old / nloc;
        if (old + 1u == (gen + 1u) * nloc) {
            __builtin_amdgcn_fence(__ATOMIC_RELEASE, "agent");
            asm volatile("s_waitcnt vmcnt(0)" ::: "memory");
            const unsigned og = xb_add(&bar[XB_TOP], 1u);
            const unsigned tg = og / nx;
            if (og + 1u == (tg + 1u) * nx) xb_add(&bar[XB_TOPGEN], 1u);
            else XB_SPIN(xb_ld(&bar[XB_TOPGEN]) == tg, bar);
            __builtin_amdgcn_fence(__ATOMIC_ACQUIRE, "agent");
            xb_add(&bar[XB_XGEN(b.x)], 1u);
            asm volatile("s_waitcnt vmcnt(0)" ::: "memory");
        } else {
            XB_SPIN(xb_ld(&bar[XB_XGEN(b.x)]) == gen, bar);
            __builtin_amdgcn_fence(__ATOMIC_ACQUIRE, "agent");
            asm volatile("s_waitcnt vmcnt(0)" ::: "memory");
        }
    }
    __syncthreads();
}

constexpr int NWAVES = 8;
constexpr int BATCH = 4, SEQ = 8192, DM = 1024, NH = 8, HD = 128, FF = 2816, MROWS = BATCH * SEQ;
constexpr int BS = 256, NBLK = SEQ / BS;
constexpr float QSCALE = 0.08838834764831845f * 1.4426950408889634f;
constexpr float EPS = 1e-6f;

constexpr size_t MiB = 1u << 20;
constexpr size_t WS_CTL = 0, CTL_ZERO_BYTES = 1 * MiB;
constexpr size_t WS_KSUM = 1 * MiB;
constexpr size_t WS_SS = 1 * MiB + 512 * 1024;
constexpr size_t WS_SS0 = 2 * MiB;
constexpr size_t WS_WQKV = 4 * MiB, WS_WO = 10 * MiB, WS_WF1 = 12 * MiB  , WS_WF2 = 34 * MiB  , WS_WCI = 45 * MiB, WS_WCO = 51 * MiB;
constexpr size_t WS_Q = 56 * MiB, WS_K = 120 * MiB, WS_V = 184 * MiB;
constexpr size_t WS_XB = 248 * MiB;
constexpr size_t WS_H = 312 * MiB;
constexpr size_t WS_END = 504 * MiB;
static_assert(WS_H + (size_t)MROWS * FF * 2 <= WS_END, "ws map");
constexpr int CW_TMO = 0, CW_CODE = 1, CW_BAR = 4096;

constexpr int RING_OFF = 0, RING_BYTES = 131072;
constexpr int LDSCTL_OFF = RING_BYTES, MISC_OFF = LDSCTL_OFF + 320;
constexpr int LDS_BYTES = 147456;

__device__ __forceinline__ float wave_sum(float v) {
#pragma unroll
    for (int o = 1; o < 64; o <<= 1) v += __shfl_xor(v, o);
    return v;
}
__device__ __forceinline__ float bf_lo(unsigned w) { return __uint_as_float(w << 16); }
__device__ __forceinline__ float bf_hi(unsigned w) { return __uint_as_float(w & 0xffff0000u); }
__device__ __forceinline__ unsigned pk2(float lo, float hi) { return pg8::cvt_pk_bf16(lo, hi); }

__device__ __forceinline__ void p0_item(const float* W, int N, int K, int k0, int n_src0, bf16* WT, int n_dst0, const float* gain, LAS unsigned char* scr, int lane) {
    const int lq = lane >> 4, ln = lane & 15;
    const float gv = gain ? gain[k0 + lane] : 1.0f;
    f32x4 v[16];
    const float* src = W + (size_t)(k0 + 2 * lq) * N + n_src0 + 4 * ln;
#pragma unroll
    for (int i = 0; i < 16; ++i) v[i] = *(const f32x4*)(src + (size_t)(8 * (i >> 1) + (i & 1)) * N);
#pragma unroll
    for (int p = 0; p < 8; ++p) {
        const float g0 = __shfl(gv, 8 * p + 2 * lq), g1 = __shfl(gv, 8 * p + 2 * lq + 1);
#pragma unroll
        for (int e = 0; e < 4; ++e) *(LAS unsigned*)(scr + (4 * ln + e) * 144 + (8 * p + 2 * lq) * 2) = pk2(v[2 * p][e] * g0, v[2 * p + 1][e] * g1);
    }
    LDS_WAIT(); asm volatile("" ::: "memory");
#pragma unroll
    for (int r = 0; r < 8; ++r) { const int row = 8 * r + (lane >> 3), c = lane & 7;
        const v4u o = *(const LAS v4u*)(scr + row * 144 + c * 16);
        *(v4u*)(WT + (size_t)(n_dst0 + row) * K + k0 + 8 * c) = o; }
    LDS_WAIT(); asm volatile("" ::: "memory");
}
__device__ __forceinline__ int interleave128(int n, int half_cols) { const int hsel = n >= half_cols ? 1 : 0, nn = n - hsel * half_cols; return 256 * (nn >> 7) + 128 * hsel + (nn & 127); }

struct Args { const float* in[12]; float* out; unsigned char* ws; };

__device__ __forceinline__ void naive_attn_item(bf16* Q, const bf16* Kb, const bf16* Vb, const float* ksum, int m, int h, int lane) {
    const int t = m & (SEQ - 1), b = m / SEQ, ib = t / BS;
    const size_t qoff = (size_t)m * DM + h * HD + 2 * lane;
    const unsigned qq = *(const unsigned*)(Q + qoff); const float q0 = bf_lo(qq), q1 = bf_hi(qq);
    int s0 = -1, s1 = -1, s2 = -1; float g0 = -3.0e38f, g1 = -3.0e38f, g2 = -3.0e38f;
    for (int j = 0; j < ib; ++j) {
        const float2 km = *(const float2*)(ksum + (size_t)(b * NBLK + j) * DM + h * HD + 2 * lane);
        const float g = wave_sum(q0 * km.x + q1 * km.y);
        if (g > g0) { g2 = g1; s2 = s1; g1 = g0; s1 = s0; g0 = g; s0 = j; }
        else if (g > g1) { g2 = g1; s2 = s1; g1 = g; s1 = j; }
        else if (g > g2) { g2 = g; s2 = j; }
    }
    float mr = -1.0e30f, l = 0.f, o0 = 0.f, o1 = 0.f;
    for (int sidx = 0; sidx < 4; ++sidx) {
        const int blk = sidx == 0 ? s0 : sidx == 1 ? s1 : sidx == 2 ? s2 : ib;
        if (blk < 0) continue;
        const int nk = (sidx == 3) ? (t & (BS - 1)) + 1 : BS;
        const size_t rbase = ((size_t)b * SEQ + (size_t)blk * BS) * DM + h * HD + 2 * lane;
        for (int k0 = 0; k0 < nk; k0 += 4) {
            float d[4]; unsigned vv[4];
#pragma unroll
            for (int u = 0; u < 4; ++u) { const unsigned kk = *(const unsigned*)(Kb + rbase + (size_t)(k0 + u) * DM); vv[u] = *(const unsigned*)(Vb + rbase + (size_t)(k0 + u) * DM); d[u] = q0 * bf_lo(kk) + q1 * bf_hi(kk); }
#pragma unroll
            for (int o = 1; o < 64; o <<= 1) {
#pragma unroll
                for (int u = 0; u < 4; ++u) d[u] += __shfl_xor(d[u], o);
            }
#pragma unroll
            for (int u = 0; u < 4; ++u) if (k0 + u >= nk) d[u] = -1.0e30f;
            const float mn = fmaxf(fmaxf(mr, fmaxf(d[0], d[1])), fmaxf(d[2], d[3]));
            const float a = __builtin_amdgcn_exp2f(mr - mn); l *= a; o0 *= a; o1 *= a; mr = mn;
#pragma unroll
            for (int u = 0; u < 4; ++u) { const float p = __builtin_amdgcn_exp2f(d[u] - mn); l += p; o0 += p * bf_lo(vv[u]); o1 += p * bf_hi(vv[u]); }
        }
    }
    const float il = 1.0f / l;
    *(unsigned*)(Q + qoff) = pk2(o0 * il, o1 * il);
}


typedef float f32x16 __attribute__((ext_vector_type(16)));
typedef short v4i16_t __attribute__((ext_vector_type(4)));
#define MFMA32(a, b, c) __builtin_amdgcn_mfma_f32_32x32x16_bf16((a), (b), (c), 0, 0, 0)
__device__ __forceinline__ int crow(int r, int hi) { return (r & 3) + 8 * (r >> 2) + 4 * hi; }
constexpr int CW_QUEUE = 8192, CW_CNT = 12288;
constexpr int LIST_PER_BH = 256 * 496;
__device__ __forceinline__ int list_off(int j) { return 256 * (31 * j - (j * (j - 1)) / 2); }
constexpr size_t OUT_LSE_OFF = 0, OUT_LIST_OFF = 2u << 20;
constexpr float NEG_BIG = -1.0e30f;
#define GT_(va, ia, vb, ib_) ((va) > (vb) || ((va) == (vb) && (ia) < (ib_)))
#define TOP3_INSERT(v, i) do { const float v_ = (v); const int i_ = (i); \
    if (GT_(v_, i_, v0, i0)) { v2 = v1; i2 = i1; v1 = v0; i1 = i0; v0 = v_; i0 = i_; } \
    else if (GT_(v_, i_, v1, i1)) { v2 = v1; i2 = i1; v1 = v_; i1 = i_; } \
    else if (GT_(v_, i_, v2, i2)) { v2 = v_; i2 = i_; } } while (0)

__device__ __forceinline__ void gate_unit(int b, int ib, int hd, const bf16* Qb, const float* ksum, gu32* gcount, unsigned* lists, LAS unsigned char* lds, int tid, int lane, int wave) {
    const int r32 = lane & 31, hi = lane >> 5, bh = b * NH + hd;
    const int t = ib * BS + wave * 32 + r32;
    LAS unsigned* cnt = (LAS unsigned*)lds; LAS unsigned* basel = cnt + 32;
    if (tid < 32) cnt[tid] = 0u;
    f32x16 acc;
#pragma unroll
    for (int i = 0; i < 16; ++i) acc[i] = 0.f;
    const bf16* qp = Qb + ((size_t)b * SEQ + t) * DM + hd * HD + 8 * hi;
    const float* kp = ksum + (size_t)(b * NBLK + r32) * DM + hd * HD + 8 * hi;
#pragma unroll
    for (int s = 0; s < 8; ++s) {
        const bf16x8 qf = *(const bf16x8*)(qp + 16 * s);
        const f32x4 k0 = *(const f32x4*)(kp + 16 * s), k1 = *(const f32x4*)(kp + 16 * s + 4);
        v4u wh, wl;
        wh.x = pk2(k0[0], k0[1]); wh.y = pk2(k0[2], k0[3]); wh.z = pk2(k1[0], k1[1]); wh.w = pk2(k1[2], k1[3]);
        wl.x = pk2(k0[0] - bf_lo(wh.x), k0[1] - bf_hi(wh.x)); wl.y = pk2(k0[2] - bf_lo(wh.y), k0[3] - bf_hi(wh.y));
        wl.z = pk2(k1[0] - bf_lo(wh.z), k1[1] - bf_hi(wh.z)); wl.w = pk2(k1[2] - bf_lo(wh.w), k1[3] - bf_hi(wh.w));
        acc = MFMA32(__builtin_bit_cast(bf16x8, wh), qf, acc);
        acc = MFMA32(__builtin_bit_cast(bf16x8, wl), qf, acc);
    }
    float v0 = -3.0e38f, v1 = -3.0e38f, v2 = -3.0e38f; int i0 = 99, i1 = 99, i2 = 99;
#pragma unroll
    for (int i = 0; i < 16; ++i) { const int blk = crow(i, hi); const float g = blk < ib ? acc[i] : -3.0e38f; TOP3_INSERT(g, blk); }
    { const float p0 = __shfl_xor(v0, 32), p1 = __shfl_xor(v1, 32), p2 = __shfl_xor(v2, 32); const int q0 = __shfl_xor(i0, 32), q1 = __shfl_xor(i1, 32), q2 = __shfl_xor(i2, 32);
      TOP3_INSERT(p0, q0); TOP3_INSERT(p1, q1); TOP3_INSERT(p2, q2); }
    const bool ok0 = hi == 0 && v0 > -1.0e38f, ok1 = hi == 0 && v1 > -1.0e38f, ok2 = hi == 0 && v2 > -1.0e38f;
    __syncthreads();
    unsigned r0 = 0, r1 = 0, r2 = 0;
    if (ok0) r0 = __hip_atomic_fetch_add(cnt + i0, 1u, __ATOMIC_RELAXED, __HIP_MEMORY_SCOPE_WORKGROUP);
    if (ok1) r1 = __hip_atomic_fetch_add(cnt + i1, 1u, __ATOMIC_RELAXED, __HIP_MEMORY_SCOPE_WORKGROUP);
    if (ok2) r2 = __hip_atomic_fetch_add(cnt + i2, 1u, __ATOMIC_RELAXED, __HIP_MEMORY_SCOPE_WORKGROUP);
    __syncthreads();
    if (tid < 32) { const unsigned c = cnt[tid]; basel[tid] = c ? __hip_atomic_fetch_add(gcount + bh * 32 + tid, c, RLX_AGENT) : 0u; }
    __syncthreads();
    unsigned* lb = lists + (size_t)bh * LIST_PER_BH;
    if (ok0) lb[list_off(i0) + basel[i0] + r0] = (unsigned)t;
    if (ok1) lb[list_off(i1) + basel[i1] + r1] = (unsigned)t | (1u << 13);
    if (ok2) lb[list_off(i2) + basel[i2] + r2] = (unsigned)t | (2u << 13);
    __syncthreads();
}

__device__ __forceinline__ void attn_wave_item(LAS unsigned char* Kimg, LAS unsigned char* Vimg, bf16x8 (&qf)[8], const bf16* qnext, bf16* Opart, float* lse, size_t mrow, int hd, int slot, bool valid, int kmax, bool own, int lane) {
    const int r32 = lane & 31, hi = lane >> 5;
    const int xr = ((r32 & 3) << 2) | ((r32 >> 2) & 3);
    const LAS unsigned char* kb = Kimg + 256 * r32;
    f32x16 S[8];
#pragma unroll
    for (int kt = 0; kt < 8; ++kt)
#pragma unroll
        for (int i = 0; i < 16; ++i) S[kt][i] = 0.f;
    bf16x8 kA[4], kB[4];
#define LOADK(dst, u) do { _Pragma("unroll") for (int j = 0; j < 4; ++j) dst[j] = *(const LAS bf16x8*)(kb + 16 * ((2 * ((u) >> 1) + hi) ^ xr) + 8192 * (4 * ((u) & 1) + j)); } while (0)
#define MMAK(src, u) do { _Pragma("unroll") for (int j = 0; j < 4; ++j) if (4 * ((u) & 1) + j <= kmax) S[4 * ((u) & 1) + j] = MFMA32(src[j], qf[(u) >> 1], S[4 * ((u) & 1) + j]); } while (0)
    LOADK(kA, 0);
    LOADK(kB, 1); MMAK(kA, 0); LOADK(kA, 2); MMAK(kB, 1);
    LOADK(kB, 3); MMAK(kA, 2); LOADK(kA, 4); MMAK(kB, 3);
    LOADK(kB, 5); MMAK(kA, 4); LOADK(kA, 6); MMAK(kB, 5);
    LOADK(kB, 7); MMAK(kA, 6); LOADK(kA, 8); MMAK(kB, 7);
    LOADK(kB, 9); MMAK(kA, 8); LOADK(kA, 10); MMAK(kB, 9);
    LOADK(kB, 11); MMAK(kA, 10); LOADK(kA, 12); MMAK(kB, 11);
    LOADK(kB, 13); MMAK(kA, 12); LOADK(kA, 14); MMAK(kB, 13);
    LOADK(kB, 15); MMAK(kA, 14); MMAK(kB, 15);
#undef LOADK
#undef MMAK
    if (qnext) {
#pragma unroll
        for (int s = 0; s < 8; ++s) qf[s] = *(const bf16x8*)(qnext + 16 * s);
    }
#pragma unroll
    for (int kt = 0; kt < 8; ++kt) {
        if (kt > kmax) {
#pragma unroll
            for (int i = 0; i < 16; ++i) S[kt][i] = NEG_BIG;
        } else if (own && kt == kmax) {
#pragma unroll
            for (int i = 0; i < 16; ++i) if (crow(i, hi) > r32) S[kt][i] = NEG_BIG;
        }
    }
    float mx = NEG_BIG;
#pragma unroll
    for (int kt = 0; kt < 8; ++kt)
#pragma unroll
        for (int i = 0; i < 16; ++i) mx = fmaxf(mx, S[kt][i]);
    mx = fmaxf(mx, __shfl_xor(mx, 32));
    float lsum = 0.f; v4u pw[8][2];
#pragma unroll
    for (int kt = 0; kt < 8; ++kt) {
        float p[16];
#pragma unroll
        for (int i = 0; i < 16; ++i) { p[i] = __builtin_amdgcn_exp2f(S[kt][i] - mx); lsum += p[i]; }
#pragma unroll
        for (int s2 = 0; s2 < 2; ++s2) { pw[kt][s2].x = pk2(p[8 * s2], p[8 * s2 + 1]); pw[kt][s2].y = pk2(p[8 * s2 + 2], p[8 * s2 + 3]); pw[kt][s2].z = pk2(p[8 * s2 + 4], p[8 * s2 + 5]); pw[kt][s2].w = pk2(p[8 * s2 + 6], p[8 * s2 + 7]); }
    }
    lsum += __shfl_xor(lsum, 32);
    int lane_v = lane; asm volatile("" : "+v"(lane_v));
    const int blk = (lane_v >> 4) & 1, q4 = (lane_v & 15) >> 2, p4 = lane_v & 3, hi_v = lane_v >> 5;
    int vb[2][4];
#pragma unroll
    for (int t = 0; t < 2; ++t)
#pragma unroll
        for (int c4 = 0; c4 < 4; ++c4) vb[t][c4] = 256 * (8 * t + 4 * hi_v + q4) + 64 * (c4 ^ q4) + 16 * ((2 * blk + (p4 >> 1)) ^ ((2 * t + hi_v) & 3)) + 8 * (p4 & 1);
    f32x16 O[4];
#pragma unroll
    for (int c4 = 0; c4 < 4; ++c4)
#pragma unroll
        for (int i = 0; i < 16; ++i) O[c4][i] = 0.f;
    v4i16_t vA[4][2], vB[4][2];
#define LOADV(dst, idx) do { _Pragma("unroll") for (int c4 = 0; c4 < 4; ++c4) { \
        dst[c4][0] = __builtin_amdgcn_ds_read_tr16_b64_v4i16((LAS v4i16_t*)(Vimg + vb[0][c4] + 4096 * (idx))); \
        dst[c4][1] = __builtin_amdgcn_ds_read_tr16_b64_v4i16((LAS v4i16_t*)(Vimg + vb[1][c4] + 4096 * (idx))); } } while (0)
#define MMAV(src, idx) do { if (((idx) >> 1) <= kmax) { const bf16x8 pf = __builtin_bit_cast(bf16x8, pw[(idx) >> 1][(idx) & 1]); _Pragma("unroll") for (int c4 = 0; c4 < 4; ++c4) { \
        const bf16x8 vf = (bf16x8){src[c4][0][0], src[c4][0][1], src[c4][0][2], src[c4][0][3], src[c4][1][0], src[c4][1][1], src[c4][1][2], src[c4][1][3]}; O[c4] = MFMA32(vf, pf, O[c4]); } } } while (0)
    LOADV(vA, 0);
    LOADV(vB, 1); MMAV(vA, 0); LOADV(vA, 2); MMAV(vB, 1);
    LOADV(vB, 3); MMAV(vA, 2); LOADV(vA, 4); MMAV(vB, 3);
    LOADV(vB, 5); MMAV(vA, 4); LOADV(vA, 6); MMAV(vB, 5);
    LOADV(vB, 7); MMAV(vA, 6); LOADV(vA, 8); MMAV(vB, 7);
    LOADV(vB, 9); MMAV(vA, 8); LOADV(vA, 10); MMAV(vB, 9);
    LOADV(vB, 11); MMAV(vA, 10); LOADV(vA, 12); MMAV(vB, 11);
    LOADV(vB, 13); MMAV(vA, 12); LOADV(vA, 14); MMAV(vB, 13);
    LOADV(vB, 15); MMAV(vA, 14); MMAV(vB, 15);
#undef LOADV
#undef MMAV
    {
        const float il = 1.0f / lsum;
        const size_t rec = (mrow * NH + hd) * 4 + slot;
        bf16* op = Opart + rec * HD + 8 * hi;
#pragma unroll
        for (int c4 = 0; c4 < 4; ++c4)
#pragma unroll
            for (int g = 0; g < 4; g += 2) {
                unsigned a0 = pk2(O[c4][4 * g] * il, O[c4][4 * g + 1] * il), a1 = pk2(O[c4][4 * g + 2] * il, O[c4][4 * g + 3] * il);
                unsigned b0 = pk2(O[c4][4 * g + 4] * il, O[c4][4 * g + 5] * il), b1 = pk2(O[c4][4 * g + 6] * il, O[c4][4 * g + 7] * il);
                const auto r0 = __builtin_amdgcn_permlane32_swap(a0, b0, false, false); const auto r1 = __builtin_amdgcn_permlane32_swap(a1, b1, false, false);
                if (valid) *(v4u*)(op + 32 * c4 + 8 * g) = (v4u){r0[0], r1[0], r0[1], r1[1]};
            }
        if (valid && hi == 0) lse[rec] = mx + __builtin_log2f(lsum);
    }
}

__device__ __forceinline__ void attn_phase(LAS unsigned char* lds, volatile LAS unsigned* qslot, gu32* ctl, const bf16* Qb, const bf16* Kb, const bf16* Vb, bf16* Opart, float* lse, const unsigned* lists, int tid, int lane, int wave) {
    LAS unsigned char* Kimg = lds; LAS unsigned char* Vimg = lds + 65536;
    for (;;) {
        if (tid == 0) *qslot = __hip_atomic_fetch_add(ctl + CW_QUEUE, 1u, RLX_AGENT);
        __syncthreads();
        const int it = (int)*qslot;
        if (it >= NBLK * BATCH * NH) break;
        const int j = it >> 5, bh = it & 31, b = bh >> 3, hd = bh & 7;
        const size_t kvrow0 = (size_t)b * SEQ + (size_t)j * BS;
        int lane_d = lane; asm volatile("" : "+v"(lane_d));
#pragma unroll
        for (int i = 0; i < 8; ++i) {
            const int pc = i * 8 + wave, row = 4 * pc + (lane_d >> 4), ch = (lane_d & 15) ^ (((lane_d >> 4) << 2) | (pc & 3));
            const size_t src = (kvrow0 + row) * DM + hd * HD + ch * 8;
            __builtin_amdgcn_global_load_lds((const unsigned*)(Kb + src), (LAS unsigned*)(Kimg + pc * 1024), 16, 0, 0);
            __builtin_amdgcn_global_load_lds((const unsigned*)(Vb + src), (LAS unsigned*)(Vimg + pc * 1024), 16, 0, 0);
        }
        const int n = (int)__hip_atomic_load(ctl + CW_CNT + bh * 32 + j, RLX_AGENT);
        const unsigned* lb = lists + (size_t)bh * LIST_PER_BH + list_off(j);
        asm volatile("s_waitcnt vmcnt(0)" ::: "memory");
        __syncthreads();
        const int nch = 8 + ((n + 31) >> 5);
        {
            const int r32 = lane & 31, hi = lane >> 5;
            const size_t qcol = (size_t)hd * HD + 8 * hi;
            int c = wave;
            int tq = j * BS + c * 32 + r32, slot = 3; bool valid = true;
            bf16x8 qf[8];
            { const bf16* qp = Qb + ((size_t)b * SEQ + tq) * DM + qcol;
#pragma unroll
              for (int s = 0; s < 8; ++s) qf[s] = *(const bf16x8*)(qp + 16 * s); }
            while (c < nch) {
                const int cn = c + NWAVES; const bool has_next = cn < nch;
                const int e = (cn - 8) * 32 + r32; const bool valid_n = has_next && e < n;
                const unsigned ent = valid_n ? lb[e] : (unsigned)(j * BS);
                const bf16* qnext = has_next ? Qb + ((size_t)b * SEQ + (ent & 8191u)) * DM + qcol : nullptr;
                attn_wave_item(Kimg, Vimg, qf, qnext, Opart, lse, (size_t)b * SEQ + tq, hd, slot, valid, c < 8 ? c : 7, c < 8, lane);
                c = cn; tq = (int)(ent & 8191u); slot = (int)(ent >> 13); valid = valid_n;
            }
        }
        __syncthreads();
    }
}


__device__ __forceinline__ int fresh_lane() { int l = __builtin_amdgcn_mbcnt_hi(~0u, __builtin_amdgcn_mbcnt_lo(~0u, 0u)); asm volatile("" : "+v"(l)); return l; }
typedef const __attribute__((address_space(4))) Args* KArgs;
__device__ __forceinline__ KArgs get_args() { const __attribute__((address_space(4))) void* p = (const __attribute__((address_space(4))) void*)__builtin_amdgcn_kernarg_segment_ptr(); asm volatile("" : "+s"(p)); return (KArgs)p; }
#define GRID_BAR() do { XcdBarrier b_; b_.bar = (unsigned*)(get_args()->ws + WS_CTL) + CW_BAR; b_.x = xb_xcc_id(); b_.st = MISC + 8; const bool lead_ = (wave == 0) && (fresh_lane() == 0); xcd_barrier(b_, lead_); if (PROBE_MASK_V & (1u << 14)) xcd_barrier(b_, lead_); } while (0)

#ifndef PROBE_MASK_V
#define PROBE_MASK_V 0u
#endif
constexpr unsigned PROBE_MASK = PROBE_MASK_V;
#define PH_BEGIN() const unsigned long long t0_ = PROBE_MASK ? __builtin_amdgcn_s_memrealtime() : 0ull
#define PH_END(p) do { if (PROBE_MASK & (1u << (p))) { const unsigned long long t1_ = __builtin_amdgcn_s_memrealtime(); while (__builtin_amdgcn_s_memrealtime() - t1_ < t1_ - t0_) __builtin_amdgcn_s_sleep(8); } } while (0)
#define WSP(T, off) ((T*)(ws + (off)))
__global__ void __launch_bounds__(NWAVES * 64, 2) moba_fwd(Args args_unused) {
    extern __shared__ __attribute__((aligned(16))) unsigned char lds_raw[];
    LAS unsigned char* lds = (LAS unsigned char*)lds_raw;
    volatile LAS unsigned* MISC = (volatile LAS unsigned*)(lds + MISC_OFF);
    const int wave = __builtin_amdgcn_readfirstlane((int)threadIdx.x >> 6);
    const int G = gridDim.x; const int bx = blockIdx.x; const int vcu = (G % 8 == 0) ? (bx % 8) * (G / 8) + bx / 8 : bx;
    for (int u = threadIdx.x; u < (LDS_BYTES - LDSCTL_OFF) / 4; u += NWAVES * 64) ((LAS unsigned*)(lds + LDSCTL_OFF))[u] = 0u;
    __syncthreads();
    (void)xcd_barrier_post((unsigned*)(get_args()->ws + WS_CTL) + CW_BAR, MISC + 8);
    const int NGW = G * NWAVES;
    const int NGT = G * NWAVES * 64;
#define PHASE_IDS() int vcu_ = vcu; asm volatile("" : "+s"(vcu_)); const int lane = fresh_lane(), tid = wave * 64 + lane, gw = vcu_ * NWAVES + wave, gt = vcu_ * NWAVES * 64 + tid; (void)gt; (void)tid; (void)gw

    {
        PH_BEGIN(); PHASE_IDS();
        KArgs A = get_args(); unsigned char* ws = A->ws;
        const float* x = A->in[0]; const float* attn_norm = A->in[1]; const float* w_qkv = A->in[2]; const float* w_o = A->in[3];
        const float* conv_norm = A->in[4]; const float* w_ci = A->in[5]; const float* w_co = A->in[7];
        const float* ffn_norm = A->in[8]; const float* w_f1 = A->in[9]; const float* w_f2 = A->in[10];
        bf16* Wqkv_t = WSP(bf16, WS_WQKV); bf16* Wo_t = WSP(bf16, WS_WO); bf16* Wf1_t = WSP(bf16, WS_WF1); bf16* Wf2_t = WSP(bf16, WS_WF2); bf16* Wci_t = WSP(bf16, WS_WCI); bf16* Wco_t = WSP(bf16, WS_WCO);
        bf16* XB = WSP(bf16, WS_XB); float* ss0 = WSP(float, WS_SS0);
        LAS unsigned char* scr = lds + RING_OFF + wave * 16384;
        constexpr int I_QKV = (DM / 64) * (3 * DM / 64), I_O = (DM / 64) * (DM / 64), I_F1 = (DM / 64) * (2 * FF / 64), I_F2 = (FF / 64) * (DM / 64);
        constexpr int NITEMS = I_QKV + I_O + 2 * I_F1 + 2 * I_F2 + I_QKV + I_O;
        for (int it = gw; it < NITEMS; it += NGW) {
            int r = it;
            if (r < I_QKV) { const int nb = 3 * DM / 64, k0 = 64 * (r / nb), n0 = 64 * (r % nb); p0_item(w_qkv, 3 * DM, DM, k0, n0, Wqkv_t, n0, attn_norm, scr, lane); continue; } r -= I_QKV;
            if (r < I_O) { const int nb = DM / 64, k0 = 64 * (r / nb), n0 = 64 * (r % nb); p0_item(w_o, DM, DM, k0, n0, Wo_t, n0, nullptr, scr, lane); continue; } r -= I_O;
            if (r < 2 * I_F1) { const int L = r / I_F1; r -= L * I_F1; const int nb = 2 * FF / 64, k0 = 64 * (r / nb), n0 = 64 * (r % nb);
                p0_item(w_f1 + (size_t)L * DM * 2 * FF, 2 * FF, DM, k0, n0, Wf1_t + (size_t)L * 2 * FF * DM, interleave128(n0, FF), ffn_norm + L * DM, scr, lane); continue; } r -= 2 * I_F1;
            if (r < 2 * I_F2) { const int L = r / I_F2; r -= L * I_F2; const int nb = DM / 64, k0 = 64 * (r / nb), n0 = 64 * (r % nb);
                p0_item(w_f2 + (size_t)L * FF * DM, DM, FF, k0, n0, Wf2_t + (size_t)L * DM * FF, n0, nullptr, scr, lane); continue; } r -= 2 * I_F2;
            if (r < I_QKV) { const int nb = 3 * DM / 64, k0 = 64 * (r / nb), n0 = 64 * (r % nb);
                const int nd = n0 < DM ? 2 * DM + n0 : interleave128(n0 - DM, DM);
                p0_item(w_ci, 3 * DM, DM, k0, n0, Wci_t, nd, conv_norm, scr, lane); continue; } r -= I_QKV;
            { const int nb = DM / 64, k0 = 64 * (r / nb), n0 = 64 * (r % nb); p0_item(w_co, DM, DM, k0, n0, Wco_t, n0, nullptr, scr, lane); }
        }
        for (int i = gt; i < (int)(MiB / 16); i += NGT) ((v4u*)(ws + WS_KSUM))[i] = (v4u){0u, 0u, 0u, 0u};
        for (int m = gw; m < MROWS; m += 2 * NGW) {
            const int m2 = m + NGW;
            const bool has2 = m2 < MROWS; const int mb = has2 ? m2 : m;
            const f32x4* xa = (const f32x4*)(x + (size_t)m * DM) + lane; const f32x4* xc = (const f32x4*)(x + (size_t)mb * DM) + lane; f32x4 va[4], vc[4]; float sa = 0.f, sc = 0.f;
#pragma unroll
            for (int j = 0; j < 4; ++j) { va[j] = xa[64 * j]; vc[j] = xc[64 * j]; }
#pragma unroll
            for (int j = 0; j < 4; ++j) { sa += (va[j].x * va[j].x + va[j].y * va[j].y) + (va[j].z * va[j].z + va[j].w * va[j].w); sc += (vc[j].x * vc[j].x + vc[j].y * vc[j].y) + (vc[j].z * vc[j].z + vc[j].w * vc[j].w); }
            sa = wave_sum(sa); sc = wave_sum(sc);
            if (lane == 0) { ss0[m] = sa; if (has2) ss0[m2] = sc; }
            unsigned long long* oa = (unsigned long long*)(XB + (size_t)m * DM) + lane; unsigned long long* oc = (unsigned long long*)(XB + (size_t)mb * DM) + lane;
#pragma unroll
            for (int j = 0; j < 4; ++j) oa[64 * j] = (unsigned long long)pk2(va[j].x, va[j].y) | ((unsigned long long)pk2(va[j].z, va[j].w) << 32);
            if (has2) {
#pragma unroll
                for (int j = 0; j < 4; ++j) oc[64 * j] = (unsigned long long)pk2(vc[j].x, vc[j].y) | ((unsigned long long)pk2(vc[j].z, vc[j].w) << 32);
            }
        }
        PH_END(0);
    }
    GRID_BAR();

    {
        PH_BEGIN(); PHASE_IDS();
        unsigned char* ws = get_args()->ws;
        pg8::Gemm g{WSP(bf16, WS_XB), WSP(bf16, WS_WQKV), MROWS, 3 * DM, DM}; pg8::StaticOrder S; S.init(MROWS, 3 * DM, G, bx);
        pg8::EpiQKV E{WSP(bf16, WS_Q), (size_t)MROWS * DM, WSP(float, WS_SS0), WSP(float, WS_KSUM), QSCALE};
        pg8::gemm_phase<pg8::EpiQKV, pg8::StaticOrder, PG8_ALIGN, PG8_SP2>(lds + RING_OFF, g, S, E, wave);
        PH_END(1);
    }
    GRID_BAR();

    {
        PH_BEGIN(); PHASE_IDS();
        KArgs A = get_args(); unsigned char* ws = A->ws;
        for (int u = vcu_; u < BATCH * NBLK * NH; u += G) gate_unit(u >> 8, (u >> 3) & 31, u & 7, WSP(bf16, WS_Q), WSP(float, WS_KSUM), (gu32*)(ws + WS_CTL) + CW_CNT, (unsigned*)A->out + OUT_LIST_OFF, lds + RING_OFF, tid, lane, wave);
        PH_END(2);
    }
    GRID_BAR();
    {
        PH_BEGIN(); PHASE_IDS();
        KArgs A = get_args(); unsigned char* ws = A->ws;
        attn_phase(lds + RING_OFF, MISC + 16, (gu32*)(ws + WS_CTL), WSP(bf16, WS_Q), WSP(bf16, WS_K), WSP(bf16, WS_V), WSP(bf16, WS_XB), A->out + OUT_LSE_OFF, (const unsigned*)A->out + OUT_LIST_OFF, tid, lane, wave);
        PH_END(3);
    }
    GRID_BAR();
    {
        PH_BEGIN(); PHASE_IDS();
        KArgs A = get_args(); unsigned char* ws = A->ws;
        const float* lse = A->out + OUT_LSE_OFF; const bf16* Opart = WSP(bf16, WS_XB); bf16* Qb = WSP(bf16, WS_Q);
        for (int base = gt; base < MROWS * NH * 16; base += 4 * NGT) {
            f32x4 L[4]; v4u o[4][4]; int mhv[4];
#pragma unroll
            for (int q = 0; q < 4; ++q) { const int idx = base + q * NGT; mhv[q] = (idx < MROWS * NH * 16 ? idx : base) >> 4; L[q] = *(const f32x4*)(lse + (size_t)mhv[q] * 4); }
#pragma unroll
            for (int q = 0; q < 4; ++q) { const bf16* op = Opart + (size_t)mhv[q] * 4 * HD + (gt & 15) * 8;
#pragma unroll
                for (int k = 0; k < 4; ++k) o[q][k] = *(const v4u*)(op + k * HD); }
#pragma unroll
            for (int q = 0; q < 4; ++q) {
                const int idx = base + q * NGT; if (idx >= MROWS * NH * 16) break;
                const int mh = mhv[q], piece = gt & 15, m = mh >> 3, ib = (m & (SEQ - 1)) >> 8, nsel = ib < 3 ? ib : 3;
                float mx = L[q][3]; if (nsel > 0) mx = fmaxf(mx, L[q][0]); if (nsel > 1) mx = fmaxf(mx, L[q][1]); if (nsel > 2) mx = fmaxf(mx, L[q][2]);
                float w[4]; w[3] = __builtin_amdgcn_exp2f(L[q][3] - mx);
#pragma unroll
                for (int k = 0; k < 3; ++k) w[k] = nsel > k ? __builtin_amdgcn_exp2f(L[q][k] - mx) : 0.f;
                float a8[8];
#pragma unroll
                for (int e = 0; e < 8; ++e) a8[e] = 0.f;
#pragma unroll
                for (int k = 0; k < 4; ++k) { const bool ok = (k == 3 || nsel > k);
#pragma unroll
                    for (int e = 0; e < 4; ++e) { const unsigned wd = ok ? o[q][k][e] : 0u; a8[2 * e] += w[k] * bf_lo(wd); a8[2 * e + 1] += w[k] * bf_hi(wd); } }
                const float inv = 1.0f / ((w[0] + w[1]) + (w[2] + w[3]));
                v4u y;
#pragma unroll
                for (int e = 0; e < 4; ++e) y[e] = pk2(a8[2 * e] * inv, a8[2 * e + 1] * inv);
                *(v4u*)(Qb + (size_t)m * DM + (mh & 7) * HD + piece * 8) = y;
            }
        }
        PH_END(4);
    }
    GRID_BAR();

    {
        PH_BEGIN(); PHASE_IDS();
        KArgs A = get_args(); unsigned char* ws = A->ws;
        pg8::Gemm g{WSP(bf16, WS_Q), WSP(bf16, WS_WO), MROWS, DM, DM}; pg8::StaticOrder S; S.init(MROWS, DM, G, bx);
        pg8::EpiRes<true, true> E{A->in[0], WSP(bf16, WS_XB), WSP(float, WS_SS)};
        pg8::gemm_phase<pg8::EpiRes<true, true>, pg8::StaticOrder, PG8_ALIGN, PG8_SP2>(lds + RING_OFF, g, S, E, wave);
        PH_END(5);
    }
    GRID_BAR();

    {
        PH_BEGIN(); PHASE_IDS();
        unsigned char* ws = get_args()->ws;
        pg8::Gemm g{WSP(bf16, WS_XB), WSP(bf16, WS_WF1), MROWS, 2 * FF, DM}; pg8::StaticOrder S; S.init(MROWS, 2 * FF, G, bx);
        pg8::EpiSwiglu E{WSP(bf16, WS_H), FF, WSP(float, WS_SS)};
        pg8::gemm_phase<pg8::EpiSwiglu, pg8::StaticOrder, PG8_ALIGN, PG8_SP2>(lds + RING_OFF, g, S, E, wave);
        PH_END(6);
    }
    GRID_BAR();
    {
        PH_BEGIN(); PHASE_IDS();
        KArgs A = get_args(); unsigned char* ws = A->ws;
        pg8::Gemm g{WSP(bf16, WS_H), WSP(bf16, WS_WF2), MROWS, DM, FF}; pg8::StaticOrder S; S.init(MROWS, DM, G, bx);
        pg8::EpiRes<false, true> E{nullptr, WSP(bf16, WS_XB), WSP(float, WS_SS) + MROWS};
        pg8::gemm_phase<pg8::EpiRes<false, true>, pg8::StaticOrder, PG8_ALIGN, PG8_SP2>(lds + RING_OFF, g, S, E, wave);
        PH_END(7);
    }
    GRID_BAR();

    {
        PH_BEGIN(); PHASE_IDS();
        unsigned char* ws = get_args()->ws;
        pg8::Gemm g{WSP(bf16, WS_XB), WSP(bf16, WS_WCI), MROWS, 3 * DM, DM}; pg8::StaticOrder S; S.init(MROWS, 3 * DM, G, bx);
        pg8::EpiConvIn E{WSP(bf16, WS_Q), WSP(bf16, WS_K), WSP(float, WS_SS) + MROWS};
        pg8::gemm_phase<pg8::EpiConvIn, pg8::StaticOrder, PG8_ALIGN, PG8_SP2>(lds + RING_OFF, g, S, E, wave);
        PH_END(8);
    }
    GRID_BAR();

    {
        PH_BEGIN(); PHASE_IDS();
        KArgs A = get_args(); unsigned char* ws = A->ws; const float* conv_w = A->in[6];
        const bf16* Qb = WSP(bf16, WS_Q); const bf16* Kb = WSP(bf16, WS_K); bf16* Vb = WSP(bf16, WS_V);
        const int c8 = (gt & 127) * 8;
        const f32x4 w0a = *(const f32x4*)(conv_w + c8), w0b = *(const f32x4*)(conv_w + c8 + 4), w1a = *(const f32x4*)(conv_w + DM + c8), w1b = *(const f32x4*)(conv_w + DM + c8 + 4),
                    w2a = *(const f32x4*)(conv_w + 2 * DM + c8), w2b = *(const f32x4*)(conv_w + 2 * DM + c8 + 4);
        for (int base = gt; base < MROWS * (DM / 8); base += 4 * NGT) {
            v4u u2[4], u1[4], u0[4], bb[4]; size_t offs[4]; bool okq[4];
#pragma unroll
            for (int q = 0; q < 4; ++q) {
                const int idx = base + q * NGT; okq[q] = idx < MROWS * (DM / 8); const int m = (okq[q] ? idx : base) >> 7, t = m & (SEQ - 1);
                offs[q] = (size_t)m * DM + c8;
                u2[q] = *(const v4u*)(Qb + offs[q]); bb[q] = *(const v4u*)(Kb + offs[q]);
                u1[q] = (v4u){0u, 0u, 0u, 0u}; u0[q] = (v4u){0u, 0u, 0u, 0u};
                if (t >= 1) u1[q] = *(const v4u*)(Qb + offs[q] - DM);
                if (t >= 2) u0[q] = *(const v4u*)(Qb + offs[q] - 2 * DM);
            }
#pragma unroll
            for (int q = 0; q < 4; ++q) {
                v4u y;
#pragma unroll
                for (int e = 0; e < 4; ++e) {
                    const float wl0 = e < 2 ? w0a[2 * e] : w0b[2 * e - 4], wh0 = e < 2 ? w0a[2 * e + 1] : w0b[2 * e - 3];
                    const float wl1 = e < 2 ? w1a[2 * e] : w1b[2 * e - 4], wh1 = e < 2 ? w1a[2 * e + 1] : w1b[2 * e - 3];
                    const float wl2 = e < 2 ? w2a[2 * e] : w2b[2 * e - 4], wh2 = e < 2 ? w2a[2 * e + 1] : w2b[2 * e - 3];
                    const float lo = bf_lo(bb[q][e]) * (wl0 * bf_lo(u0[q][e]) + wl1 * bf_lo(u1[q][e]) + wl2 * bf_lo(u2[q][e]));
                    const float hi = bf_hi(bb[q][e]) * (wh0 * bf_hi(u0[q][e]) + wh1 * bf_hi(u1[q][e]) + wh2 * bf_hi(u2[q][e]));
                    y[e] = pk2(lo, hi);
                }
                if (okq[q]) *(v4u*)(Vb + offs[q]) = y;
            }
        }
        PH_END(9);
    }
    GRID_BAR();

    {
        PH_BEGIN(); PHASE_IDS();
        KArgs A = get_args(); unsigned char* ws = A->ws;
        pg8::Gemm g{WSP(bf16, WS_V), WSP(bf16, WS_WCO), MROWS, DM, DM}; pg8::StaticOrder S; S.init(MROWS, DM, G, bx);
        pg8::EpiRes<false, true> E{nullptr, WSP(bf16, WS_XB), WSP(float, WS_SS) + 2 * MROWS};
        pg8::gemm_phase<pg8::EpiRes<false, true>, pg8::StaticOrder, PG8_ALIGN, PG8_SP2>(lds + RING_OFF, g, S, E, wave);
        PH_END(10);
    }
    GRID_BAR();

    {
        PH_BEGIN(); PHASE_IDS();
        unsigned char* ws = get_args()->ws;
        pg8::Gemm g{WSP(bf16, WS_XB), WSP(bf16, WS_WF1) + (size_t)2 * FF * DM, MROWS, 2 * FF, DM}; pg8::StaticOrder S; S.init(MROWS, 2 * FF, G, bx);
        pg8::EpiSwiglu E{WSP(bf16, WS_H), FF, WSP(float, WS_SS) + 2 * MROWS};
        pg8::gemm_phase<pg8::EpiSwiglu, pg8::StaticOrder, PG8_ALIGN, PG8_SP2>(lds + RING_OFF, g, S, E, wave);
        PH_END(11);
    }
    GRID_BAR();
    {
        PH_BEGIN(); PHASE_IDS();
        KArgs A = get_args(); unsigned char* ws = A->ws;
        pg8::Gemm g{WSP(bf16, WS_H), WSP(bf16, WS_WF2) + (size_t)DM * FF, MROWS, DM, FF}; pg8::StaticOrder S; S.init(MROWS, DM, G, bx);
        pg8::EpiRes<false, false> E{nullptr, WSP(bf16, WS_XB), nullptr};
        pg8::gemm_phase<pg8::EpiRes<false, false>, pg8::StaticOrder, PG8_ALIGN, PG8_SP2>(lds + RING_OFF, g, S, E, wave);
        PH_END(12);
    }
    GRID_BAR();

    {
        PH_BEGIN(); PHASE_IDS();
        KArgs A = get_args(); float* out = A->out; const float* final_norm = A->in[11]; const bf16* XB = (const bf16*)(A->ws + WS_XB);
        const f32x4* gr = (const f32x4*)final_norm + lane; f32x4 gg[4];
#pragma unroll
        for (int j = 0; j < 4; ++j) gg[j] = gr[64 * j];
        for (int m = gw; m < MROWS; m += 2 * NGW) {
            const int m2 = m + NGW; const bool has2 = m2 < MROWS; const int mb = has2 ? m2 : m;
            const uint2* xa = (const uint2*)(XB + (size_t)m * DM) + lane; const uint2* xc = (const uint2*)(XB + (size_t)mb * DM) + lane; uint2 pa[4], pc[4];
#pragma unroll
            for (int j = 0; j < 4; ++j) { pa[j] = xa[64 * j]; pc[j] = xc[64 * j]; }
            f32x4 va[4], vc[4]; float sa = 0.f, sc = 0.f;
#pragma unroll
            for (int j = 0; j < 4; ++j) { va[j] = (f32x4){bf_lo(pa[j].x), bf_hi(pa[j].x), bf_lo(pa[j].y), bf_hi(pa[j].y)}; vc[j] = (f32x4){bf_lo(pc[j].x), bf_hi(pc[j].x), bf_lo(pc[j].y), bf_hi(pc[j].y)};
                sa += (va[j].x * va[j].x + va[j].y * va[j].y) + (va[j].z * va[j].z + va[j].w * va[j].w); sc += (vc[j].x * vc[j].x + vc[j].y * vc[j].y) + (vc[j].z * vc[j].z + vc[j].w * vc[j].w); }
            const float ra = __builtin_amdgcn_rsqf(wave_sum(sa) * (1.0f / DM) + EPS), rc = __builtin_amdgcn_rsqf(wave_sum(sc) * (1.0f / DM) + EPS);
            f32x4* oa = (f32x4*)(out + (size_t)m * DM) + lane; f32x4* oc = (f32x4*)(out + (size_t)mb * DM) + lane;
#pragma unroll
            for (int j = 0; j < 4; ++j) oa[64 * j] = va[j] * ra * gg[j];
            if (has2) {
#pragma unroll
                for (int j = 0; j < 4; ++j) oc[64 * j] = vc[j] * rc * gg[j];
            }
        }
        PH_END(13);
    }
}

extern "C" void kernel_launch(void* const* d_in, const int* in_sizes, int n_in, void* d_out, int out_size, void* d_ws, size_t ws_size, hipStream_t stream) {
    static int grid = 0;
    if (grid == 0) {
        if (n_in != 12 || in_sizes[0] != MROWS * DM || out_size != MROWS * DM || ws_size < WS_END) {
            fprintf(stderr, "kernel_launch: unexpected shapes (n_in %d, in0 %d, out %d, ws %zu); nothing launched\n", n_in, n_in > 0 ? in_sizes[0] : -1, out_size, ws_size); grid = -1; return; }
        int dev = 0, cus = 0, per_cu = 0;
        if (hipGetDevice(&dev) != hipSuccess || hipDeviceGetAttribute(&cus, hipDeviceAttributeMultiprocessorCount, dev) != hipSuccess) { grid = -1; return; }
        if (hipFuncSetAttribute((const void*)moba_fwd, hipFuncAttributeMaxDynamicSharedMemorySize, LDS_BYTES) != hipSuccess) { fprintf(stderr, "kernel_launch: hipFuncSetAttribute failed\n"); grid = -1; return; }
        if (hipOccupancyMaxActiveBlocksPerMultiprocessor(&per_cu, (const void*)moba_fwd, NWAVES * 64, LDS_BYTES) != hipSuccess || per_cu < 1) {
            fprintf(stderr, "kernel_launch: occupancy query reports %d blocks per CU; nothing launched\n", per_cu); (void)hipGetLastError(); grid = -1; return; }
        grid = cus;
    }
    if (grid < 0) return;
    if (hipMemsetAsync((char*)d_ws + WS_CTL, 0, CTL_ZERO_BYTES, stream) != hipSuccess) return;
    Args a{};
    for (int i = 0; i < 12; ++i) a.in[i] = (const float*)d_in[i];
    a.out = (float*)d_out; a.ws = (unsigned char*)d_ws;
    hipLaunchKernelGGL(moba_fwd, dim3(grid), dim3(NWAVES * 64), LDS_BYTES, stream, a);
}
```

```cpp
#include <hip/hip_runtime.h>
#include <cstdio>
#include <cstdint>
#define PROBE_MASK_V 0u
namespace pg8 {
#define PG8_LAS __attribute__((address_space(3)))
typedef unsigned short bf16_t;
typedef short bf16x8 __attribute__((ext_vector_type(8)));
typedef float f32x4 __attribute__((ext_vector_type(4)));
typedef unsigned u32x4 __attribute__((ext_vector_type(4)));
constexpr int BM = 256, BK = 64, HALF = 128, HTB = HALF * BK * 2  , STAGE_BYTES = 8 * HTB, NXCD = 8, WGM = 8;

__host__ __device__ __forceinline__ int lds_byte(int r, int c) { const int st = (r >> 4) * 2 + (c >> 5), rr = r & 15, cc = c & 31, ob = rr * 64 + cc * 2; return st * 1024 + (ob ^ (((ob >> 9) & 1) << 5)); }
__host__ __device__ __forceinline__ void stage_rc(int b, int& R, int& C) { const int st = b / 1024, sb = b % 1024, swz = sb ^ (((sb >> 9) & 1) << 5); R = (st >> 1) * 16 + swz / 64; C = (st & 1) * 32 + (swz % 64) / 2; }
__host__ __device__ __forceinline__ int perm32(int rho) { const int n = rho >> 4, i = rho & 15; return 8 * (i >> 2) + 4 * n + (i & 3); }

struct Unit { int pm, pn; };
struct Gemm { const bf16_t* A; const bf16_t* Bt; int M, N, K; };

struct StaticOrder {
    int nM, nN, nwg, G, c, wgm;
    __host__ __device__ void init(int M, int N, int G_, int c_, int wgm_ = WGM) { nM = M / BM; nN = N / BM; nwg = nM * nN; G = G_; c = c_; wgm = wgm_; }
    __host__ __device__ bool next(int i, Unit& u) const {
        const long L = (long)i * G + c; if (L >= nwg) return false;
        int wgid = (int)L; { const int q = nwg / NXCD, r = nwg % NXCD, xcd = wgid % NXCD, off = wgid / NXCD; wgid = (xcd < r ? xcd * (q + 1) : r * (q + 1) + (xcd - r) * q) + off; }
        const int nig = wgm * nN, gid = wgid / nig, fm = gid * wgm, gsz = (nM - fm) < wgm ? (nM - fm) : wgm;
        u.pm = fm + ((wgid % nig) % gsz); u.pn = (wgid % nig) / gsz; return true;
    }
    __device__ __forceinline__ void a_ready(const Unit&) const {}
    __device__ __forceinline__ void done(const Unit&) const {}
};

__device__ __forceinline__ unsigned cvt_pk_bf16(float lo, float hi) { unsigned r; asm volatile("v_cvt_pk_bf16_f32 %0, %1, %2" : "=v"(r) : "v"(lo), "v"(hi)); return r; }
constexpr int   ROWLEN = 1024;
constexpr float RMS_EPS = 1e-6f, INV_D = 1.0f / 1024.0f;
__device__ __forceinline__ u32x4 pack8(const f32x4 a, const f32x4 b) { u32x4 w; w.x = cvt_pk_bf16(a[0], a[1]); w.y = cvt_pk_bf16(a[2], a[3]); w.z = cvt_pk_bf16(b[0], b[1]); w.w = cvt_pk_bf16(b[2], b[3]); return w; }
__device__ __forceinline__ float rowscale(const float* ss, int row) { return __builtin_amdgcn_rsqf(ss[row] * INV_D + RMS_EPS); }

struct EpiQKV {
    static constexpr bool PERM = true, AFTER_DRAIN = false;
    bf16_t* Q; size_t tstride; const float* ss; float* ksum; float qscale;
    __device__ __forceinline__ void prefetch(float (&pfr)[8], const Unit& u, int wr, int fr) const {
#pragma unroll
        for (int ai = 0; ai < 2; ++ai)
#pragma unroll
            for (int m = 0; m < 4; ++m) pfr[ai * 4 + m] = ss[u.pm * BM + ai * HALF + wr * 64 + m * 16 + fr];
    }
    __device__ __forceinline__ void operator()(const f32x4 (&acc)[2][2][4][2], const Unit& u, int wr, int wc, int fr, int fq) const {
        float pfr[8]; prefetch(pfr, u, wr, fr);
        const int t = u.pn >> 2, colt = (u.pn & 3) * BM + wc * 32 + 8 * fq;
        bf16_t* base = Q + (size_t)t * tstride;
        const float sc = (t == 0) ? qscale : 1.0f;
        f32x4 cs[2][2];
#pragma unroll
        for (int bj = 0; bj < 2; ++bj)
#pragma unroll
            for (int n = 0; n < 2; ++n) cs[bj][n] = (f32x4){0.f, 0.f, 0.f, 0.f};
#pragma unroll
        for (int ai = 0; ai < 2; ++ai)
#pragma unroll
            for (int m = 0; m < 4; ++m) {
                const int row = u.pm * BM + ai * HALF + wr * 64 + m * 16 + fr;
                const float r = __builtin_amdgcn_rsqf(pfr[ai * 4 + m] * INV_D + RMS_EPS) * sc;
#pragma unroll
                for (int bj = 0; bj < 2; ++bj) {
                    const f32x4 v0 = acc[ai][bj][m][0] * r, v1 = acc[ai][bj][m][1] * r;
                    cs[bj][0] += v0; cs[bj][1] += v1;
                    *(u32x4*)(base + (size_t)row * ROWLEN + colt + bj * HALF) = pack8(v0, v1);
                }
            }
        if (t == 1) {
#pragma unroll
            for (int bj = 0; bj < 2; ++bj)
#pragma unroll
                for (int n = 0; n < 2; ++n)
#pragma unroll
                    for (int e = 0; e < 4; ++e) {
                        float s = cs[bj][n][e];
                        s += __shfl_xor(s, 1); s += __shfl_xor(s, 2); s += __shfl_xor(s, 4); s += __shfl_xor(s, 8);
                        if (fr == 0) atomicAdd(ksum + (size_t)u.pm * ROWLEN + colt + bj * HALF + 4 * n + e, s);
                    }
        }
    }
};

template <bool F32IN, bool WANT_SS> struct EpiRes {
    static constexpr bool PERM = true, AFTER_DRAIN = false;
    const float* xin; bf16_t* xb; float* ss;
    __device__ __forceinline__ void prefetch(float (&pfr)[8], const Unit&, int, int) const {
#pragma unroll
        for (int i = 0; i < 8; ++i) pfr[i] = 0.f;
    }
    __device__ __forceinline__ void operator()(const f32x4 (&acc)[2][2][4][2], const Unit& u, int wr, int wc, int fr, int fq) const {
        float pfr[8]; prefetch(pfr, u, wr, fr);
        const int col0 = u.pn * BM + wc * 32 + 8 * fq;
        if (F32IN) {
#pragma unroll
            for (int ai = 0; ai < 2; ++ai) {
                f32x4 pre[4][2][2];
#pragma unroll
                for (int m = 0; m < 4; ++m)
#pragma unroll
                    for (int bj = 0; bj < 2; ++bj) { const size_t off = (size_t)(u.pm * BM + ai * HALF + wr * 64 + m * 16 + fr) * ROWLEN + col0 + bj * HALF; pre[m][bj][0] = *(const f32x4*)(xin + off); pre[m][bj][1] = *(const f32x4*)(xin + off + 4); }
#pragma unroll
                for (int m = 0; m < 4; ++m) {
                    const int row = u.pm * BM + ai * HALF + wr * 64 + m * 16 + fr;
                    float sq = 0.f;
#pragma unroll
                    for (int bj = 0; bj < 2; ++bj) {
                        const size_t off = (size_t)row * ROWLEN + col0 + bj * HALF;
                        const f32x4 v0 = pre[m][bj][0] + acc[ai][bj][m][0], v1 = pre[m][bj][1] + acc[ai][bj][m][1];
                        *(u32x4*)(xb + off) = pack8(v0, v1);
                        if (WANT_SS) sq += (v0[0] * v0[0] + v0[1] * v0[1]) + (v0[2] * v0[2] + v0[3] * v0[3]) + (v1[0] * v1[0] + v1[1] * v1[1]) + (v1[2] * v1[2] + v1[3] * v1[3]);
                    }
                    if (WANT_SS) { sq += __shfl_xor(sq, 16); sq += __shfl_xor(sq, 32); if (fq == 0) atomicAdd(ss + row, sq); }
                }
            }
        } else {
            u32x4 pre[2][4][2];
#pragma unroll
            for (int ai = 0; ai < 2; ++ai)
#pragma unroll
                for (int m = 0; m < 4; ++m)
#pragma unroll
                    for (int bj = 0; bj < 2; ++bj) pre[ai][m][bj] = *(const u32x4*)(xb + (size_t)(u.pm * BM + ai * HALF + wr * 64 + m * 16 + fr) * ROWLEN + col0 + bj * HALF);
#pragma unroll
            for (int ai = 0; ai < 2; ++ai)
#pragma unroll
                for (int m = 0; m < 4; ++m) {
                    const int row = u.pm * BM + ai * HALF + wr * 64 + m * 16 + fr;
                    float sq = 0.f;
#pragma unroll
                    for (int bj = 0; bj < 2; ++bj) {
                        const size_t off = (size_t)row * ROWLEN + col0 + bj * HALF;
                        const u32x4 p = pre[ai][m][bj];
                        const f32x4 x0 = (f32x4){__uint_as_float(p.x << 16), __uint_as_float(p.x & 0xffff0000u), __uint_as_float(p.y << 16), __uint_as_float(p.y & 0xffff0000u)};
                        const f32x4 x1 = (f32x4){__uint_as_float(p.z << 16), __uint_as_float(p.z & 0xffff0000u), __uint_as_float(p.w << 16), __uint_as_float(p.w & 0xffff0000u)};
                        const f32x4 v0 = x0 + acc[ai][bj][m][0], v1 = x1 + acc[ai][bj][m][1];
                        *(u32x4*)(xb + off) = pack8(v0, v1);
                        if (WANT_SS) sq += (v0[0] * v0[0] + v0[1] * v0[1]) + (v0[2] * v0[2] + v0[3] * v0[3]) + (v1[0] * v1[0] + v1[1] * v1[1]) + (v1[2] * v1[2] + v1[3] * v1[3]);
                    }
                    if (WANT_SS) { sq += __shfl_xor(sq, 16); sq += __shfl_xor(sq, 32); if (fq == 0) atomicAdd(ss + row, sq); }
                }
        }
    }
};

struct EpiSwiglu {
    static constexpr bool PERM = true, AFTER_DRAIN = false;
    bf16_t* Hh; int ldh; const float* ss;
    __device__ __forceinline__ void prefetch(float (&pfr)[8], const Unit& u, int wr, int fr) const {
#pragma unroll
        for (int ai = 0; ai < 2; ++ai)
#pragma unroll
            for (int m = 0; m < 4; ++m) pfr[ai * 4 + m] = ss[u.pm * BM + ai * HALF + wr * 64 + m * 16 + fr];
    }
    __device__ __forceinline__ void operator()(const f32x4 (&acc)[2][2][4][2], const Unit& u, int wr, int wc, int fr, int fq) const {
        float pfr[8]; prefetch(pfr, u, wr, fr);
        const int col0 = u.pn * HALF + wc * 32 + 8 * fq;
#pragma unroll
        for (int ai = 0; ai < 2; ++ai)
#pragma unroll
            for (int m = 0; m < 4; ++m) {
                const int row = u.pm * BM + ai * HALF + wr * 64 + m * 16 + fr;
                const float r = __builtin_amdgcn_rsqf(pfr[ai * 4 + m] * INV_D + RMS_EPS);
                f32x4 hv[2];
#pragma unroll
                for (int n = 0; n < 2; ++n) {
                    const f32x4 g = acc[ai][0][m][n] * r, uu = acc[ai][1][m][n] * r;
#pragma unroll
                    for (int e = 0; e < 4; ++e) hv[n][e] = g[e] * uu[e] * __builtin_amdgcn_rcpf(1.0f + __builtin_amdgcn_exp2f(g[e] * -1.4426950408889634f));
                }
                *(u32x4*)(Hh + (size_t)row * ldh + col0) = pack8(hv[0], hv[1]);
            }
    }
};

struct EpiConvIn {
    static constexpr bool PERM = true, AFTER_DRAIN = false;
    bf16_t* U; bf16_t* Bb; const float* ss;
    __device__ __forceinline__ void prefetch(float (&pfr)[8], const Unit& u, int wr, int fr) const {
#pragma unroll
        for (int ai = 0; ai < 2; ++ai)
#pragma unroll
            for (int m = 0; m < 4; ++m) pfr[ai * 4 + m] = ss[u.pm * BM + ai * HALF + wr * 64 + m * 16 + fr];
    }
    __device__ __forceinline__ void operator()(const f32x4 (&acc)[2][2][4][2], const Unit& u, int wr, int wc, int fr, int fq) const {
        float pfr[8]; prefetch(pfr, u, wr, fr);
#pragma unroll
        for (int ai = 0; ai < 2; ++ai)
#pragma unroll
            for (int m = 0; m < 4; ++m) {
                const int row = u.pm * BM + ai * HALF + wr * 64 + m * 16 + fr;
                const float r = __builtin_amdgcn_rsqf(pfr[ai * 4 + m] * INV_D + RMS_EPS);
                if (u.pn < 8) {
                    const float r2 = r * r;
                    const f32x4 a = acc[ai][0][m][0] * acc[ai][1][m][0] * r2, b = acc[ai][0][m][1] * acc[ai][1][m][1] * r2;
                    *(u32x4*)(U + (size_t)row * ROWLEN + u.pn * HALF + wc * 32 + 8 * fq) = pack8(a, b);
                } else {
#pragma unroll
                    for (int bj = 0; bj < 2; ++bj)
                        *(u32x4*)(Bb + (size_t)row * ROWLEN + (u.pn - 8) * BM + bj * HALF + wc * 32 + 8 * fq) = pack8(acc[ai][bj][m][0] * r, acc[ai][bj][m][1] * r);
                }
            }
    }
};

template <class Epi, class Sched, bool ALIGN_EPI = false, bool SP2 = false>
__device__ __forceinline__ void gemm_phase(PG8_LAS unsigned char* lds, const Gemm g, const Sched& S, const Epi& E, const int wave_id) {
    int lane_ = __builtin_amdgcn_mbcnt_hi(~0u, __builtin_amdgcn_mbcnt_lo(~0u, 0u)); asm volatile("" : "+v"(lane_));
    const int wid = wave_id, tid = wid * 64 + lane_, lane = lane_, wr = wid >> 2, wc = wid & 3, fr = lane & 15, fq = lane >> 4;
    const int K = g.K, nt = K / BK;
    unsigned voffA[2], voffB[2];
#pragma unroll
    for (int i = 0; i < 2; ++i) { int R, C; stage_rc(tid * 16 + i * 8192, R, C); const int Rb = Epi::PERM ? ((R & ~31) + perm32(R & 31)) : R;
        voffA[i] = (unsigned)(R * K + C) * 2u; voffB[i] = (unsigned)(Rb * K + C) * 2u; }
    const size_t kstep = (size_t)(BK * 2);
    const size_t hstep = (size_t)HALF * K * 2;
    const size_t tstep = 2 * hstep;
    const unsigned ldsw = (unsigned)wid * 1024u;
    const int aoff = lds_byte(wr * 64 + fr, fq * 8), boff = lds_byte(wc * 32 + fr, fq * 8);
#define PG8_SA(b, h) (((b) * 2 + (h)) * HTB)
#define PG8_SB(b, h) ((4 + (b) * 2 + (h)) * HTB)
#define PG8_STAGE(bufoff, gbase, voff) do { _Pragma("unroll") for (int _i = 0; _i < 2; ++_i) \
        __builtin_amdgcn_global_load_lds((const unsigned*)((const char*)(gbase) + (voff)[_i]), (PG8_LAS unsigned*)(lds + (bufoff) + ldsw + _i * 8192), 16, 0, 0); } while (0)
#define PG8_LDA(dst, b, h) do { _Pragma("unroll") for (int m = 0; m < 4; ++m) _Pragma("unroll") for (int k = 0; k < 2; ++k) dst[m][k] = *(const PG8_LAS bf16x8*)(lds + PG8_SA(b, h) + aoff + m * 2048 + k * 1024); } while (0)
#define PG8_LDB(dst, b, h) do { _Pragma("unroll") for (int n = 0; n < 2; ++n) _Pragma("unroll") for (int k = 0; k < 2; ++k) dst[n][k] = *(const PG8_LAS bf16x8*)(lds + PG8_SB(b, h) + boff + n * 2048 + k * 1024); } while (0)
#define PG8_MMA(ai, bj, At, Bt) do { __builtin_amdgcn_s_setprio(1); _Pragma("unroll") for (int m = 0; m < 4; ++m) _Pragma("unroll") for (int n = 0; n < 2; ++n) _Pragma("unroll") for (int k = 0; k < 2; ++k) \
        acc[ai][bj][m][n] = __builtin_amdgcn_mfma_f32_16x16x32_bf16(Bt[n][k], At[m][k], acc[ai][bj][m][n], 0, 0, 0); __builtin_amdgcn_s_setprio(0); } while (0)
#define PG8_WAIT_V(n) asm volatile("s_waitcnt vmcnt(" #n ")" ::: "memory")
#define PG8_WAIT_L(n) asm volatile("s_waitcnt lgkmcnt(" #n ")" ::: "memory")
#define PG8_BAR __builtin_amdgcn_s_barrier()
#define PG8_SCHED __builtin_amdgcn_sched_barrier(0)
    Unit cur, nxt; int ui = 0;
    if (!S.next(0, cur)) return;
    f32x4 acc[2][2][4][2];
#pragma unroll
    for (int a = 0; a < 2; ++a)
#pragma unroll
        for (int b = 0; b < 2; ++b)
#pragma unroll
            for (int m = 0; m < 4; ++m)
#pragma unroll
                for (int n = 0; n < 2; ++n) acc[a][b][m][n] = (f32x4){0.f, 0.f, 0.f, 0.f};
    bf16x8 At[4][2], B0[2][2], B1[2][2];
    const char* cA = (const char*)g.A + (size_t)cur.pm * tstep; const char* cB = (const char*)g.Bt + (size_t)cur.pn * tstep;
    S.a_ready(cur);
    if constexpr (SP2) {
        PG8_STAGE(PG8_SB(0, 0), cB, voffB); PG8_STAGE(PG8_SB(0, 1), cB + hstep, voffB); PG8_STAGE(PG8_SA(0, 0), cA, voffA); PG8_STAGE(PG8_SA(0, 1), cA + hstep, voffA);
        if (wr == 1) PG8_BAR;
        PG8_WAIT_V(2); PG8_BAR;
        PG8_STAGE(PG8_SB(1, 0), cB + kstep, voffB); PG8_STAGE(PG8_SA(1, 0), cA + kstep, voffA); PG8_STAGE(PG8_SB(1, 1), cB + hstep + kstep, voffB);
        PG8_WAIT_V(6); PG8_BAR;
    } else {
        PG8_STAGE(PG8_SB(0, 0), cB, voffB); PG8_STAGE(PG8_SA(0, 0), cA, voffA); PG8_STAGE(PG8_SB(0, 1), cB + hstep, voffB); PG8_STAGE(PG8_SA(0, 1), cA + hstep, voffA);
        if (wr == 1) PG8_BAR;
        PG8_WAIT_V(4); PG8_BAR;
        PG8_STAGE(PG8_SB(1, 0), cB + kstep, voffB); PG8_STAGE(PG8_SA(1, 0), cA + kstep, voffA); PG8_STAGE(PG8_SB(1, 1), cB + hstep + kstep, voffB);
        PG8_WAIT_V(6); PG8_BAR;
    }
    for (;;) {
        const bool has_next = S.next(ui + 1, nxt);
        const char* nA = has_next ? (const char*)g.A + (size_t)nxt.pm * tstep : cA; const char* nB = has_next ? (const char*)g.Bt + (size_t)nxt.pn * tstep : cB;
        for (int t = 0; t < nt; t += 2) {
            const bool last = (t == nt - 2);
            const char* a1 = cA + (size_t)(t + 1) * kstep;
            const char* a2 = last ? nA : cA + (size_t)(t + 2) * kstep; const char* b2 = last ? nB : cB + (size_t)(t + 2) * kstep;
            const char* a3 = a2 + kstep; const char* b3 = b2 + kstep;
            if (last && has_next) S.a_ready(nxt);
            if constexpr (SP2) {
            PG8_LDB(B0, 0, 0); PG8_LDB(B1, 0, 1); PG8_SCHED; PG8_LDA(At, 0, 0); PG8_STAGE(PG8_SA(1, 1), a1 + hstep, voffA);
            PG8_WAIT_V(8); PG8_WAIT_L(0); PG8_BAR; PG8_MMA(0, 0, At, B0); PG8_MMA(0, 1, At, B1); PG8_BAR; PG8_SCHED;
            PG8_LDA(At, 0, 1); PG8_STAGE(PG8_SB(0, 0), b2, voffB); PG8_STAGE(PG8_SB(0, 1), b2 + hstep, voffB); PG8_STAGE(PG8_SA(0, 0), a2, voffA);
            PG8_WAIT_V(8); PG8_WAIT_L(0); PG8_BAR; PG8_MMA(1, 0, At, B0); PG8_MMA(1, 1, At, B1); PG8_BAR; PG8_SCHED;
            PG8_LDB(B0, 1, 0); PG8_LDB(B1, 1, 1); PG8_SCHED; PG8_LDA(At, 1, 0); PG8_STAGE(PG8_SA(0, 1), a2 + hstep, voffA);
            PG8_WAIT_V(8); PG8_WAIT_L(0); PG8_BAR; PG8_MMA(0, 0, At, B0); PG8_MMA(0, 1, At, B1); PG8_BAR; PG8_SCHED;
            PG8_LDA(At, 1, 1); PG8_STAGE(PG8_SB(1, 0), b3, voffB); PG8_STAGE(PG8_SB(1, 1), b3 + hstep, voffB); PG8_STAGE(PG8_SA(1, 0), a3, voffA);
            PG8_WAIT_V(8); PG8_WAIT_L(0); PG8_BAR; PG8_MMA(1, 0, At, B0); PG8_MMA(1, 1, At, B1); PG8_BAR; PG8_SCHED;
            } else {
            PG8_LDB(B0, 0, 0); PG8_SCHED; PG8_LDA(At, 0, 0); PG8_STAGE(PG8_SA(1, 1), a1 + hstep, voffA);
            PG8_WAIT_L(8); PG8_BAR; PG8_WAIT_L(0); PG8_MMA(0, 0, At, B0); PG8_BAR; PG8_SCHED;
            PG8_LDB(B1, 0, 1); PG8_STAGE(PG8_SB(0, 0), b2, voffB);
            PG8_BAR; PG8_WAIT_L(0); PG8_MMA(0, 1, At, B1); PG8_BAR;
            PG8_LDA(At, 0, 1); PG8_STAGE(PG8_SA(0, 0), a2, voffA);
            PG8_BAR; PG8_WAIT_L(0); PG8_MMA(1, 0, At, B0); PG8_BAR; PG8_SCHED;
            PG8_STAGE(PG8_SB(0, 1), b2 + hstep, voffB);
            PG8_WAIT_V(6); PG8_BAR; PG8_MMA(1, 1, At, B1); PG8_BAR;
            PG8_LDB(B0, 1, 0); PG8_SCHED; PG8_LDA(At, 1, 0); PG8_STAGE(PG8_SA(0, 1), a2 + hstep, voffA);
            PG8_WAIT_L(8); PG8_BAR; PG8_WAIT_L(0); PG8_MMA(0, 0, At, B0); PG8_BAR; PG8_SCHED;
            PG8_LDB(B1, 1, 1); PG8_STAGE(PG8_SB(1, 0), b3, voffB);
            PG8_BAR; PG8_WAIT_L(0); PG8_MMA(0, 1, At, B1); PG8_BAR;
            PG8_LDA(At, 1, 1); PG8_STAGE(PG8_SA(1, 0), a3, voffA);
            PG8_BAR; PG8_WAIT_L(0); PG8_MMA(1, 0, At, B0); PG8_BAR; PG8_SCHED;
            PG8_STAGE(PG8_SB(1, 1), b3 + hstep, voffB);
            PG8_WAIT_V(6); PG8_BAR; PG8_MMA(1, 1, At, B1); PG8_BAR;
            }
        }
        if constexpr (ALIGN_EPI) { if (wr == 0) PG8_BAR; }
        if constexpr (!Epi::AFTER_DRAIN) {
            const bool epi_probe_ = (PROBE_MASK_V & (1u << 15)) || ((PROBE_MASK_V & (1u << 16)) && g.N == 5632) || ((PROBE_MASK_V & (1u << 17)) && g.N == 3072) || ((PROBE_MASK_V & (1u << 18)) && g.N == 1024);
            const unsigned long long te0_ = epi_probe_ ? __builtin_amdgcn_s_memrealtime() : 0ull;
            E(acc, cur, wr, wc, fr, fq); S.done(cur);
            if (epi_probe_) { const unsigned long long te1_ = __builtin_amdgcn_s_memrealtime(); while (__builtin_amdgcn_s_memrealtime() - te1_ < te1_ - te0_) __builtin_amdgcn_s_sleep(4); }
        }
        if (!has_next) break;
#pragma unroll
        for (int a = 0; a < 2; ++a)
#pragma unroll
            for (int b = 0; b < 2; ++b)
#pragma unroll
                for (int m = 0; m < 4; ++m)
#pragma unroll
                    for (int n = 0; n < 2; ++n) acc[a][b][m][n] = (f32x4){0.f, 0.f, 0.f, 0.f};
        cur = nxt; cA = nA; cB = nB; ++ui;
        if constexpr (ALIGN_EPI) { if (wr == 1) PG8_BAR; }
    }
    PG8_WAIT_V(0);
    if constexpr (!ALIGN_EPI) { if (wr == 0) PG8_BAR; }
    PG8_BAR;
    if constexpr (Epi::AFTER_DRAIN) { E.fused(acc, cur, wr, wc, fr, fq, lds, wid, lane); S.done(cur); }
#undef PG8_SA
#undef PG8_SB
#undef PG8_STAGE
#undef PG8_LDA
#undef PG8_LDB
#undef PG8_MMA
#undef PG8_WAIT_V
#undef PG8_WAIT_L
#undef PG8_BAR
#undef PG8_SCHED
}
}

#ifndef PG8_SP2
#define PG8_SP2 true
#endif
#ifndef PG8_ALIGN
#define PG8_ALIGN true
#endif
#define GAS __attribute__((address_space(1)))
#define LAS __attribute__((address_space(3)))
typedef unsigned short bf16;
typedef unsigned v4u __attribute__((ext_vector_type(4)));
typedef float f32x4 __attribute__((ext_vector_type(4)));
typedef short bf16x8 __attribute__((ext_vector_type(8)));
typedef GAS unsigned gu32;
typedef GAS unsigned long long gu64;
#define RLX_AGENT __ATOMIC_RELAXED, __HIP_MEMORY_SCOPE_AGENT
#define LDS_WAIT() asm volatile("s_waitcnt lgkmcnt(0)" ::: "memory")
#define VM_WAIT() asm volatile("s_waitcnt vmcnt(0)" ::: "memory")
__device__ __forceinline__ unsigned long long rt() { return __builtin_amdgcn_s_memrealtime(); }

#define XB_TMO      128
#define XB_XCNT(j)  (256  + 64 * (j))
#define XB_XSUB(j)  (1280 + 64 * (j))
#define XB_XGEN(j)  (2304 + 64 * (j))
#define XB_TOP      3328
#define XB_TOPGEN   3392
#define XCD_BAR_WORDS 3456
#define XB_SPIN_CAP (1u << 18)

__device__ __forceinline__ unsigned xb_ld(unsigned* p)              { return __hip_atomic_load(p, __ATOMIC_RELAXED, __HIP_MEMORY_SCOPE_AGENT); }
__device__ __forceinline__ unsigned xb_add(unsigned* p, unsigned v) { return __hip_atomic_fetch_add(p, v, __ATOMIC_RELAXED, __HIP_MEMORY_SCOPE_AGENT); }
__device__ __forceinline__ unsigned xb_xcc_id() { return (unsigned)__builtin_amdgcn_s_getreg((3 << 11) | 20) & 0xFu; }
#define XB_SPIN(cond, bar) do { unsigned _sp = 0; while (cond) { __builtin_amdgcn_s_sleep(1); \
    if ((++_sp & 255u) == 0u) { if (xb_ld(&(bar)[XB_TMO])) break; if (_sp > XB_SPIN_CAP) { atomicAdd(&(bar)[XB_TMO], 1u); break; } } } } while (0)

struct XcdBarrier {
    unsigned* bar; unsigned x;
    volatile LAS unsigned* st;
};

__device__ __forceinline__ XcdBarrier xcd_barrier_post(unsigned* bar, volatile LAS unsigned* st) {
    XcdBarrier b; b.bar = bar; b.x = xb_xcc_id(); b.st = st;
    if (threadIdx.x == 0) (void)xb_add(&bar[XB_XCNT(b.x)], 1u);
    return b;
}
__device__ __forceinline__ void xcd_barrier_complete(unsigned* bar, unsigned x, unsigned& nloc, unsigned& nx) {
    const unsigned G = gridDim.x * gridDim.y * gridDim.z;
    unsigned sum, cnt, mine, sp = 0u;
    for (;;) {
        sum = 0u; cnt = 0u; mine = 0u;
#pragma unroll
        for (unsigned j = 0; j < 16; ++j) { const unsigned c = xb_ld(&bar[XB_XCNT(j)]); sum += c; cnt += (c > 0u) ? 1u : 0u; mine = (j == x) ? c : mine; }
        if (sum == G) break;
        __builtin_amdgcn_s_sleep(1);
        if ((++sp & 255u) == 0u) { if (xb_ld(&bar[XB_TMO])) break; if (sp > XB_SPIN_CAP) { atomicAdd(&bar[XB_TMO], 1u); break; } }
    }
    nloc = mine > 0u ? mine : 1u; nx = cnt > 0u ? cnt : 1u;
}

__device__ __forceinline__ void xcd_barrier(const XcdBarrier& b, const bool lead) {
    asm volatile("s_waitcnt vmcnt(0)" ::: "memory");
    __syncthreads();
    if (lead) {
        unsigned* bar = b.bar;
        __builtin_amdgcn_s_waitcnt(0);
        unsigned nloc = b.st[0], nx = b.st[1];
        if (nloc == 0u) { xcd_barrier_complete(bar, b.x, nloc, nx); b.st[0] = nloc; b.st[1] = nx; }
        const unsigned old = xb_add(&bar[XB_XSUB(b.x)], 1u);
        const unsigned gen = old / nloc;
        if (old + 1u == (gen + 1u) * nloc) {
            __builtin_amdgcn_fence(__ATOMIC_RELEASE, "agent");
            asm volatile("s_waitcnt vmcnt(0)" ::: "memory");
            const unsigned og = xb_add(&bar[XB_TOP], 1u);
            const unsigned tg = og / nx;
            if (og + 1u == (tg + 1u) * nx) xb_add(&bar[XB_TOPGEN], 1u);
            else XB_SPIN(xb_ld(&bar[XB_TOPGEN]) == tg, bar);
            __builtin_amdgcn_fence(__ATOMIC_ACQUIRE, "agent");
            xb_add(&bar[XB_XGEN(b.x)], 1u);
            asm volatile("s_waitcnt vmcnt(0)" ::: "memory");
        } else {
            XB_SPIN(xb_ld(&bar[XB_XGEN(b.x)]) == gen, bar);
            __builtin_amdgcn_fence(__ATOMIC_ACQUIRE, "agent");
            asm volatile("s_waitcnt vmcnt(0)" ::: "memory");
        }
    }
    __syncthreads();
}

constexpr int NWAVES = 8;
constexpr int BATCH = 4, SEQ = 8192, DM = 1024, NH = 8, HD = 128, FF = 2816, MROWS = BATCH * SEQ;
constexpr int BS = 256, NBLK = SEQ / BS;
constexpr float QSCALE = 0.08838834764831845f * 1.4426950408889634f;
constexpr float EPS = 1e-6f;
#ifndef WGM_SET
#define WGM_SET 4, 4, 4, 4
#endif
constexpr int WGM_ARR[4] = {WGM_SET};
constexpr int WGM_N3072 = WGM_ARR[0], WGM_FFNIN = WGM_ARR[1], WGM_N1024 = WGM_ARR[2], WGM_FFNOUT = WGM_ARR[3];

constexpr size_t MiB = 1u << 20;
constexpr size_t WS_CTL = 0, CTL_ZERO_BYTES = 1 * MiB;
constexpr size_t WS_KSUM = 1 * MiB;
constexpr size_t WS_SS = 1 * MiB + 512 * 1024;
constexpr size_t WS_SS0 = 2 * MiB;
constexpr size_t WS_WQKV = 4 * MiB, WS_WO = 10 * MiB, WS_WF1 = 12 * MiB  , WS_WF2 = 34 * MiB  , WS_WCI = 45 * MiB, WS_WCO = 51 * MiB;
constexpr size_t WS_Q = 56 * MiB, WS_K = 120 * MiB, WS_V = 184 * MiB;
constexpr size_t WS_XB = 248 * MiB;
constexpr size_t WS_H = 312 * MiB;
constexpr size_t WS_END = 504 * MiB;
static_assert(WS_H + (size_t)MROWS * FF * 2 <= WS_END, "ws map");
constexpr int CW_TMO = 0, CW_CODE = 1, CW_BAR = 4096;

constexpr int RING_OFF = 0, RING_BYTES = 131072;
constexpr int LDSCTL_OFF = RING_BYTES, MISC_OFF = LDSCTL_OFF + 320;
constexpr int LDS_BYTES = 147456;

__device__ __forceinline__ float wave_sum(float v) {
#pragma unroll
    for (int o = 1; o < 64; o <<= 1) v += __shfl_xor(v, o);
    return v;
}
__device__ __forceinline__ float bf_lo(unsigned w) { return __uint_as_float(w << 16); }
__device__ __forceinline__ float bf_hi(unsigned w) { return __uint_as_float(w & 0xffff0000u); }
__device__ __forceinline__ unsigned pk2(float lo, float hi) { return pg8::cvt_pk_bf16(lo, hi); }

__device__ __forceinline__ void p0_item(const float* W, int N, int K, int k0, int n_src0, bf16* WT, int n_dst0, const float* gain, LAS unsigned char* scr, int lane) {
    const int lq = lane >> 4, ln = lane & 15;
    const float gv = gain ? gain[k0 + lane] : 1.0f;
    f32x4 v[16];
    const float* src = W + (size_t)(k0 + 2 * lq) * N + n_src0 + 4 * ln;
#pragma unroll
    for (int i = 0; i < 16; ++i) v[i] = *(const f32x4*)(src + (size_t)(8 * (i >> 1) + (i & 1)) * N);
#pragma unroll
    for (int p = 0; p < 8; ++p) {
        const float g0 = __shfl(gv, 8 * p + 2 * lq), g1 = __shfl(gv, 8 * p + 2 * lq + 1);
#pragma unroll
        for (int e = 0; e < 4; ++e) *(LAS unsigned*)(scr + (4 * ln + e) * 144 + (8 * p + 2 * lq) * 2) = pk2(v[2 * p][e] * g0, v[2 * p + 1][e] * g1);
    }
    LDS_WAIT(); asm volatile("" ::: "memory");
#pragma unroll
    for (int r = 0; r < 8; ++r) { const int row = 8 * r + (lane >> 3), c = lane & 7;
        const v4u o = *(const LAS v4u*)(scr + row * 144 + c * 16);
        *(v4u*)(WT + (size_t)(n_dst0 + row) * K + k0 + 8 * c) = o; }
    LDS_WAIT(); asm volatile("" ::: "memory");
}
__device__ __forceinline__ int interleave128(int n, int half_cols) { const int hsel = n >= half_cols ? 1 : 0, nn = n - hsel * half_cols; return 256 * (nn >> 7) + 128 * hsel + (nn & 127); }

struct Args { const float* in[12]; float* out; unsigned char* ws; };

__device__ __forceinline__ void naive_attn_item(bf16* Q, const bf16* Kb, const bf16* Vb, const float* ksum, int m, int h, int lane) {
    const int t = m & (SEQ - 1), b = m / SEQ, ib = t / BS;
    const size_t qoff = (size_t)m * DM + h * HD + 2 * lane;
    const unsigned qq = *(const unsigned*)(Q + qoff); const float q0 = bf_lo(qq), q1 = bf_hi(qq);
    int s0 = -1, s1 = -1, s2 = -1; float g0 = -3.0e38f, g1 = -3.0e38f, g2 = -3.0e38f;
    for (int j = 0; j < ib; ++j) {
        const float2 km = *(const float2*)(ksum + (size_t)(b * NBLK + j) * DM + h * HD + 2 * lane);
        const float g = wave_sum(q0 * km.x + q1 * km.y);
        if (g > g0) { g2 = g1; s2 = s1; g1 = g0; s1 = s0; g0 = g; s0 = j; }
        else if (g > g1) { g2 = g1; s2 = s1; g1 = g; s1 = j; }
        else if (g > g2) { g2 = g; s2 = j; }
    }
    float mr = -1.0e30f, l = 0.f, o0 = 0.f, o1 = 0.f;
    for (int sidx = 0; sidx < 4; ++sidx) {
        const int blk = sidx == 0 ? s0 : sidx == 1 ? s1 : sidx == 2 ? s2 : ib;
        if (blk < 0) continue;
        const int nk = (sidx == 3) ? (t & (BS - 1)) + 1 : BS;
        const size_t rbase = ((size_t)b * SEQ + (size_t)blk * BS) * DM + h * HD + 2 * lane;
        for (int k0 = 0; k0 < nk; k0 += 4) {
            float d[4]; unsigned vv[4];
#pragma unroll
            for (int u = 0; u < 4; ++u) { const unsigned kk = *(const unsigned*)(Kb + rbase + (size_t)(k0 + u) * DM); vv[u] = *(const unsigned*)(Vb + rbase + (size_t)(k0 + u) * DM); d[u] = q0 * bf_lo(kk) + q1 * bf_hi(kk); }
#pragma unroll
            for (int o = 1; o < 64; o <<= 1) {
#pragma unroll
                for (int u = 0; u < 4; ++u) d[u] += __shfl_xor(d[u], o);
            }
#pragma unroll
            for (int u = 0; u < 4; ++u) if (k0 + u >= nk) d[u] = -1.0e30f;
            const float mn = fmaxf(fmaxf(mr, fmaxf(d[0], d[1])), fmaxf(d[2], d[3]));
            const float a = __builtin_amdgcn_exp2f(mr - mn); l *= a; o0 *= a; o1 *= a; mr = mn;
#pragma unroll
            for (int u = 0; u < 4; ++u) { const float p = __builtin_amdgcn_exp2f(d[u] - mn); l += p; o0 += p * bf_lo(vv[u]); o1 += p * bf_hi(vv[u]); }
        }
    }
    const float il = 1.0f / l;
    *(unsigned*)(Q + qoff) = pk2(o0 * il, o1 * il);
}


typedef float f32x16 __attribute__((ext_vector_type(16)));
typedef short v4i16_t __attribute__((ext_vector_type(4)));
#define MFMA32(a, b, c) __builtin_amdgcn_mfma_f32_32x32x16_bf16((a), (b), (c), 0, 0, 0)
__device__ __forceinline__ int crow(int r, int hi) { return (r & 3) + 8 * (r >> 2) + 4 * hi; }
constexpr int CW_QUEUE = 8192, CW_CNT = 12288;
constexpr int LIST_PER_BH = 256 * 496;
__device__ __forceinline__ int list_off(int j) { return 256 * (31 * j - (j * (j - 1)) / 2); }
constexpr size_t OUT_LSE_OFF = 0, OUT_LIST_OFF = 2u << 20;
constexpr float NEG_BIG = -1.0e30f;
#define GT_(va, ia, vb, ib_) ((va) > (vb) || ((va) == (vb) && (ia) < (ib_)))
#define TOP3_INSERT(v, i) do { const float v_ = (v); const int i_ = (i); \
    if (GT_(v_, i_, v0, i0)) { v2 = v1; i2 = i1; v1 = v0; i1 = i0; v0 = v_; i0 = i_; } \
    else if (GT_(v_, i_, v1, i1)) { v2 = v1; i2 = i1; v1 = v_; i1 = i_; } \
    else if (GT_(v_, i_, v2, i2)) { v2 = v_; i2 = i_; } } while (0)

__device__ __forceinline__ void gate_unit(int b, int ib, int hd, const bf16* Qb, const float* ksum, gu32* gcount, unsigned* lists, LAS unsigned char* lds, int tid, int lane, int wave) {
    const int r32 = lane & 31, hi = lane >> 5, bh = b * NH + hd;
    const int t = ib * BS + wave * 32 + r32;
    LAS unsigned* cnt = (LAS unsigned*)lds; LAS unsigned* basel = cnt + 32;
    if (tid < 32) cnt[tid] = 0u;
    f32x16 acc;
#pragma unroll
    for (int i = 0; i < 16; ++i) acc[i] = 0.f;
    const bf16* qp = Qb + ((size_t)b * SEQ + t) * DM + hd * HD + 8 * hi;
    const float* kp = ksum + (size_t)(b * NBLK + r32) * DM + hd * HD + 8 * hi;
#pragma unroll
    for (int s = 0; s < 8; ++s) {
        const bf16x8 qf = *(const bf16x8*)(qp + 16 * s);
        const f32x4 k0 = *(const f32x4*)(kp + 16 * s), k1 = *(const f32x4*)(kp + 16 * s + 4);
        v4u wh, wl;
        wh.x = pk2(k0[0], k0[1]); wh.y = pk2(k0[2], k0[3]); wh.z = pk2(k1[0], k1[1]); wh.w = pk2(k1[2], k1[3]);
        wl.x = pk2(k0[0] - bf_lo(wh.x), k0[1] - bf_hi(wh.x)); wl.y = pk2(k0[2] - bf_lo(wh.y), k0[3] - bf_hi(wh.y));
        wl.z = pk2(k1[0] - bf_lo(wh.z), k1[1] - bf_hi(wh.z)); wl.w = pk2(k1[2] - bf_lo(wh.w), k1[3] - bf_hi(wh.w));
        acc = MFMA32(__builtin_bit_cast(bf16x8, wh), qf, acc);
        acc = MFMA32(__builtin_bit_cast(bf16x8, wl), qf, acc);
    }
    float v0 = -3.0e38f, v1 = -3.0e38f, v2 = -3.0e38f; int i0 = 99, i1 = 99, i2 = 99;
#pragma unroll
    for (int i = 0; i < 16; ++i) { const int blk = crow(i, hi); const float g = blk < ib ? acc[i] : -3.0e38f; TOP3_INSERT(g, blk); }
    { const float p0 = __shfl_xor(v0, 32), p1 = __shfl_xor(v1, 32), p2 = __shfl_xor(v2, 32); const int q0 = __shfl_xor(i0, 32), q1 = __shfl_xor(i1, 32), q2 = __shfl_xor(i2, 32);
      TOP3_INSERT(p0, q0); TOP3_INSERT(p1, q1); TOP3_INSERT(p2, q2); }
    const bool ok0 = hi == 0 && v0 > -1.0e38f, ok1 = hi == 0 && v1 > -1.0e38f, ok2 = hi == 0 && v2 > -1.0e38f;
    __syncthreads();
    unsigned r0 = 0, r1 = 0, r2 = 0;
    if (ok0) r0 = __hip_atomic_fetch_add(cnt + i0, 1u, __ATOMIC_RELAXED, __HIP_MEMORY_SCOPE_WORKGROUP);
    if (ok1) r1 = __hip_atomic_fetch_add(cnt + i1, 1u, __ATOMIC_RELAXED, __HIP_MEMORY_SCOPE_WORKGROUP);
    if (ok2) r2 = __hip_atomic_fetch_add(cnt + i2, 1u, __ATOMIC_RELAXED, __HIP_MEMORY_SCOPE_WORKGROUP);
    __syncthreads();
    if (tid < 32) { const unsigned c = cnt[tid]; basel[tid] = c ? __hip_atomic_fetch_add(gcount + bh * 32 + tid, c, RLX_AGENT) : 0u; }
    __syncthreads();
    unsigned* lb = lists + (size_t)bh * LIST_PER_BH;
    if (ok0) lb[list_off(i0) + basel[i0] + r0] = (unsigned)t;
    if (ok1) lb[list_off(i1) + basel[i1] + r1] = (unsigned)t | (1u << 13);
    if (ok2) lb[list_off(i2) + basel[i2] + r2] = (unsigned)t | (2u << 13);
    __syncthreads();
}

__device__ __forceinline__ void attn_wave_item(LAS unsigned char* Kimg, LAS unsigned char* Vimg, bf16x8 (&qf)[8], const bf16* qnext, bf16* Opart, float* lse, size_t mrow, int hd, int slot, bool valid, int kmax, bool own, int lane) {
    const int r32 = lane & 31, hi = lane >> 5;
    const int xr = ((r32 & 3) << 2) | ((r32 >> 2) & 3);
    const LAS unsigned char* kb = Kimg + 256 * r32;
    f32x16 S[8];
#pragma unroll
    for (int kt = 0; kt < 8; ++kt)
#pragma unroll
        for (int i = 0; i < 16; ++i) S[kt][i] = 0.f;
    bf16x8 kA[4], kB[4];
#define LOADK(dst, u) do { _Pragma("unroll") for (int j = 0; j < 4; ++j) dst[j] = *(const LAS bf16x8*)(kb + 16 * ((2 * ((u) >> 1) + hi) ^ xr) + 8192 * (4 * ((u) & 1) + j)); } while (0)
#define MMAK(src, u) do { _Pragma("unroll") for (int j = 0; j < 4; ++j) if (4 * ((u) & 1) + j <= kmax) S[4 * ((u) & 1) + j] = MFMA32(src[j], qf[(u) >> 1], S[4 * ((u) & 1) + j]); } while (0)
    LOADK(kA, 0);
    LOADK(kB, 1); MMAK(kA, 0); LOADK(kA, 2); MMAK(kB, 1);
    LOADK(kB, 3); MMAK(kA, 2); LOADK(kA, 4); MMAK(kB, 3);
    LOADK(kB, 5); MMAK(kA, 4); LOADK(kA, 6); MMAK(kB, 5);
    LOADK(kB, 7); MMAK(kA, 6); LOADK(kA, 8); MMAK(kB, 7);
    LOADK(kB, 9); MMAK(kA, 8); LOADK(kA, 10); MMAK(kB, 9);
    LOADK(kB, 11); MMAK(kA, 10); LOADK(kA, 12); MMAK(kB, 11);
    LOADK(kB, 13); MMAK(kA, 12); LOADK(kA, 14); MMAK(kB, 13);
    LOADK(kB, 15); MMAK(kA, 14); MMAK(kB, 15);
#undef LOADK
#undef MMAK
    if (qnext) {
#pragma unroll
        for (int s = 0; s < 8; ++s) qf[s] = *(const bf16x8*)(qnext + 16 * s);
    }
#pragma unroll
    for (int kt = 0; kt < 8; ++kt) {
        if (kt > kmax) {
#pragma unroll
            for (int i = 0; i < 16; ++i) S[kt][i] = NEG_BIG;
        } else if (own && kt == kmax) {
#pragma unroll
            for (int i = 0; i < 16; ++i) if (crow(i, hi) > r32) S[kt][i] = NEG_BIG;
        }
    }
    float mx = NEG_BIG;
#pragma unroll
    for (int kt = 0; kt < 8; ++kt)
#pragma unroll
        for (int i = 0; i < 16; ++i) mx = fmaxf(mx, S[kt][i]);
    mx = fmaxf(mx, __shfl_xor(mx, 32));
    float lsum = 0.f; v4u pw[8][2];
#pragma unroll
    for (int kt = 0; kt < 8; ++kt) {
        float p[16];
#pragma unroll
        for (int i = 0; i < 16; ++i) { p[i] = __builtin_amdgcn_exp2f(S[kt][i] - mx); lsum += p[i]; }
#pragma unroll
        for (int s2 = 0; s2 < 2; ++s2) { pw[kt][s2].x = pk2(p[8 * s2], p[8 * s2 + 1]); pw[kt][s2].y = pk2(p[8 * s2 + 2], p[8 * s2 + 3]); pw[kt][s2].z = pk2(p[8 * s2 + 4], p[8 * s2 + 5]); pw[kt][s2].w = pk2(p[8 * s2 + 6], p[8 * s2 + 7]); }
    }
    lsum += __shfl_xor(lsum, 32);
    int lane_v = lane; asm volatile("" : "+v"(lane_v));
    const int blk = (lane_v >> 4) & 1, q4 = (lane_v & 15) >> 2, p4 = lane_v & 3, hi_v = lane_v >> 5;
    int vb[2][4];
#pragma unroll
    for (int t = 0; t < 2; ++t)
#pragma unroll
        for (int c4 = 0; c4 < 4; ++c4) vb[t][c4] = 256 * (8 * t + 4 * hi_v + q4) + 64 * (c4 ^ q4) + 16 * ((2 * blk + (p4 >> 1)) ^ ((2 * t + hi_v) & 3)) + 8 * (p4 & 1);
    f32x16 O[4];
#pragma unroll
    for (int c4 = 0; c4 < 4; ++c4)
#pragma unroll
        for (int i = 0; i < 16; ++i) O[c4][i] = 0.f;
    v4i16_t vA[4][2], vB[4][2];
#define LOADV(dst, idx) do { _Pragma("unroll") for (int c4 = 0; c4 < 4; ++c4) { \
        dst[c4][0] = __builtin_amdgcn_ds_read_tr16_b64_v4i16((LAS v4i16_t*)(Vimg + vb[0][c4] + 4096 * (idx))); \
        dst[c4][1] = __builtin_amdgcn_ds_read_tr16_b64_v4i16((LAS v4i16_t*)(Vimg + vb[1][c4] + 4096 * (idx))); } } while (0)
#define MMAV(src, idx) do { if (((idx) >> 1) <= kmax) { const bf16x8 pf = __builtin_bit_cast(bf16x8, pw[(idx) >> 1][(idx) & 1]); _Pragma("unroll") for (int c4 = 0; c4 < 4; ++c4) { \
        const bf16x8 vf = (bf16x8){src[c4][0][0], src[c4][0][1], src[c4][0][2], src[c4][0][3], src[c4][1][0], src[c4][1][1], src[c4][1][2], src[c4][1][3]}; O[c4] = MFMA32(vf, pf, O[c4]); } } } while (0)
    LOADV(vA, 0);
    LOADV(vB, 1); MMAV(vA, 0); LOADV(vA, 2); MMAV(vB, 1);
    LOADV(vB, 3); MMAV(vA, 2); LOADV(vA, 4); MMAV(vB, 3);
    LOADV(vB, 5); MMAV(vA, 4); LOADV(vA, 6); MMAV(vB, 5);
    LOADV(vB, 7); MMAV(vA, 6); LOADV(vA, 8); MMAV(vB, 7);
    LOADV(vB, 9); MMAV(vA, 8); LOADV(vA, 10); MMAV(vB, 9);
    LOADV(vB, 11); MMAV(vA, 10); LOADV(vA, 12); MMAV(vB, 11);
    LOADV(vB, 13); MMAV(vA, 12); LOADV(vA, 14); MMAV(vB, 13);
    LOADV(vB, 15); MMAV(vA, 14); MMAV(vB, 15);
#undef LOADV
#undef MMAV
    {
        const float il = 1.0f / lsum;
        const size_t rec = (mrow * NH + hd) * 4 + slot;
        bf16* op = Opart + rec * HD + 8 * hi;
#pragma unroll
        for (int c4 = 0; c4 < 4; ++c4)
#pragma unroll
            for (int g = 0; g < 4; g += 2) {
                unsigned a0 = pk2(O[c4][4 * g] * il, O[c4][4 * g + 1] * il), a1 = pk2(O[c4][4 * g + 2] * il, O[c4][4 * g + 3] * il);
                unsigned b0 = pk2(O[c4][4 * g + 4] * il, O[c4][4 * g + 5] * il), b1 = pk2(O[c4][4 * g + 6] * il, O[c4][4 * g + 7] * il);
                const auto r0 = __builtin_amdgcn_permlane32_swap(a0, b0, false, false); const auto r1 = __builtin_amdgcn_permlane32_swap(a1, b1, false, false);
                if (valid) *(v4u*)(op + 32 * c4 + 8 * g) = (v4u){r0[0], r1[0], r0[1], r1[1]};
            }
        if (valid && hi == 0) lse[rec] = mx + __builtin_log2f(lsum);
    }
}

__device__ __forceinline__ void attn_phase(LAS unsigned char* lds, volatile LAS unsigned* qslot, gu32* ctl, const bf16* Qb, const bf16* Kb, const bf16* Vb, bf16* Opart, float* lse, const unsigned* lists, int tid, int lane, int wave) {
    LAS unsigned char* Kimg = lds; LAS unsigned char* Vimg = lds + 65536;
    for (;;) {
        if (tid == 0) *qslot = __hip_atomic_fetch_add(ctl + CW_QUEUE, 1u, RLX_AGENT);
        __syncthreads();
        const int it = (int)*qslot;
        if (it >= NBLK * BATCH * NH) break;
        const int j = it >> 5, bh = it & 31, b = bh >> 3, hd = bh & 7;
        const size_t kvrow0 = (size_t)b * SEQ + (size_t)j * BS;
        int lane_d = lane; asm volatile("" : "+v"(lane_d));
#pragma unroll
        for (int i = 0; i < 8; ++i) {
            const int pc = i * 8 + wave, row = 4 * pc + (lane_d >> 4), ch = (lane_d & 15) ^ (((lane_d >> 4) << 2) | (pc & 3));
            const size_t src = (kvrow0 + row) * DM + hd * HD + ch * 8;
            __builtin_amdgcn_global_load_lds((const unsigned*)(Kb + src), (LAS unsigned*)(Kimg + pc * 1024), 16, 0, 0);
            __builtin_amdgcn_global_load_lds((const unsigned*)(Vb + src), (LAS unsigned*)(Vimg + pc * 1024), 16, 0, 0);
        }
        const int n = (int)__hip_atomic_load(ctl + CW_CNT + bh * 32 + j, RLX_AGENT);
        const unsigned* lb = lists + (size_t)bh * LIST_PER_BH + list_off(j);
        asm volatile("s_waitcnt vmcnt(0)" ::: "memory");
        __syncthreads();
        const int nch = 8 + ((n + 31) >> 5);
        {
            const int r32 = lane & 31, hi = lane >> 5;
            const size_t qcol = (size_t)hd * HD + 8 * hi;
            int c = wave;
            int tq = j * BS + c * 32 + r32, slot = 3; bool valid = true;
            bf16x8 qf[8];
            { const bf16* qp = Qb + ((size_t)b * SEQ + tq) * DM + qcol;
#pragma unroll
              for (int s = 0; s < 8; ++s) qf[s] = *(const bf16x8*)(qp + 16 * s); }
            while (c < nch) {
                const int cn = c + NWAVES; const bool has_next = cn < nch;
                const int e = (cn - 8) * 32 + r32; const bool valid_n = has_next && e < n;
                const unsigned ent = valid_n ? lb[e] : (unsigned)(j * BS);
                const bf16* qnext = has_next ? Qb + ((size_t)b * SEQ + (ent & 8191u)) * DM + qcol : nullptr;
                attn_wave_item(Kimg, Vimg, qf, qnext, Opart, lse, (size_t)b * SEQ + tq, hd, slot, valid, c < 8 ? c : 7, c < 8, lane);
                c = cn; tq = (int)(ent & 8191u); slot = (int)(ent >> 13); valid = valid_n;
            }
        }
        __syncthreads();
    }
}


__device__ __forceinline__ int fresh_lane() { int l = __builtin_amdgcn_mbcnt_hi(~0u, __builtin_amdgcn_mbcnt_lo(~0u, 0u)); asm volatile("" : "+v"(l)); return l; }
typedef const __attribute__((address_space(4))) Args* KArgs;
__device__ __forceinline__ KArgs get_args() { const __attribute__((address_space(4))) void* p = (const __attribute__((address_space(4))) void*)__builtin_amdgcn_kernarg_segment_ptr(); asm volatile("" : "+s"(p)); return (KArgs)p; }
#define GRID_BAR() do { XcdBarrier b_; b_.bar = (unsigned*)(get_args()->ws + WS_CTL) + CW_BAR; b_.x = xb_xcc_id(); b_.st = MISC + 8; const bool lead_ = (wave == 0) && (fresh_lane() == 0); xcd_barrier(b_, lead_); if (PROBE_MASK_V & (1u << 14)) xcd_barrier(b_, lead_); } while (0)

#ifndef PROBE_MASK_V
#define PROBE_MASK_V 0u
#endif
constexpr unsigned PROBE_MASK = PROBE_MASK_V;
#define PH_BEGIN() const unsigned long long t0_ = PROBE_MASK ? __builtin_amdgcn_s_memrealtime() : 0ull
#define PH_END(p) do { if (PROBE_MASK & (1u << (p))) { const unsigned long long t1_ = __builtin_amdgcn_s_memrealtime(); while (__builtin_amdgcn_s_memrealtime() - t1_ < t1_ - t0_) __builtin_amdgcn_s_sleep(8); } } while (0)
#define WSP(T, off) ((T*)(ws + (off)))
__global__ void __launch_bounds__(NWAVES * 64, 2) moba_fwd(Args args_unused) {
    extern __shared__ __attribute__((aligned(16))) unsigned char lds_raw[];
    LAS unsigned char* lds = (LAS unsigned char*)lds_raw;
    volatile LAS unsigned* MISC = (volatile LAS unsigned*)(lds + MISC_OFF);
    const int wave = __builtin_amdgcn_readfirstlane((int)threadIdx.x >> 6);
    const int G = gridDim.x; const int bx = blockIdx.x; const int vcu = (G % 8 == 0) ? (bx % 8) * (G / 8) + bx / 8 : bx;
    for (int u = threadIdx.x; u < (LDS_BYTES - LDSCTL_OFF) / 4; u += NWAVES * 64) ((LAS unsigned*)(lds + LDSCTL_OFF))[u] = 0u;
    __syncthreads();
    (void)xcd_barrier_post((unsigned*)(get_args()->ws + WS_CTL) + CW_BAR, MISC + 8);
    const int NGW = G * NWAVES;
    const int NGT = G * NWAVES * 64;
#define PHASE_IDS() int vcu_ = vcu; asm volatile("" : "+s"(vcu_)); const int lane = fresh_lane(), tid = wave * 64 + lane, gw = vcu_ * NWAVES + wave, gt = vcu_ * NWAVES * 64 + tid; (void)gt; (void)tid; (void)gw

    {
        PH_BEGIN(); PHASE_IDS();
        KArgs A = get_args(); unsigned char* ws = A->ws;
        const float* x = A->in[0]; const float* attn_norm = A->in[1]; const float* w_qkv = A->in[2]; const float* w_o = A->in[3];
        const float* conv_norm = A->in[4]; const float* w_ci = A->in[5]; const float* w_co = A->in[7];
        const float* ffn_norm = A->in[8]; const float* w_f1 = A->in[9]; const float* w_f2 = A->in[10];
        bf16* Wqkv_t = WSP(bf16, WS_WQKV); bf16* Wo_t = WSP(bf16, WS_WO); bf16* Wf1_t = WSP(bf16, WS_WF1); bf16* Wf2_t = WSP(bf16, WS_WF2); bf16* Wci_t = WSP(bf16, WS_WCI); bf16* Wco_t = WSP(bf16, WS_WCO);
        bf16* XB = WSP(bf16, WS_XB); float* ss0 = WSP(float, WS_SS0);
        LAS unsigned char* scr = lds + RING_OFF + wave * 16384;
        constexpr int I_QKV = (DM / 64) * (3 * DM / 64), I_O = (DM / 64) * (DM / 64), I_F1 = (DM / 64) * (2 * FF / 64), I_F2 = (FF / 64) * (DM / 64);
        constexpr int NITEMS = I_QKV + I_O + 2 * I_F1 + 2 * I_F2 + I_QKV + I_O;
        for (int it = gw; it < NITEMS; it += NGW) {
            int r = it;
            if (r < I_QKV) { const int nb = 3 * DM / 64, k0 = 64 * (r / nb), n0 = 64 * (r % nb); p0_item(w_qkv, 3 * DM, DM, k0, n0, Wqkv_t, n0, attn_norm, scr, lane); continue; } r -= I_QKV;
            if (r < I_O) { const int nb = DM / 64, k0 = 64 * (r / nb), n0 = 64 * (r % nb); p0_item(w_o, DM, DM, k0, n0, Wo_t, n0, nullptr, scr, lane); continue; } r -= I_O;
            if (r < 2 * I_F1) { const int L = r / I_F1; r -= L * I_F1; const int nb = 2 * FF / 64, k0 = 64 * (r / nb), n0 = 64 * (r % nb);
                p0_item(w_f1 + (size_t)L * DM * 2 * FF, 2 * FF, DM, k0, n0, Wf1_t + (size_t)L * 2 * FF * DM, interleave128(n0, FF), ffn_norm + L * DM, scr, lane); continue; } r -= 2 * I_F1;
            if (r < 2 * I_F2) { const int L = r / I_F2; r -= L * I_F2; const int nb = DM / 64, k0 = 64 * (r / nb), n0 = 64 * (r % nb);
                p0_item(w_f2 + (size_t)L * FF * DM, DM, FF, k0, n0, Wf2_t + (size_t)L * DM * FF, n0, nullptr, scr, lane); continue; } r -= 2 * I_F2;
            if (r < I_QKV) { const int nb = 3 * DM / 64, k0 = 64 * (r / nb), n0 = 64 * (r % nb);
                const int nd = n0 < DM ? 2 * DM + n0 : interleave128(n0 - DM, DM);
                p0_item(w_ci, 3 * DM, DM, k0, n0, Wci_t, nd, conv_norm, scr, lane); continue; } r -= I_QKV;
            { const int nb = DM / 64, k0 = 64 * (r / nb), n0 = 64 * (r % nb); p0_item(w_co, DM, DM, k0, n0, Wco_t, n0, nullptr, scr, lane); }
        }
        for (int i = gt; i < (int)(MiB / 16); i += NGT) ((v4u*)(ws + WS_KSUM))[i] = (v4u){0u, 0u, 0u, 0u};
        for (int m = gw; m < MROWS; m += 2 * NGW) {
            const int m2 = m + NGW;
            const bool has2 = m2 < MROWS; const int mb = has2 ? m2 : m;
            const f32x4* xa = (const f32x4*)(x + (size_t)m * DM) + lane; const f32x4* xc = (const f32x4*)(x + (size_t)mb * DM) + lane; f32x4 va[4], vc[4]; float sa = 0.f, sc = 0.f;
#pragma unroll
            for (int j = 0; j < 4; ++j) { va[j] = xa[64 * j]; vc[j] = xc[64 * j]; }
#pragma unroll
            for (int j = 0; j < 4; ++j) { sa += (va[j].x * va[j].x + va[j].y * va[j].y) + (va[j].z * va[j].z + va[j].w * va[j].w); sc += (vc[j].x * vc[j].x + vc[j].y * vc[j].y) + (vc[j].z * vc[j].z + vc[j].w * vc[j].w); }
            sa = wave_sum(sa); sc = wave_sum(sc);
            if (lane == 0) { ss0[m] = sa; if (has2) ss0[m2] = sc; }
            unsigned long long* oa = (unsigned long long*)(XB + (size_t)m * DM) + lane; unsigned long long* oc = (unsigned long long*)(XB + (size_t)mb * DM) + lane;
#pragma unroll
            for (int j = 0; j < 4; ++j) oa[64 * j] = (unsigned long long)pk2(va[j].x, va[j].y) | ((unsigned long long)pk2(va[j].z, va[j].w) << 32);
            if (has2) {
#pragma unroll
                for (int j = 0; j < 4; ++j) oc[64 * j] = (unsigned long long)pk2(vc[j].x, vc[j].y) | ((unsigned long long)pk2(vc[j].z, vc[j].w) << 32);
            }
        }
        PH_END(0);
    }
    GRID_BAR();

    {
        PH_BEGIN(); PHASE_IDS();
        unsigned char* ws = get_args()->ws;
        pg8::Gemm g{WSP(bf16, WS_XB), WSP(bf16, WS_WQKV), MROWS, 3 * DM, DM}; pg8::StaticOrder S; S.init(MROWS, 3 * DM, G, bx, WGM_N3072);
        pg8::EpiQKV E{WSP(bf16, WS_Q), (size_t)MROWS * DM, WSP(float, WS_SS0), WSP(float, WS_KSUM), QSCALE};
        pg8::gemm_phase<pg8::EpiQKV, pg8::StaticOrder, PG8_ALIGN, PG8_SP2>(lds + RING_OFF, g, S, E, wave);
        PH_END(1);
    }
    GRID_BAR();

    {
        PH_BEGIN(); PHASE_IDS();
        KArgs A = get_args(); unsigned char* ws = A->ws;
        for (int u = vcu_; u < BATCH * NBLK * NH; u += G) gate_unit(u >> 8, (u >> 3) & 31, u & 7, WSP(bf16, WS_Q), WSP(float, WS_KSUM), (gu32*)(ws + WS_CTL) + CW_CNT, (unsigned*)A->out + OUT_LIST_OFF, lds + RING_OFF, tid, lane, wave);
        PH_END(2);
    }
    GRID_BAR();
    {
        PH_BEGIN(); PHASE_IDS();
        KArgs A = get_args(); unsigned char* ws = A->ws;
        attn_phase(lds + RING_OFF, MISC + 16, (gu32*)(ws + WS_CTL), WSP(bf16, WS_Q), WSP(bf16, WS_K), WSP(bf16, WS_V), WSP(bf16, WS_XB), A->out + OUT_LSE_OFF, (const unsigned*)A->out + OUT_LIST_OFF, tid, lane, wave);
        PH_END(3);
    }
    GRID_BAR();
    {
        PH_BEGIN(); PHASE_IDS();
        KArgs A = get_args(); unsigned char* ws = A->ws;
        const float* lse = A->out + OUT_LSE_OFF; const bf16* Opart = WSP(bf16, WS_XB); bf16* Qb = WSP(bf16, WS_Q);
        for (int base = gt; base < MROWS * NH * 16; base += 4 * NGT) {
            f32x4 L[4]; v4u o[4][4]; int mhv[4];
#pragma unroll
            for (int q = 0; q < 4; ++q) { const int idx = base + q * NGT; mhv[q] = (idx < MROWS * NH * 16 ? idx : base) >> 4; L[q] = *(const f32x4*)(lse + (size_t)mhv[q] * 4); }
#pragma unroll
            for (int q = 0; q < 4; ++q) { const bf16* op = Opart + (size_t)mhv[q] * 4 * HD + (gt & 15) * 8;
#pragma unroll
                for (int k = 0; k < 4; ++k) o[q][k] = *(const v4u*)(op + k * HD); }
#pragma unroll
            for (int q = 0; q < 4; ++q) {
                const int idx = base + q * NGT; if (idx >= MROWS * NH * 16) break;
                const int mh = mhv[q], piece = gt & 15, m = mh >> 3, ib = (m & (SEQ - 1)) >> 8, nsel = ib < 3 ? ib : 3;
                float mx = L[q][3]; if (nsel > 0) mx = fmaxf(mx, L[q][0]); if (nsel > 1) mx = fmaxf(mx, L[q][1]); if (nsel > 2) mx = fmaxf(mx, L[q][2]);
                float w[4]; w[3] = __builtin_amdgcn_exp2f(L[q][3] - mx);
#pragma unroll
                for (int k = 0; k < 3; ++k) w[k] = nsel > k ? __builtin_amdgcn_exp2f(L[q][k] - mx) : 0.f;
                float a8[8];
#pragma unroll
                for (int e = 0; e < 8; ++e) a8[e] = 0.f;
#pragma unroll
                for (int k = 0; k < 4; ++k) { const bool ok = (k == 3 || nsel > k);
#pragma unroll
                    for (int e = 0; e < 4; ++e) { const unsigned wd = ok ? o[q][k][e] : 0u; a8[2 * e] += w[k] * bf_lo(wd); a8[2 * e + 1] += w[k] * bf_hi(wd); } }
                const float inv = 1.0f / ((w[0] + w[1]) + (w[2] + w[3]));
                v4u y;
#pragma unroll
                for (int e = 0; e < 4; ++e) y[e] = pk2(a8[2 * e] * inv, a8[2 * e + 1] * inv);
                *(v4u*)(Qb + (size_t)m * DM + (mh & 7) * HD + piece * 8) = y;
            }
        }
        PH_END(4);
    }
    GRID_BAR();

    {
        PH_BEGIN(); PHASE_IDS();
        KArgs A = get_args(); unsigned char* ws = A->ws;
        pg8::Gemm g{WSP(bf16, WS_Q), WSP(bf16, WS_WO), MROWS, DM, DM}; pg8::StaticOrder S; S.init(MROWS, DM, G, bx, WGM_N1024);
        pg8::EpiRes<true, true> E{A->in[0], WSP(bf16, WS_XB), WSP(float, WS_SS)};
        pg8::gemm_phase<pg8::EpiRes<true, true>, pg8::StaticOrder, PG8_ALIGN, PG8_SP2>(lds + RING_OFF, g, S, E, wave);
        PH_END(5);
    }
    GRID_BAR();

    {
        PH_BEGIN(); PHASE_IDS();
        unsigned char* ws = get_args()->ws;
        pg8::Gemm g{WSP(bf16, WS_XB), WSP(bf16, WS_WF1), MROWS, 2 * FF, DM}; pg8::StaticOrder S; S.init(MROWS, 2 * FF, G, bx, WGM_FFNIN);
        pg8::EpiSwiglu E{WSP(bf16, WS_H), FF, WSP(float, WS_SS)};
        pg8::gemm_phase<pg8::EpiSwiglu, pg8::StaticOrder, PG8_ALIGN, PG8_SP2>(lds + RING_OFF, g, S, E, wave);
        PH_END(6);
    }
    GRID_BAR();
    {
        PH_BEGIN(); PHASE_IDS();
        KArgs A = get_args(); unsigned char* ws = A->ws;
        pg8::Gemm g{WSP(bf16, WS_H), WSP(bf16, WS_WF2), MROWS, DM, FF}; pg8::StaticOrder S; S.init(MROWS, DM, G, bx, WGM_FFNOUT);
        pg8::EpiRes<false, true> E{nullptr, WSP(bf16, WS_XB), WSP(float, WS_SS) + MROWS};
        pg8::gemm_phase<pg8::EpiRes<false, true>, pg8::StaticOrder, PG8_ALIGN, PG8_SP2>(lds + RING_OFF, g, S, E, wave);
        PH_END(7);
    }
    GRID_BAR();

    {
        PH_BEGIN(); PHASE_IDS();
        unsigned char* ws = get_args()->ws;
        pg8::Gemm g{WSP(bf16, WS_XB), WSP(bf16, WS_WCI), MROWS, 3 * DM, DM}; pg8::StaticOrder S; S.init(MROWS, 3 * DM, G, bx, WGM_N3072);
        pg8::EpiConvIn E{WSP(bf16, WS_Q), WSP(bf16, WS_K), WSP(float, WS_SS) + MROWS};
        pg8::gemm_phase<pg8::EpiConvIn, pg8::StaticOrder, PG8_ALIGN, PG8_SP2>(lds + RING_OFF, g, S, E, wave);
        PH_END(8);
    }
    GRID_BAR();

    {
        PH_BEGIN(); PHASE_IDS();
        KArgs A = get_args(); unsigned char* ws = A->ws; const float* conv_w = A->in[6];
        const bf16* Qb = WSP(bf16, WS_Q); const bf16* Kb = WSP(bf16, WS_K); bf16* Vb = WSP(bf16, WS_V);
        const int c8 = (gt & 127) * 8;
        const f32x4 w0a = *(const f32x4*)(conv_w + c8), w0b = *(const f32x4*)(conv_w + c8 + 4), w1a = *(const f32x4*)(conv_w + DM + c8), w1b = *(const f32x4*)(conv_w + DM + c8 + 4),
                    w2a = *(const f32x4*)(conv_w + 2 * DM + c8), w2b = *(const f32x4*)(conv_w + 2 * DM + c8 + 4);
        for (int base = gt; base < MROWS * (DM / 8); base += 4 * NGT) {
            v4u u2[4], u1[4], u0[4], bb[4]; size_t offs[4]; bool okq[4];
#pragma unroll
            for (int q = 0; q < 4; ++q) {
                const int idx = base + q * NGT; okq[q] = idx < MROWS * (DM / 8); const int m = (okq[q] ? idx : base) >> 7, t = m & (SEQ - 1);
                offs[q] = (size_t)m * DM + c8;
                u2[q] = *(const v4u*)(Qb + offs[q]); bb[q] = *(const v4u*)(Kb + offs[q]);
                u1[q] = (v4u){0u, 0u, 0u, 0u}; u0[q] = (v4u){0u, 0u, 0u, 0u};
                if (t >= 1) u1[q] = *(const v4u*)(Qb + offs[q] - DM);
                if (t >= 2) u0[q] = *(const v4u*)(Qb + offs[q] - 2 * DM);
            }
#pragma unroll
            for (int q = 0; q < 4; ++q) {
                v4u y;
#pragma unroll
                for (int e = 0; e < 4; ++e) {
                    const float wl0 = e < 2 ? w0a[2 * e] : w0b[2 * e - 4], wh0 = e < 2 ? w0a[2 * e + 1] : w0b[2 * e - 3];
                    const float wl1 = e < 2 ? w1a[2 * e] : w1b[2 * e - 4], wh1 = e < 2 ? w1a[2 * e + 1] : w1b[2 * e - 3];
                    const float wl2 = e < 2 ? w2a[2 * e] : w2b[2 * e - 4], wh2 = e < 2 ? w2a[2 * e + 1] : w2b[2 * e - 3];
                    const float lo = bf_lo(bb[q][e]) * (wl0 * bf_lo(u0[q][e]) + wl1 * bf_lo(u1[q][e]) + wl2 * bf_lo(u2[q][e]));
                    const float hi = bf_hi(bb[q][e]) * (wh0 * bf_hi(u0[q][e]) + wh1 * bf_hi(u1[q][e]) + wh2 * bf_hi(u2[q][e]));
                    y[e] = pk2(lo, hi);
                }
                if (okq[q]) *(v4u*)(Vb + offs[q]) = y;
            }
        }
        PH_END(9);
    }
    GRID_BAR();

    {
        PH_BEGIN(); PHASE_IDS();
        KArgs A = get_args(); unsigned char* ws = A->ws;
        pg8::Gemm g{WSP(bf16, WS_V), WSP(bf16, WS_WCO), MROWS, DM, DM}; pg8::StaticOrder S; S.init(MROWS, DM, G, bx, WGM_N1024);
        pg8::EpiRes<false, true> E{nullptr, WSP(bf16, WS_XB), WSP(float, WS_SS) + 2 * MROWS};
        pg8::gemm_phase<pg8::EpiRes<false, true>, pg8::StaticOrder, PG8_ALIGN, PG8_SP2>(lds + RING_OFF, g, S, E, wave);
        PH_END(10);
    }
    GRID_BAR();

    {
        PH_BEGIN(); PHASE_IDS();
        unsigned char* ws = get_args()->ws;
        pg8::Gemm g{WSP(bf16, WS_XB), WSP(bf16, WS_WF1) + (size_t)2 * FF * DM, MROWS, 2 * FF, DM}; pg8::StaticOrder S; S.init(MROWS, 2 * FF, G, bx, WGM_FFNIN);
        pg8::EpiSwiglu E{WSP(bf16, WS_H), FF, WSP(float, WS_SS) + 2 * MROWS};
        pg8::gemm_phase<pg8::EpiSwiglu, pg8::StaticOrder, PG8_ALIGN, PG8_SP2>(lds + RING_OFF, g, S, E, wave);
        PH_END(11);
    }
    GRID_BAR();
    {
        PH_BEGIN(); PHASE_IDS();
        KArgs A = get_args(); unsigned char* ws = A->ws;
        pg8::Gemm g{WSP(bf16, WS_H), WSP(bf16, WS_WF2) + (size_t)DM * FF, MROWS, DM, FF}; pg8::StaticOrder S; S.init(MROWS, DM, G, bx, WGM_FFNOUT);
        pg8::EpiRes<false, false> E{nullptr, WSP(bf16, WS_XB), nullptr};
        pg8::gemm_phase<pg8::EpiRes<false, false>, pg8::StaticOrder, PG8_ALIGN, PG8_SP2>(lds + RING_OFF, g, S, E, wave);
        PH_END(12);
    }
    GRID_BAR();

    {
        PH_BEGIN(); PHASE_IDS();
        KArgs A = get_args(); float* out = A->out; const float* final_norm = A->in[11]; const bf16* XB = (const bf16*)(A->ws + WS_XB);
        const f32x4* gr = (const f32x4*)final_norm + lane; f32x4 gg[4];
#pragma unroll
        for (int j = 0; j < 4; ++j) gg[j] = gr[64 * j];
        for (int m = gw; m < MROWS; m += 2 * NGW) {
            const int m2 = m + NGW; const bool has2 = m2 < MROWS; const int mb = has2 ? m2 : m;
            const uint2* xa = (const uint2*)(XB + (size_t)m * DM) + lane; const uint2* xc = (const uint2*)(XB + (size_t)mb * DM) + lane; uint2 pa[4], pc[4];
#pragma unroll
            for (int j = 0; j < 4; ++j) { pa[j] = xa[64 * j]; pc[j] = xc[64 * j]; }
            f32x4 va[4], vc[4]; float sa = 0.f, sc = 0.f;
#pragma unroll
            for (int j = 0; j < 4; ++j) { va[j] = (f32x4){bf_lo(pa[j].x), bf_hi(pa[j].x), bf_lo(pa[j].y), bf_hi(pa[j].y)}; vc[j] = (f32x4){bf_lo(pc[j].x), bf_hi(pc[j].x), bf_lo(pc[j].y), bf_hi(pc[j].y)};
                sa += (va[j].x * va[j].x + va[j].y * va[j].y) + (va[j].z * va[j].z + va[j].w * va[j].w); sc += (vc[j].x * vc[j].x + vc[j].y * vc[j].y) + (vc[j].z * vc[j].z + vc[j].w * vc[j].w); }
            const float ra = __builtin_amdgcn_rsqf(wave_sum(sa) * (1.0f / DM) + EPS), rc = __builtin_amdgcn_rsqf(wave_sum(sc) * (1.0f / DM) + EPS);
            f32x4* oa = (f32x4*)(out + (size_t)m * DM) + lane; f32x4* oc = (f32x4*)(out + (size_t)mb * DM) + lane;
#pragma unroll
            for (int j = 0; j < 4; ++j) oa[64 * j] = va[j] * ra * gg[j];
            if (has2) {
#pragma unroll
                for (int j = 0; j < 4; ++j) oc[64 * j] = vc[j] * rc * gg[j];
            }
        }
        PH_END(13);
    }
}

extern "C" void kernel_launch(void* const* d_in, const int* in_sizes, int n_in, void* d_out, int out_size, void* d_ws, size_t ws_size, hipStream_t stream) {
    static int grid = 0;
    if (grid == 0) {
        if (n_in != 12 || in_sizes[0] != MROWS * DM || out_size != MROWS * DM || ws_size < WS_END) {
            fprintf(stderr, "kernel_launch: unexpected shapes (n_in %d, in0 %d, out %d, ws %zu); nothing launched\n", n_in, n_in > 0 ? in_sizes[0] : -1, out_size, ws_size); grid = -1; return; }
        int dev = 0, cus = 0, per_cu = 0;
        if (hipGetDevice(&dev) != hipSuccess || hipDeviceGetAttribute(&cus, hipDeviceAttributeMultiprocessorCount, dev) != hipSuccess) { grid = -1; return; }
        if (hipFuncSetAttribute((const void*)moba_fwd, hipFuncAttributeMaxDynamicSharedMemorySize, LDS_BYTES) != hipSuccess) { fprintf(stderr, "kernel_launch: hipFuncSetAttribute failed\n"); grid = -1; return; }
        if (hipOccupancyMaxActiveBlocksPerMultiprocessor(&per_cu, (const void*)moba_fwd, NWAVES * 64, LDS_BYTES) != hipSuccess || per_cu < 1) {
            fprintf(stderr, "kernel_launch: occupancy query reports %d blocks per CU; nothing launched\n", per_cu); (void)hipGetLastError(); grid = -1; return; }
        grid = cus;
    }
    if (grid < 0) return;
    if (hipMemsetAsync((char*)d_ws + WS_CTL, 0, CTL_ZERO_BYTES, stream) != hipSuccess) return;
    Args a{};
    for (int i = 0; i < 12; ++i) a.in[i] = (const float*)d_in[i];
    a.out = (float*)d_out; a.ws = (unsigned char*)d_ws;
    hipLaunchKernelGGL(moba_fwd, dim3(grid), dim3(NWAVES * 64), LDS_BYTES, stream, a);
}
```

```cpp
#include <hip/hip_runtime.h>
#include <cstdio>
#include <cstdint>
#define PROBE_MASK_V 0u
namespace pg8 {
#define PG8_LAS __attribute__((address_space(3)))
typedef unsigned short bf16_t;
typedef short bf16x8 __attribute__((ext_vector_type(8)));
typedef float f32x4 __attribute__((ext_vector_type(4)));
typedef unsigned u32x4 __attribute__((ext_vector_type(4)));
constexpr int BM = 256, BK = 64, HALF = 128, HTB = HALF * BK * 2  , STAGE_BYTES = 8 * HTB, NXCD = 8, WGM = 8;

__host__ __device__ __forceinline__ int lds_byte(int r, int c) { const int st = (r >> 4) * 2 + (c >> 5), rr = r & 15, cc = c & 31, ob = rr * 64 + cc * 2; return st * 1024 + (ob ^ (((ob >> 9) & 1) << 5)); }
__host__ __device__ __forceinline__ void stage_rc(int b, int& R, int& C) { const int st = b / 1024, sb = b % 1024, swz = sb ^ (((sb >> 9) & 1) << 5); R = (st >> 1) * 16 + swz / 64; C = (st & 1) * 32 + (swz % 64) / 2; }
__host__ __device__ __forceinline__ int perm32(int rho) { const int n = rho >> 4, i = rho & 15; return 8 * (i >> 2) + 4 * n + (i & 3); }

struct Unit { int pm, pn; };
struct Gemm { const bf16_t* A; const bf16_t* Bt; int M, N, K; };

struct StaticOrder {
    int nM, nN, nwg, G, c, wgm;
    __host__ __device__ void init(int M, int N, int G_, int c_, int wgm_ = WGM) { nM = M / BM; nN = N / BM; nwg = nM * nN; G = G_; c = c_; wgm = wgm_; }
    __host__ __device__ bool next(int i, Unit& u) const {
        const long L = (long)i * G + c; if (L >= nwg) return false;
        int wgid = (int)L; { const int q = nwg / NXCD, r = nwg % NXCD, xcd = wgid % NXCD, off = wgid / NXCD; wgid = (xcd < r ? xcd * (q + 1) : r * (q + 1) + (xcd - r) * q) + off; }
        const int nig = wgm * nN, gid = wgid / nig, fm = gid * wgm, gsz = (nM - fm) < wgm ? (nM - fm) : wgm;
        u.pm = fm + ((wgid % nig) % gsz); u.pn = (wgid % nig) / gsz; return true;
    }
    __device__ __forceinline__ void a_ready(const Unit&) const {}
    __device__ __forceinline__ void done(const Unit&) const {}
};

__device__ __forceinline__ unsigned cvt_pk_bf16(float lo, float hi) { unsigned r; asm volatile("v_cvt_pk_bf16_f32 %0, %1, %2" : "=v"(r) : "v"(lo), "v"(hi)); return r; }
constexpr int   ROWLEN = 1024;
constexpr float RMS_EPS = 1e-6f, INV_D = 1.0f / 1024.0f;
__device__ __forceinline__ u32x4 pack8(const f32x4 a, const f32x4 b) { u32x4 w; w.x = cvt_pk_bf16(a[0], a[1]); w.y = cvt_pk_bf16(a[2], a[3]); w.z = cvt_pk_bf16(b[0], b[1]); w.w = cvt_pk_bf16(b[2], b[3]); return w; }
__device__ __forceinline__ float rowscale(const float* ss, int row) { return __builtin_amdgcn_rsqf(ss[row] * INV_D + RMS_EPS); }

struct EpiQKV {
    static constexpr bool PERM = true, AFTER_DRAIN = false;
    bf16_t* Q; size_t tstride; const float* ss; float* ksum; float qscale;
    __device__ __forceinline__ void prefetch(float (&pfr)[8], const Unit& u, int wr, int fr) const {
#pragma unroll
        for (int ai = 0; ai < 2; ++ai)
#pragma unroll
            for (int m = 0; m < 4; ++m) pfr[ai * 4 + m] = ss[u.pm * BM + ai * HALF + wr * 64 + m * 16 + fr];
    }
    __device__ __forceinline__ void operator()(const f32x4 (&acc)[2][2][4][2], const Unit& u, int wr, int wc, int fr, int fq) const {
        float pfr[8]; prefetch(pfr, u, wr, fr);
        const int t = u.pn >> 2, colt = (u.pn & 3) * BM + wc * 32 + 8 * fq;
        bf16_t* base = Q + (size_t)t * tstride;
        const float sc = (t == 0) ? qscale : 1.0f;
        f32x4 cs[2][2];
#pragma unroll
        for (int bj = 0; bj < 2; ++bj)
#pragma unroll
            for (int n = 0; n < 2; ++n) cs[bj][n] = (f32x4){0.f, 0.f, 0.f, 0.f};
#pragma unroll
        for (int ai = 0; ai < 2; ++ai)
#pragma unroll
            for (int m = 0; m < 4; ++m) {
                const int row = u.pm * BM + ai * HALF + wr * 64 + m * 16 + fr;
                const float r = __builtin_amdgcn_rsqf(pfr[ai * 4 + m] * INV_D + RMS_EPS) * sc;
#pragma unroll
                for (int bj = 0; bj < 2; ++bj) {
                    const f32x4 v0 = acc[ai][bj][m][0] * r, v1 = acc[ai][bj][m][1] * r;
                    cs[bj][0] += v0; cs[bj][1] += v1;
                    *(u32x4*)(base + (size_t)row * ROWLEN + colt + bj * HALF) = pack8(v0, v1);
                }
            }
        if (t == 1) {
#pragma unroll
            for (int bj = 0; bj < 2; ++bj)
#pragma unroll
                for (int n = 0; n < 2; ++n)
#pragma unroll
                    for (int e = 0; e < 4; ++e) {
                        float s = cs[bj][n][e];
                        s += __shfl_xor(s, 1); s += __shfl_xor(s, 2); s += __shfl_xor(s, 4); s += __shfl_xor(s, 8);
                        if (fr == 0) atomicAdd(ksum + (size_t)u.pm * ROWLEN + colt + bj * HALF + 4 * n + e, s);
                    }
        }
    }
};

template <bool F32IN, bool WANT_SS> struct EpiRes {
    static constexpr bool PERM = true, AFTER_DRAIN = false;
    const float* xin; bf16_t* xb; float* ss;
    __device__ __forceinline__ void prefetch(float (&pfr)[8], const Unit&, int, int) const {
#pragma unroll
        for (int i = 0; i < 8; ++i) pfr[i] = 0.f;
    }
    __device__ __forceinline__ void operator()(const f32x4 (&acc)[2][2][4][2], const Unit& u, int wr, int wc, int fr, int fq) const {
        float pfr[8]; prefetch(pfr, u, wr, fr);
        const int col0 = u.pn * BM + wc * 32 + 8 * fq;
        if (F32IN) {
#pragma unroll
            for (int ai = 0; ai < 2; ++ai) {
                f32x4 pre[4][2][2];
#pragma unroll
                for (int m = 0; m < 4; ++m)
#pragma unroll
                    for (int bj = 0; bj < 2; ++bj) { const size_t off = (size_t)(u.pm * BM + ai * HALF + wr * 64 + m * 16 + fr) * ROWLEN + col0 + bj * HALF; pre[m][bj][0] = __builtin_nontemporal_load((const f32x4*)(xin + off)); pre[m][bj][1] = __builtin_nontemporal_load((const f32x4*)(xin + off + 4)); }
#pragma unroll
                for (int m = 0; m < 4; ++m) {
                    const int row = u.pm * BM + ai * HALF + wr * 64 + m * 16 + fr;
                    float sq = 0.f;
#pragma unroll
                    for (int bj = 0; bj < 2; ++bj) {
                        const size_t off = (size_t)row * ROWLEN + col0 + bj * HALF;
                        const f32x4 v0 = pre[m][bj][0] + acc[ai][bj][m][0], v1 = pre[m][bj][1] + acc[ai][bj][m][1];
                        *(u32x4*)(xb + off) = pack8(v0, v1);
                        if (WANT_SS) sq += (v0[0] * v0[0] + v0[1] * v0[1]) + (v0[2] * v0[2] + v0[3] * v0[3]) + (v1[0] * v1[0] + v1[1] * v1[1]) + (v1[2] * v1[2] + v1[3] * v1[3]);
                    }
                    if (WANT_SS) { sq += __shfl_xor(sq, 16); sq += __shfl_xor(sq, 32); if (fq == 0) atomicAdd(ss + row, sq); }
                }
            }
        } else {
            u32x4 pre[2][4][2];
#pragma unroll
            for (int ai = 0; ai < 2; ++ai)
#pragma unroll
                for (int m = 0; m < 4; ++m)
#pragma unroll
                    for (int bj = 0; bj < 2; ++bj) pre[ai][m][bj] = *(const u32x4*)(xb + (size_t)(u.pm * BM + ai * HALF + wr * 64 + m * 16 + fr) * ROWLEN + col0 + bj * HALF);
#pragma unroll
            for (int ai = 0; ai < 2; ++ai)
#pragma unroll
                for (int m = 0; m < 4; ++m) {
                    const int row = u.pm * BM + ai * HALF + wr * 64 + m * 16 + fr;
                    float sq = 0.f;
#pragma unroll
                    for (int bj = 0; bj < 2; ++bj) {
                        const size_t off = (size_t)row * ROWLEN + col0 + bj * HALF;
                        const u32x4 p = pre[ai][m][bj];
                        const f32x4 x0 = (f32x4){__uint_as_float(p.x << 16), __uint_as_float(p.x & 0xffff0000u), __uint_as_float(p.y << 16), __uint_as_float(p.y & 0xffff0000u)};
                        const f32x4 x1 = (f32x4){__uint_as_float(p.z << 16), __uint_as_float(p.z & 0xffff0000u), __uint_as_float(p.w << 16), __uint_as_float(p.w & 0xffff0000u)};
                        const f32x4 v0 = x0 + acc[ai][bj][m][0], v1 = x1 + acc[ai][bj][m][1];
                        *(u32x4*)(xb + off) = pack8(v0, v1);
                        if (WANT_SS) sq += (v0[0] * v0[0] + v0[1] * v0[1]) + (v0[2] * v0[2] + v0[3] * v0[3]) + (v1[0] * v1[0] + v1[1] * v1[1]) + (v1[2] * v1[2] + v1[3] * v1[3]);
                    }
                    if (WANT_SS) { sq += __shfl_xor(sq, 16); sq += __shfl_xor(sq, 32); if (fq == 0) atomicAdd(ss + row, sq); }
                }
        }
    }
};

struct EpiSwiglu {
    static constexpr bool PERM = true, AFTER_DRAIN = false;
    bf16_t* Hh; int ldh; const float* ss;
    __device__ __forceinline__ void prefetch(float (&pfr)[8], const Unit& u, int wr, int fr) const {
#pragma unroll
        for (int ai = 0; ai < 2; ++ai)
#pragma unroll
            for (int m = 0; m < 4; ++m) pfr[ai * 4 + m] = ss[u.pm * BM + ai * HALF + wr * 64 + m * 16 + fr];
    }
    __device__ __forceinline__ void operator()(const f32x4 (&acc)[2][2][4][2], const Unit& u, int wr, int wc, int fr, int fq) const {
        float pfr[8]; prefetch(pfr, u, wr, fr);
        const int col0 = u.pn * HALF + wc * 32 + 8 * fq;
#pragma unroll
        for (int ai = 0; ai < 2; ++ai)
#pragma unroll
            for (int m = 0; m < 4; ++m) {
                const int row = u.pm * BM + ai * HALF + wr * 64 + m * 16 + fr;
                const float r = __builtin_amdgcn_rsqf(pfr[ai * 4 + m] * INV_D + RMS_EPS);
                f32x4 hv[2];
#pragma unroll
                for (int n = 0; n < 2; ++n) {
                    const f32x4 g = acc[ai][0][m][n] * r, uu = acc[ai][1][m][n] * r;
#pragma unroll
                    for (int e = 0; e < 4; ++e) hv[n][e] = g[e] * uu[e] * __builtin_amdgcn_rcpf(1.0f + __builtin_amdgcn_exp2f(g[e] * -1.4426950408889634f));
                }
                *(u32x4*)(Hh + (size_t)row * ldh + col0) = pack8(hv[0], hv[1]);
            }
    }
};

struct EpiConvIn {
    static constexpr bool PERM = true, AFTER_DRAIN = false;
    bf16_t* U; bf16_t* Bb; const float* ss;
    __device__ __forceinline__ void prefetch(float (&pfr)[8], const Unit& u, int wr, int fr) const {
#pragma unroll
        for (int ai = 0; ai < 2; ++ai)
#pragma unroll
            for (int m = 0; m < 4; ++m) pfr[ai * 4 + m] = ss[u.pm * BM + ai * HALF + wr * 64 + m * 16 + fr];
    }
    __device__ __forceinline__ void operator()(const f32x4 (&acc)[2][2][4][2], const Unit& u, int wr, int wc, int fr, int fq) const {
        float pfr[8]; prefetch(pfr, u, wr, fr);
#pragma unroll
        for (int ai = 0; ai < 2; ++ai)
#pragma unroll
            for (int m = 0; m < 4; ++m) {
                const int row = u.pm * BM + ai * HALF + wr * 64 + m * 16 + fr;
                const float r = __builtin_amdgcn_rsqf(pfr[ai * 4 + m] * INV_D + RMS_EPS);
                if (u.pn < 8) {
                    const float r2 = r * r;
                    const f32x4 a = acc[ai][0][m][0] * acc[ai][1][m][0] * r2, b = acc[ai][0][m][1] * acc[ai][1][m][1] * r2;
                    *(u32x4*)(U + (size_t)row * ROWLEN + u.pn * HALF + wc * 32 + 8 * fq) = pack8(a, b);
                } else {
#pragma unroll
                    for (int bj = 0; bj < 2; ++bj)
                        *(u32x4*)(Bb + (size_t)row * ROWLEN + (u.pn - 8) * BM + bj * HALF + wc * 32 + 8 * fq) = pack8(acc[ai][bj][m][0] * r, acc[ai][bj][m][1] * r);
                }
            }
    }
};

template <class Epi, class Sched, bool ALIGN_EPI = false, bool SP2 = false>
__device__ __forceinline__ void gemm_phase(PG8_LAS unsigned char* lds, const Gemm g, const Sched& S, const Epi& E, const int wave_id) {
    int lane_ = __builtin_amdgcn_mbcnt_hi(~0u, __builtin_amdgcn_mbcnt_lo(~0u, 0u)); asm volatile("" : "+v"(lane_));
    const int wid = wave_id, tid = wid * 64 + lane_, lane = lane_, wr = wid >> 2, wc = wid & 3, fr = lane & 15, fq = lane >> 4;
    const int K = g.K, nt = K / BK;
    unsigned voffA[2], voffB[2];
#pragma unroll
    for (int i = 0; i < 2; ++i) { int R, C; stage_rc(tid * 16 + i * 8192, R, C); const int Rb = Epi::PERM ? ((R & ~31) + perm32(R & 31)) : R;
        voffA[i] = (unsigned)(R * K + C) * 2u; voffB[i] = (unsigned)(Rb * K + C) * 2u; }
    const size_t kstep = (size_t)(BK * 2);
    const size_t hstep = (size_t)HALF * K * 2;
    const size_t tstep = 2 * hstep;
    const unsigned ldsw = (unsigned)wid * 1024u;
    const int aoff = lds_byte(wr * 64 + fr, fq * 8), boff = lds_byte(wc * 32 + fr, fq * 8);
#define PG8_SA(b, h) (((b) * 2 + (h)) * HTB)
#define PG8_SB(b, h) ((4 + (b) * 2 + (h)) * HTB)
#define PG8_STAGE(bufoff, gbase, voff) do { _Pragma("unroll") for (int _i = 0; _i < 2; ++_i) \
        __builtin_amdgcn_global_load_lds((const unsigned*)((const char*)(gbase) + (voff)[_i]), (PG8_LAS unsigned*)(lds + (bufoff) + ldsw + _i * 8192), 16, 0, 0); } while (0)
#define PG8_LDA(dst, b, h) do { _Pragma("unroll") for (int m = 0; m < 4; ++m) _Pragma("unroll") for (int k = 0; k < 2; ++k) dst[m][k] = *(const PG8_LAS bf16x8*)(lds + PG8_SA(b, h) + aoff + m * 2048 + k * 1024); } while (0)
#define PG8_LDB(dst, b, h) do { _Pragma("unroll") for (int n = 0; n < 2; ++n) _Pragma("unroll") for (int k = 0; k < 2; ++k) dst[n][k] = *(const PG8_LAS bf16x8*)(lds + PG8_SB(b, h) + boff + n * 2048 + k * 1024); } while (0)
#define PG8_MMA(ai, bj, At, Bt) do { __builtin_amdgcn_s_setprio(1); _Pragma("unroll") for (int m = 0; m < 4; ++m) _Pragma("unroll") for (int n = 0; n < 2; ++n) _Pragma("unroll") for (int k = 0; k < 2; ++k) \
        acc[ai][bj][m][n] = __builtin_amdgcn_mfma_f32_16x16x32_bf16(Bt[n][k], At[m][k], acc[ai][bj][m][n], 0, 0, 0); __builtin_amdgcn_s_setprio(0); } while (0)
#define PG8_WAIT_V(n) asm volatile("s_waitcnt vmcnt(" #n ")" ::: "memory")
#define PG8_WAIT_L(n) asm volatile("s_waitcnt lgkmcnt(" #n ")" ::: "memory")
#define PG8_BAR __builtin_amdgcn_s_barrier()
#define PG8_SCHED __builtin_amdgcn_sched_barrier(0)
    Unit cur, nxt; int ui = 0;
    if (!S.next(0, cur)) return;
    f32x4 acc[2][2][4][2];
#pragma unroll
    for (int a = 0; a < 2; ++a)
#pragma unroll
        for (int b = 0; b < 2; ++b)
#pragma unroll
            for (int m = 0; m < 4; ++m)
#pragma unroll
                for (int n = 0; n < 2; ++n) acc[a][b][m][n] = (f32x4){0.f, 0.f, 0.f, 0.f};
    bf16x8 At[4][2], B0[2][2], B1[2][2];
    const char* cA = (const char*)g.A + (size_t)cur.pm * tstep; const char* cB = (const char*)g.Bt + (size_t)cur.pn * tstep;
    S.a_ready(cur);
    if constexpr (SP2) {
        PG8_STAGE(PG8_SB(0, 0), cB, voffB); PG8_STAGE(PG8_SB(0, 1), cB + hstep, voffB); PG8_STAGE(PG8_SA(0, 0), cA, voffA); PG8_STAGE(PG8_SA(0, 1), cA + hstep, voffA);
        if (wr == 1) PG8_BAR;
        PG8_WAIT_V(2); PG8_BAR;
        PG8_STAGE(PG8_SB(1, 0), cB + kstep, voffB); PG8_STAGE(PG8_SA(1, 0), cA + kstep, voffA); PG8_STAGE(PG8_SB(1, 1), cB + hstep + kstep, voffB);
        PG8_WAIT_V(6); PG8_BAR;
    } else {
        PG8_STAGE(PG8_SB(0, 0), cB, voffB); PG8_STAGE(PG8_SA(0, 0), cA, voffA); PG8_STAGE(PG8_SB(0, 1), cB + hstep, voffB); PG8_STAGE(PG8_SA(0, 1), cA + hstep, voffA);
        if (wr == 1) PG8_BAR;
        PG8_WAIT_V(4); PG8_BAR;
        PG8_STAGE(PG8_SB(1, 0), cB + kstep, voffB); PG8_STAGE(PG8_SA(1, 0), cA + kstep, voffA); PG8_STAGE(PG8_SB(1, 1), cB + hstep + kstep, voffB);
        PG8_WAIT_V(6); PG8_BAR;
    }
    for (;;) {
        const bool has_next = S.next(ui + 1, nxt);
        const char* nA = has_next ? (const char*)g.A + (size_t)nxt.pm * tstep : cA; const char* nB = has_next ? (const char*)g.Bt + (size_t)nxt.pn * tstep : cB;
        for (int t = 0; t < nt; t += 2) {
            const bool last = (t == nt - 2);
            const char* a1 = cA + (size_t)(t + 1) * kstep;
            const char* a2 = last ? nA : cA + (size_t)(t + 2) * kstep; const char* b2 = last ? nB : cB + (size_t)(t + 2) * kstep;
            const char* a3 = a2 + kstep; const char* b3 = b2 + kstep;
            if (last && has_next) S.a_ready(nxt);
            if constexpr (SP2) {
            PG8_LDB(B0, 0, 0); PG8_LDB(B1, 0, 1); PG8_SCHED; PG8_LDA(At, 0, 0); PG8_STAGE(PG8_SA(1, 1), a1 + hstep, voffA);
            PG8_WAIT_V(8); PG8_WAIT_L(0); PG8_BAR; PG8_MMA(0, 0, At, B0); PG8_MMA(0, 1, At, B1); PG8_BAR; PG8_SCHED;
            PG8_LDA(At, 0, 1); PG8_STAGE(PG8_SB(0, 0), b2, voffB); PG8_STAGE(PG8_SB(0, 1), b2 + hstep, voffB); PG8_STAGE(PG8_SA(0, 0), a2, voffA);
            PG8_WAIT_V(8); PG8_WAIT_L(0); PG8_BAR; PG8_MMA(1, 0, At, B0); PG8_MMA(1, 1, At, B1); PG8_BAR; PG8_SCHED;
            PG8_LDB(B0, 1, 0); PG8_LDB(B1, 1, 1); PG8_SCHED; PG8_LDA(At, 1, 0); PG8_STAGE(PG8_SA(0, 1), a2 + hstep, voffA);
            PG8_WAIT_V(8); PG8_WAIT_L(0); PG8_BAR; PG8_MMA(0, 0, At, B0); PG8_MMA(0, 1, At, B1); PG8_BAR; PG8_SCHED;
            PG8_LDA(At, 1, 1); PG8_STAGE(PG8_SB(1, 0), b3, voffB); PG8_STAGE(PG8_SB(1, 1), b3 + hstep, voffB); PG8_STAGE(PG8_SA(1, 0), a3, voffA);
            PG8_WAIT_V(8); PG8_WAIT_L(0); PG8_BAR; PG8_MMA(1, 0, At, B0); PG8_MMA(1, 1, At, B1); PG8_BAR; PG8_SCHED;
            } else {
            PG8_LDB(B0, 0, 0); PG8_SCHED; PG8_LDA(At, 0, 0); PG8_STAGE(PG8_SA(1, 1), a1 + hstep, voffA);
            PG8_WAIT_L(8); PG8_BAR; PG8_WAIT_L(0); PG8_MMA(0, 0, At, B0); PG8_BAR; PG8_SCHED;
            PG8_LDB(B1, 0, 1); PG8_STAGE(PG8_SB(0, 0), b2, voffB);
            PG8_BAR; PG8_WAIT_L(0); PG8_MMA(0, 1, At, B1); PG8_BAR;
            PG8_LDA(At, 0, 1); PG8_STAGE(PG8_SA(0, 0), a2, voffA);
            PG8_BAR; PG8_WAIT_L(0); PG8_MMA(1, 0, At, B0); PG8_BAR; PG8_SCHED;
            PG8_STAGE(PG8_SB(0, 1), b2 + hstep, voffB);
            PG8_WAIT_V(6); PG8_BAR; PG8_MMA(1, 1, At, B1); PG8_BAR;
            PG8_LDB(B0, 1, 0); PG8_SCHED; PG8_LDA(At, 1, 0); PG8_STAGE(PG8_SA(0, 1), a2 + hstep, voffA);
            PG8_WAIT_L(8); PG8_BAR; PG8_WAIT_L(0); PG8_MMA(0, 0, At, B0); PG8_BAR; PG8_SCHED;
            PG8_LDB(B1, 1, 1); PG8_STAGE(PG8_SB(1, 0), b3, voffB);
            PG8_BAR; PG8_WAIT_L(0); PG8_MMA(0, 1, At, B1); PG8_BAR;
            PG8_LDA(At, 1, 1); PG8_STAGE(PG8_SA(1, 0), a3, voffA);
            PG8_BAR; PG8_WAIT_L(0); PG8_MMA(1, 0, At, B0); PG8_BAR; PG8_SCHED;
            PG8_STAGE(PG8_SB(1, 1), b3 + hstep, voffB);
            PG8_WAIT_V(6); PG8_BAR; PG8_MMA(1, 1, At, B1); PG8_BAR;
            }
        }
        if constexpr (ALIGN_EPI) { if (wr == 0) PG8_BAR; }
        if constexpr (!Epi::AFTER_DRAIN) {
            const bool epi_probe_ = (PROBE_MASK_V & (1u << 15)) || ((PROBE_MASK_V & (1u << 16)) && g.N == 5632) || ((PROBE_MASK_V & (1u << 17)) && g.N == 3072) || ((PROBE_MASK_V & (1u << 18)) && g.N == 1024);
            const unsigned long long te0_ = epi_probe_ ? __builtin_amdgcn_s_memrealtime() : 0ull;
            E(acc, cur, wr, wc, fr, fq); S.done(cur);
            if (epi_probe_) { const unsigned long long te1_ = __builtin_amdgcn_s_memrealtime(); while (__builtin_amdgcn_s_memrealtime() - te1_ < te1_ - te0_) __builtin_amdgcn_s_sleep(4); }
        }
        if (!has_next) break;
#pragma unroll
        for (int a = 0; a < 2; ++a)
#pragma unroll
            for (int b = 0; b < 2; ++b)
#pragma unroll
                for (int m = 0; m < 4; ++m)
#pragma unroll
                    for (int n = 0; n < 2; ++n) acc[a][b][m][n] = (f32x4){0.f, 0.f, 0.f, 0.f};
        cur = nxt; cA = nA; cB = nB; ++ui;
        if constexpr (ALIGN_EPI) { if (wr == 1) PG8_BAR; }
    }
    PG8_WAIT_V(0);
    if constexpr (!ALIGN_EPI) { if (wr == 0) PG8_BAR; }
    PG8_BAR;
    if constexpr (Epi::AFTER_DRAIN) { E.fused(acc, cur, wr, wc, fr, fq, lds, wid, lane); S.done(cur); }
#undef PG8_SA
#undef PG8_SB
#undef PG8_STAGE
#undef PG8_LDA
#undef PG8_LDB
#undef PG8_MMA
#undef PG8_WAIT_V
#undef PG8_WAIT_L
#undef PG8_BAR
#undef PG8_SCHED
}
}

#ifndef PG8_SP2
#define PG8_SP2 true
#endif
#ifndef PG8_ALIGN
#define PG8_ALIGN true
#endif
#define GAS __attribute__((address_space(1)))
#define LAS __attribute__((address_space(3)))
typedef unsigned short bf16;
typedef unsigned v4u __attribute__((ext_vector_type(4)));
typedef float f32x4 __attribute__((ext_vector_type(4)));
typedef short bf16x8 __attribute__((ext_vector_type(8)));
typedef GAS unsigned gu32;
typedef GAS unsigned long long gu64;
#define RLX_AGENT __ATOMIC_RELAXED, __HIP_MEMORY_SCOPE_AGENT
#define LDS_WAIT() asm volatile("s_waitcnt lgkmcnt(0)" ::: "memory")
#define VM_WAIT() asm volatile("s_waitcnt vmcnt(0)" ::: "memory")
__device__ __forceinline__ unsigned long long rt() { return __builtin_amdgcn_s_memrealtime(); }

#define XB_TMO      128
#define XB_XCNT(j)  (256  + 64 * (j))
#define XB_XSUB(j)  (1280 + 64 * (j))
#define XB_XGEN(j)  (2304 + 64 * (j))
#define XB_TOP      3328
#define XB_TOPGEN   3392
#define XCD_BAR_WORDS 3456
#define XB_SPIN_CAP (1u << 18)

__device__ __forceinline__ unsigned xb_ld(unsigned* p)              { return __hip_atomic_load(p, __ATOMIC_RELAXED, __HIP_MEMORY_SCOPE_AGENT); }
__device__ __forceinline__ unsigned xb_add(unsigned* p, unsigned v) { return __hip_atomic_fetch_add(p, v, __ATOMIC_RELAXED, __HIP_MEMORY_SCOPE_AGENT); }
__device__ __forceinline__ unsigned xb_xcc_id() { return (unsigned)__builtin_amdgcn_s_getreg((3 << 11) | 20) & 0xFu; }
#define XB_SPIN(cond, bar) do { unsigned _sp = 0; while (cond) { __builtin_amdgcn_s_sleep(1); \
    if ((++_sp & 255u) == 0u) { if (xb_ld(&(bar)[XB_TMO])) break; if (_sp > XB_SPIN_CAP) { atomicAdd(&(bar)[XB_TMO], 1u); break; } } } } while (0)

struct XcdBarrier {
    unsigned* bar; unsigned x;
    volatile LAS unsigned* st;
};

__device__ __forceinline__ XcdBarrier xcd_barrier_post(unsigned* bar, volatile LAS unsigned* st) {
    XcdBarrier b; b.bar = bar; b.x = xb_xcc_id(); b.st = st;
    if (threadIdx.x == 0) (void)xb_add(&bar[XB_XCNT(b.x)], 1u);
    return b;
}
__device__ __forceinline__ void xcd_barrier_complete(unsigned* bar, unsigned x, unsigned& nloc, unsigned& nx) {
    const unsigned G = gridDim.x * gridDim.y * gridDim.z;
    unsigned sum, cnt, mine, sp = 0u;
    for (;;) {
        sum = 0u; cnt = 0u; mine = 0u;
#pragma unroll
        for (unsigned j = 0; j < 16; ++j) { const unsigned c = xb_ld(&bar[XB_XCNT(j)]); sum += c; cnt += (c > 0u) ? 1u : 0u; mine = (j == x) ? c : mine; }
        if (sum == G) break;
        __builtin_amdgcn_s_sleep(1);
        if ((++sp & 255u) == 0u) { if (xb_ld(&bar[XB_TMO])) break; if (sp > XB_SPIN_CAP) { atomicAdd(&bar[XB_TMO], 1u); break; } }
    }
    nloc = mine > 0u ? mine : 1u; nx = cnt > 0u ? cnt : 1u;
}

__device__ __forceinline__ void xcd_barrier(const XcdBarrier& b, const bool lead) {
    asm volatile("s_waitcnt vmcnt(0)" ::: "memory");
    __syncthreads();
    if (lead) {
        unsigned* bar = b.bar;
        __builtin_amdgcn_s_waitcnt(0);
        unsigned nloc = b.st[0], nx = b.st[1];
        if (nloc == 0u) { xcd_barrier_complete(bar, b.x, nloc, nx); b.st[0] = nloc; b.st[1] = nx; }
        const unsigned old = xb_add(&bar[XB_XSUB(b.x)], 1u);
        const unsigned gen = old / nloc;
        if (old + 1u == (gen + 1u) * nloc) {
            __builtin_amdgcn_fence(__ATOMIC_RELEASE, "agent");
            asm volatile("s_waitcnt vmcnt(0)" ::: "memory");
            const unsigned og = xb_add(&bar[XB_TOP], 1u);
            const unsigned tg = og / nx;
            if (og + 1u == (tg + 1u) * nx) xb_add(&bar[XB_TOPGEN], 1u);
            else XB_SPIN(xb_ld(&bar[XB_TOPGEN]) == tg, bar);
            __builtin_amdgcn_fence(__ATOMIC_ACQUIRE, "agent");
            xb_add(&bar[XB_XGEN(b.x)], 1u);
            asm volatile("s_waitcnt vmcnt(0)" ::: "memory");
        } else {
            XB_SPIN(xb_ld(&bar[XB_XGEN(b.x)]) == gen, bar);
            __builtin_amdgcn_fence(__ATOMIC_ACQUIRE, "agent");
            asm volatile("s_waitcnt vmcnt(0)" ::: "memory");
        }
    }
    __syncthreads();
}

constexpr int NWAVES = 8;
constexpr int BATCH = 4, SEQ = 8192, DM = 1024, NH = 8, HD = 128, FF = 2816, MROWS = BATCH * SEQ;
constexpr int BS = 256, NBLK = SEQ / BS;
constexpr float QSCALE = 0.08838834764831845f * 1.4426950408889634f;
constexpr float EPS = 1e-6f;
#ifndef WGM_SET
#define WGM_SET 4, 4, 4, 4
#endif
constexpr int WGM_ARR[4] = {WGM_SET};
constexpr int WGM_N3072 = WGM_ARR[0], WGM_FFNIN = WGM_ARR[1], WGM_N1024 = WGM_ARR[2], WGM_FFNOUT = WGM_ARR[3];

constexpr size_t MiB = 1u << 20;
constexpr size_t WS_CTL = 0, CTL_ZERO_BYTES = 1 * MiB;
constexpr size_t WS_KSUM = 1 * MiB;
constexpr size_t WS_SS = 1 * MiB + 512 * 1024;
constexpr size_t WS_SS0 = 2 * MiB;
constexpr size_t WS_WQKV = 4 * MiB, WS_WO = 10 * MiB, WS_WF1 = 12 * MiB  , WS_WF2 = 34 * MiB  , WS_WCI = 45 * MiB, WS_WCO = 51 * MiB;
constexpr size_t WS_Q = 56 * MiB, WS_K = 120 * MiB, WS_V = 184 * MiB;
constexpr size_t WS_XB = 248 * MiB;
constexpr size_t WS_H = 312 * MiB;
constexpr size_t WS_END = 504 * MiB;
static_assert(WS_H + (size_t)MROWS * FF * 2 <= WS_END, "ws map");
constexpr int CW_TMO = 0, CW_CODE = 1, CW_BAR = 4096;

constexpr int RING_OFF = 0, RING_BYTES = 131072;
constexpr int LDSCTL_OFF = RING_BYTES, MISC_OFF = LDSCTL_OFF + 320;
constexpr int LDS_BYTES = 147456;

__device__ __forceinline__ float wave_sum(float v) {
#pragma unroll
    for (int o = 1; o < 64; o <<= 1) v += __shfl_xor(v, o);
    return v;
}
__device__ __forceinline__ float bf_lo(unsigned w) { return __uint_as_float(w << 16); }
__device__ __forceinline__ float bf_hi(unsigned w) { return __uint_as_float(w & 0xffff0000u); }
__device__ __forceinline__ unsigned pk2(float lo, float hi) { return pg8::cvt_pk_bf16(lo, hi); }

__device__ __forceinline__ void p0_item(const float* W, int N, int K, int k0, int n_src0, bf16* WT, int n_dst0, const float* gain, LAS unsigned char* scr, int lane) {
    const int lq = lane >> 4, ln = lane & 15;
    const float gv = gain ? gain[k0 + lane] : 1.0f;
    f32x4 v[16];
    const float* src = W + (size_t)(k0 + 2 * lq) * N + n_src0 + 4 * ln;
#pragma unroll
    for (int i = 0; i < 16; ++i) v[i] = __builtin_nontemporal_load((const f32x4*)(src + (size_t)(8 * (i >> 1) + (i & 1)) * N));
#pragma unroll
    for (int p = 0; p < 8; ++p) {
        const float g0 = __shfl(gv, 8 * p + 2 * lq), g1 = __shfl(gv, 8 * p + 2 * lq + 1);
#pragma unroll
        for (int e = 0; e < 4; ++e) *(LAS unsigned*)(scr + (4 * ln + e) * 144 + (8 * p + 2 * lq) * 2) = pk2(v[2 * p][e] * g0, v[2 * p + 1][e] * g1);
    }
    LDS_WAIT(); asm volatile("" ::: "memory");
#pragma unroll
    for (int r = 0; r < 8; ++r) { const int row = 8 * r + (lane >> 3), c = lane & 7;
        const v4u o = *(const LAS v4u*)(scr + row * 144 + c * 16);
        *(v4u*)(WT + (size_t)(n_dst0 + row) * K + k0 + 8 * c) = o; }
    LDS_WAIT(); asm volatile("" ::: "memory");
}
__device__ __forceinline__ int interleave128(int n, int half_cols) { const int hsel = n >= half_cols ? 1 : 0, nn = n - hsel * half_cols; return 256 * (nn >> 7) + 128 * hsel + (nn & 127); }

struct Args { const float* in[12]; float* out; unsigned char* ws; };

__device__ __forceinline__ void naive_attn_item(bf16* Q, const bf16* Kb, const bf16* Vb, const float* ksum, int m, int h, int lane) {
    const int t = m & (SEQ - 1), b = m / SEQ, ib = t / BS;
    const size_t qoff = (size_t)m * DM + h * HD + 2 * lane;
    const unsigned qq = *(const unsigned*)(Q + qoff); const float q0 = bf_lo(qq), q1 = bf_hi(qq);
    int s0 = -1, s1 = -1, s2 = -1; float g0 = -3.0e38f, g1 = -3.0e38f, g2 = -3.0e38f;
    for (int j = 0; j < ib; ++j) {
        const float2 km = *(const float2*)(ksum + (size_t)(b * NBLK + j) * DM + h * HD + 2 * lane);
        const float g = wave_sum(q0 * km.x + q1 * km.y);
        if (g > g0) { g2 = g1; s2 = s1; g1 = g0; s1 = s0; g0 = g; s0 = j; }
        else if (g > g1) { g2 = g1; s2 = s1; g1 = g; s1 = j; }
        else if (g > g2) { g2 = g; s2 = j; }
    }
    float mr = -1.0e30f, l = 0.f, o0 = 0.f, o1 = 0.f;
    for (int sidx = 0; sidx < 4; ++sidx) {
        const int blk = sidx == 0 ? s0 : sidx == 1 ? s1 : sidx == 2 ? s2 : ib;
        if (blk < 0) continue;
        const int nk = (sidx == 3) ? (t & (BS - 1)) + 1 : BS;
        const size_t rbase = ((size_t)b * SEQ + (size_t)blk * BS) * DM + h * HD + 2 * lane;
        for (int k0 = 0; k0 < nk; k0 += 4) {
            float d[4]; unsigned vv[4];
#pragma unroll
            for (int u = 0; u < 4; ++u) { const unsigned kk = *(const unsigned*)(Kb + rbase + (size_t)(k0 + u) * DM); vv[u] = *(const unsigned*)(Vb + rbase + (size_t)(k0 + u) * DM); d[u] = q0 * bf_lo(kk) + q1 * bf_hi(kk); }
#pragma unroll
            for (int o = 1; o < 64; o <<= 1) {
#pragma unroll
                for (int u = 0; u < 4; ++u) d[u] += __shfl_xor(d[u], o);
            }
#pragma unroll
            for (int u = 0; u < 4; ++u) if (k0 + u >= nk) d[u] = -1.0e30f;
            const float mn = fmaxf(fmaxf(mr, fmaxf(d[0], d[1])), fmaxf(d[2], d[3]));
            const float a = __builtin_amdgcn_exp2f(mr - mn); l *= a; o0 *= a; o1 *= a; mr = mn;
#pragma unroll
            for (int u = 0; u < 4; ++u) { const float p = __builtin_amdgcn_exp2f(d[u] - mn); l += p; o0 += p * bf_lo(vv[u]); o1 += p * bf_hi(vv[u]); }
        }
    }
    const float il = 1.0f / l;
    *(unsigned*)(Q + qoff) = pk2(o0 * il, o1 * il);
}


typedef float f32x16 __attribute__((ext_vector_type(16)));
typedef short v4i16_t __attribute__((ext_vector_type(4)));
#define MFMA32(a, b, c) __builtin_amdgcn_mfma_f32_32x32x16_bf16((a), (b), (c), 0, 0, 0)
__device__ __forceinline__ int crow(int r, int hi) { return (r & 3) + 8 * (r >> 2) + 4 * hi; }
constexpr int CW_QUEUE = 8192, CW_CNT = 12288;
constexpr int LIST_PER_BH = 256 * 496;
__device__ __forceinline__ int list_off(int j) { return 256 * (31 * j - (j * (j - 1)) / 2); }
constexpr size_t OUT_LSE_OFF = 0, OUT_LIST_OFF = 2u << 20;
constexpr float NEG_BIG = -1.0e30f;
#define GT_(va, ia, vb, ib_) ((va) > (vb) || ((va) == (vb) && (ia) < (ib_)))
#define TOP3_INSERT(v, i) do { const float v_ = (v); const int i_ = (i); \
    if (GT_(v_, i_, v0, i0)) { v2 = v1; i2 = i1; v1 = v0; i1 = i0; v0 = v_; i0 = i_; } \
    else if (GT_(v_, i_, v1, i1)) { v2 = v1; i2 = i1; v1 = v_; i1 = i_; } \
    else if (GT_(v_, i_, v2, i2)) { v2 = v_; i2 = i_; } } while (0)

__device__ __forceinline__ void gate_unit(int b, int ib, int hd, const bf16* Qb, const float* ksum, gu32* gcount, unsigned* lists, LAS unsigned char* lds, int tid, int lane, int wave) {
    const int r32 = lane & 31, hi = lane >> 5, bh = b * NH + hd;
    const int t = ib * BS + wave * 32 + r32;
    LAS unsigned* cnt = (LAS unsigned*)lds; LAS unsigned* basel = cnt + 32;
    if (tid < 32) cnt[tid] = 0u;
    f32x16 acc;
#pragma unroll
    for (int i = 0; i < 16; ++i) acc[i] = 0.f;
    const bf16* qp = Qb + ((size_t)b * SEQ + t) * DM + hd * HD + 8 * hi;
    const float* kp = ksum + (size_t)(b * NBLK + r32) * DM + hd * HD + 8 * hi;
#pragma unroll
    for (int s = 0; s < 8; ++s) {
        const bf16x8 qf = *(const bf16x8*)(qp + 16 * s);
        const f32x4 k0 = *(const f32x4*)(kp + 16 * s), k1 = *(const f32x4*)(kp + 16 * s + 4);
        v4u wh, wl;
        wh.x = pk2(k0[0], k0[1]); wh.y = pk2(k0[2], k0[3]); wh.z = pk2(k1[0], k1[1]); wh.w = pk2(k1[2], k1[3]);
        wl.x = pk2(k0[0] - bf_lo(wh.x), k0[1] - bf_hi(wh.x)); wl.y = pk2(k0[2] - bf_lo(wh.y), k0[3] - bf_hi(wh.y));
        wl.z = pk2(k1[0] - bf_lo(wh.z), k1[1] - bf_hi(wh.z)); wl.w = pk2(k1[2] - bf_lo(wh.w), k1[3] - bf_hi(wh.w));
        acc = MFMA32(__builtin_bit_cast(bf16x8, wh), qf, acc);
        acc = MFMA32(__builtin_bit_cast(bf16x8, wl), qf, acc);
    }
    float v0 = -3.0e38f, v1 = -3.0e38f, v2 = -3.0e38f; int i0 = 99, i1 = 99, i2 = 99;
#pragma unroll
    for (int i = 0; i < 16; ++i) { const int blk = crow(i, hi); const float g = blk < ib ? acc[i] : -3.0e38f; TOP3_INSERT(g, blk); }
    { const float p0 = __shfl_xor(v0, 32), p1 = __shfl_xor(v1, 32), p2 = __shfl_xor(v2, 32); const int q0 = __shfl_xor(i0, 32), q1 = __shfl_xor(i1, 32), q2 = __shfl_xor(i2, 32);
      TOP3_INSERT(p0, q0); TOP3_INSERT(p1, q1); TOP3_INSERT(p2, q2); }
    const bool ok0 = hi == 0 && v0 > -1.0e38f, ok1 = hi == 0 && v1 > -1.0e38f, ok2 = hi == 0 && v2 > -1.0e38f;
    __syncthreads();
    unsigned r0 = 0, r1 = 0, r2 = 0;
    if (ok0) r0 = __hip_atomic_fetch_add(cnt + i0, 1u, __ATOMIC_RELAXED, __HIP_MEMORY_SCOPE_WORKGROUP);
    if (ok1) r1 = __hip_atomic_fetch_add(cnt + i1, 1u, __ATOMIC_RELAXED, __HIP_MEMORY_SCOPE_WORKGROUP);
    if (ok2) r2 = __hip_atomic_fetch_add(cnt + i2, 1u, __ATOMIC_RELAXED, __HIP_MEMORY_SCOPE_WORKGROUP);
    __syncthreads();
    if (tid < 32) { const unsigned c = cnt[tid]; basel[tid] = c ? __hip_atomic_fetch_add(gcount + bh * 32 + tid, c, RLX_AGENT) : 0u; }
    __syncthreads();
    unsigned* lb = lists + (size_t)bh * LIST_PER_BH;
    if (ok0) lb[list_off(i0) + basel[i0] + r0] = (unsigned)t;
    if (ok1) lb[list_off(i1) + basel[i1] + r1] = (unsigned)t | (1u << 13);
    if (ok2) lb[list_off(i2) + basel[i2] + r2] = (unsigned)t | (2u << 13);
    __syncthreads();
}

__device__ __forceinline__ void attn_wave_item(LAS unsigned char* Kimg, LAS unsigned char* Vimg, bf16x8 (&qf)[8], const bf16* qnext, bf16* Opart, float* lse, size_t mrow, int hd, int slot, bool valid, int kmax, bool own, int lane) {
    const int r32 = lane & 31, hi = lane >> 5;
    const int xr = ((r32 & 3) << 2) | ((r32 >> 2) & 3);
    const LAS unsigned char* kb = Kimg + 256 * r32;
    f32x16 S[8];
#pragma unroll
    for (int kt = 0; kt < 8; ++kt)
#pragma unroll
        for (int i = 0; i < 16; ++i) S[kt][i] = 0.f;
    bf16x8 kA[4], kB[4];
#define LOADK(dst, u) do { _Pragma("unroll") for (int j = 0; j < 4; ++j) dst[j] = *(const LAS bf16x8*)(kb + 16 * ((2 * ((u) >> 1) + hi) ^ xr) + 8192 * (4 * ((u) & 1) + j)); } while (0)
#define MMAK(src, u) do { _Pragma("unroll") for (int j = 0; j < 4; ++j) if (4 * ((u) & 1) + j <= kmax) S[4 * ((u) & 1) + j] = MFMA32(src[j], qf[(u) >> 1], S[4 * ((u) & 1) + j]); } while (0)
    LOADK(kA, 0);
    LOADK(kB, 1); MMAK(kA, 0); LOADK(kA, 2); MMAK(kB, 1);
    LOADK(kB, 3); MMAK(kA, 2); LOADK(kA, 4); MMAK(kB, 3);
    LOADK(kB, 5); MMAK(kA, 4); LOADK(kA, 6); MMAK(kB, 5);
    LOADK(kB, 7); MMAK(kA, 6); LOADK(kA, 8); MMAK(kB, 7);
    LOADK(kB, 9); MMAK(kA, 8); LOADK(kA, 10); MMAK(kB, 9);
    LOADK(kB, 11); MMAK(kA, 10); LOADK(kA, 12); MMAK(kB, 11);
    LOADK(kB, 13); MMAK(kA, 12); LOADK(kA, 14); MMAK(kB, 13);
    LOADK(kB, 15); MMAK(kA, 14); MMAK(kB, 15);
#undef LOADK
#undef MMAK
    if (qnext) {
#pragma unroll
        for (int s = 0; s < 8; ++s) qf[s] = *(const bf16x8*)(qnext + 16 * s);
    }
#pragma unroll
    for (int kt = 0; kt < 8; ++kt) {
        if (kt > kmax) {
#pragma unroll
            for (int i = 0; i < 16; ++i) S[kt][i] = NEG_BIG;
        } else if (own && kt == kmax) {
#pragma unroll
            for (int i = 0; i < 16; ++i) if (crow(i, hi) > r32) S[kt][i] = NEG_BIG;
        }
    }
    float mx = NEG_BIG;
#pragma unroll
    for (int kt = 0; kt < 8; ++kt)
#pragma unroll
        for (int i = 0; i < 16; ++i) mx = fmaxf(mx, S[kt][i]);
    mx = fmaxf(mx, __shfl_xor(mx, 32));
    float lsum = 0.f; v4u pw[8][2];
#pragma unroll
    for (int kt = 0; kt < 8; ++kt) {
        float p[16];
#pragma unroll
        for (int i = 0; i < 16; ++i) { p[i] = __builtin_amdgcn_exp2f(S[kt][i] - mx); lsum += p[i]; }
#pragma unroll
        for (int s2 = 0; s2 < 2; ++s2) { pw[kt][s2].x = pk2(p[8 * s2], p[8 * s2 + 1]); pw[kt][s2].y = pk2(p[8 * s2 + 2], p[8 * s2 + 3]); pw[kt][s2].z = pk2(p[8 * s2 + 4], p[8 * s2 + 5]); pw[kt][s2].w = pk2(p[8 * s2 + 6], p[8 * s2 + 7]); }
    }
    lsum += __shfl_xor(lsum, 32);
    int lane_v = lane; asm volatile("" : "+v"(lane_v));
    const int blk = (lane_v >> 4) & 1, q4 = (lane_v & 15) >> 2, p4 = lane_v & 3, hi_v = lane_v >> 5;
    int vb[2][4];
#pragma unroll
    for (int t = 0; t < 2; ++t)
#pragma unroll
        for (int c4 = 0; c4 < 4; ++c4) vb[t][c4] = 256 * (8 * t + 4 * hi_v + q4) + 64 * (c4 ^ q4) + 16 * ((2 * blk + (p4 >> 1)) ^ ((2 * t + hi_v) & 3)) + 8 * (p4 & 1);
    f32x16 O[4];
#pragma unroll
    for (int c4 = 0; c4 < 4; ++c4)
#pragma unroll
        for (int i = 0; i < 16; ++i) O[c4][i] = 0.f;
    v4i16_t vA[4][2], vB[4][2];
#define LOADV(dst, idx) do { _Pragma("unroll") for (int c4 = 0; c4 < 4; ++c4) { \
        dst[c4][0] = __builtin_amdgcn_ds_read_tr16_b64_v4i16((LAS v4i16_t*)(Vimg + vb[0][c4] + 4096 * (idx))); \
        dst[c4][1] = __builtin_amdgcn_ds_read_tr16_b64_v4i16((LAS v4i16_t*)(Vimg + vb[1][c4] + 4096 * (idx))); } } while (0)
#define MMAV(src, idx) do { if (((idx) >> 1) <= kmax) { const bf16x8 pf = __builtin_bit_cast(bf16x8, pw[(idx) >> 1][(idx) & 1]); _Pragma("unroll") for (int c4 = 0; c4 < 4; ++c4) { \
        const bf16x8 vf = (bf16x8){src[c4][0][0], src[c4][0][1], src[c4][0][2], src[c4][0][3], src[c4][1][0], src[c4][1][1], src[c4][1][2], src[c4][1][3]}; O[c4] = MFMA32(vf, pf, O[c4]); } } } while (0)
    LOADV(vA, 0);
    LOADV(vB, 1); MMAV(vA, 0); LOADV(vA, 2); MMAV(vB, 1);
    LOADV(vB, 3); MMAV(vA, 2); LOADV(vA, 4); MMAV(vB, 3);
    LOADV(vB, 5); MMAV(vA, 4); LOADV(vA, 6); MMAV(vB, 5);
    LOADV(vB, 7); MMAV(vA, 6); LOADV(vA, 8); MMAV(vB, 7);
    LOADV(vB, 9); MMAV(vA, 8); LOADV(vA, 10); MMAV(vB, 9);
    LOADV(vB, 11); MMAV(vA, 10); LOADV(vA, 12); MMAV(vB, 11);
    LOADV(vB, 13); MMAV(vA, 12); LOADV(vA, 14); MMAV(vB, 13);
    LOADV(vB, 15); MMAV(vA, 14); MMAV(vB, 15);
#undef LOADV
#undef MMAV
    {
        const float il = 1.0f / lsum;
        const size_t rec = (mrow * NH + hd) * 4 + slot;
        bf16* op = Opart + rec * HD + 8 * hi;
#pragma unroll
        for (int c4 = 0; c4 < 4; ++c4)
#pragma unroll
            for (int g = 0; g < 4; g += 2) {
                unsigned a0 = pk2(O[c4][4 * g] * il, O[c4][4 * g + 1] * il), a1 = pk2(O[c4][4 * g + 2] * il, O[c4][4 * g + 3] * il);
                unsigned b0 = pk2(O[c4][4 * g + 4] * il, O[c4][4 * g + 5] * il), b1 = pk2(O[c4][4 * g + 6] * il, O[c4][4 * g + 7] * il);
                const auto r0 = __builtin_amdgcn_permlane32_swap(a0, b0, false, false); const auto r1 = __builtin_amdgcn_permlane32_swap(a1, b1, false, false);
                if (valid) *(v4u*)(op + 32 * c4 + 8 * g) = (v4u){r0[0], r1[0], r0[1], r1[1]};
            }
        if (valid && hi == 0) lse[rec] = mx + __builtin_log2f(lsum);
    }
}

__device__ __forceinline__ void attn_phase(LAS unsigned char* lds, volatile LAS unsigned* qslot, gu32* ctl, const bf16* Qb, const bf16* Kb, const bf16* Vb, bf16* Opart, float* lse, const unsigned* lists, int tid, int lane, int wave) {
    LAS unsigned char* Kimg = lds; LAS unsigned char* Vimg = lds + 65536;
    for (;;) {
        if (tid == 0) *qslot = __hip_atomic_fetch_add(ctl + CW_QUEUE, 1u, RLX_AGENT);
        __syncthreads();
        const int it = (int)*qslot;
        if (it >= NBLK * BATCH * NH) break;
        const int j = it >> 5, bh = it & 31, b = bh >> 3, hd = bh & 7;
        const size_t kvrow0 = (size_t)b * SEQ + (size_t)j * BS;
        int lane_d = lane; asm volatile("" : "+v"(lane_d));
#pragma unroll
        for (int i = 0; i < 8; ++i) {
            const int pc = i * 8 + wave, row = 4 * pc + (lane_d >> 4), ch = (lane_d & 15) ^ (((lane_d >> 4) << 2) | (pc & 3));
            const size_t src = (kvrow0 + row) * DM + hd * HD + ch * 8;
            __builtin_amdgcn_global_load_lds((const unsigned*)(Kb + src), (LAS unsigned*)(Kimg + pc * 1024), 16, 0, 0);
            __builtin_amdgcn_global_load_lds((const unsigned*)(Vb + src), (LAS unsigned*)(Vimg + pc * 1024), 16, 0, 0);
        }
        const int n = (int)__hip_atomic_load(ctl + CW_CNT + bh * 32 + j, RLX_AGENT);
        const unsigned* lb = lists + (size_t)bh * LIST_PER_BH + list_off(j);
        asm volatile("s_waitcnt vmcnt(0)" ::: "memory");
        __syncthreads();
        const int nch = 8 + ((n + 31) >> 5);
        {
            const int r32 = lane & 31, hi = lane >> 5;
            const size_t qcol = (size_t)hd * HD + 8 * hi;
            int c = wave;
            int tq = j * BS + c * 32 + r32, slot = 3; bool valid = true;
            bf16x8 qf[8];
            { const bf16* qp = Qb + ((size_t)b * SEQ + tq) * DM + qcol;
#pragma unroll
              for (int s = 0; s < 8; ++s) qf[s] = *(const bf16x8*)(qp + 16 * s); }
            while (c < nch) {
                const int cn = c + NWAVES; const bool has_next = cn < nch;
                const int e = (cn - 8) * 32 + r32; const bool valid_n = has_next && e < n;
                const unsigned ent = valid_n ? lb[e] : (unsigned)(j * BS);
                const bf16* qnext = has_next ? Qb + ((size_t)b * SEQ + (ent & 8191u)) * DM + qcol : nullptr;
                attn_wave_item(Kimg, Vimg, qf, qnext, Opart, lse, (size_t)b * SEQ + tq, hd, slot, valid, c < 8 ? c : 7, c < 8, lane);
                c = cn; tq = (int)(ent & 8191u); slot = (int)(ent >> 13); valid = valid_n;
            }
        }
        __syncthreads();
    }
}


__device__ __forceinline__ int fresh_lane() { int l = __builtin_amdgcn_mbcnt_hi(~0u, __builtin_amdgcn_mbcnt_lo(~0u, 0u)); asm volatile("" : "+v"(l)); return l; }
typedef const __attribute__((address_space(4))) Args* KArgs;
__device__ __forceinline__ KArgs get_args() { const __attribute__((address_space(4))) void* p = (const __attribute__((address_space(4))) void*)__builtin_amdgcn_kernarg_segment_ptr(); asm volatile("" : "+s"(p)); return (KArgs)p; }
#define GRID_BAR() do { XcdBarrier b_; b_.bar = (unsigned*)(get_args()->ws + WS_CTL) + CW_BAR; b_.x = xb_xcc_id(); b_.st = MISC + 8; const bool lead_ = (wave == 0) && (fresh_lane() == 0); xcd_barrier(b_, lead_); if (PROBE_MASK_V & (1u << 14)) xcd_barrier(b_, lead_); } while (0)

#ifndef PROBE_MASK_V
#define PROBE_MASK_V 0u
#endif
constexpr unsigned PROBE_MASK = PROBE_MASK_V;
#define PH_BEGIN() const unsigned long long t0_ = PROBE_MASK ? __builtin_amdgcn_s_memrealtime() : 0ull
#define PH_END(p) do { if (PROBE_MASK & (1u << (p))) { const unsigned long long t1_ = __builtin_amdgcn_s_memrealtime(); while (__builtin_amdgcn_s_memrealtime() - t1_ < t1_ - t0_) __builtin_amdgcn_s_sleep(8); } } while (0)
#define WSP(T, off) ((T*)(ws + (off)))
__global__ void __launch_bounds__(NWAVES * 64, 2) moba_fwd(Args args_unused) {
    extern __shared__ __attribute__((aligned(16))) unsigned char lds_raw[];
    LAS unsigned char* lds = (LAS unsigned char*)lds_raw;
    volatile LAS unsigned* MISC = (volatile LAS unsigned*)(lds + MISC_OFF);
    const int wave = __builtin_amdgcn_readfirstlane((int)threadIdx.x >> 6);
    const int G = gridDim.x; const int bx = blockIdx.x; const int vcu = (G % 8 == 0) ? (bx % 8) * (G / 8) + bx / 8 : bx;
    for (int u = threadIdx.x; u < (LDS_BYTES - LDSCTL_OFF) / 4; u += NWAVES * 64) ((LAS unsigned*)(lds + LDSCTL_OFF))[u] = 0u;
    __syncthreads();
    (void)xcd_barrier_post((unsigned*)(get_args()->ws + WS_CTL) + CW_BAR, MISC + 8);
    const int NGW = G * NWAVES;
    const int NGT = G * NWAVES * 64;
#define PHASE_IDS() int vcu_ = vcu; asm volatile("" : "+s"(vcu_)); const int lane = fresh_lane(), tid = wave * 64 + lane, gw = vcu_ * NWAVES + wave, gt = vcu_ * NWAVES * 64 + tid; (void)gt; (void)tid; (void)gw

    {
        PH_BEGIN(); PHASE_IDS();
        KArgs A = get_args(); unsigned char* ws = A->ws;
        const float* x = A->in[0]; const float* attn_norm = A->in[1]; const float* w_qkv = A->in[2]; const float* w_o = A->in[3];
        const float* conv_norm = A->in[4]; const float* w_ci = A->in[5]; const float* w_co = A->in[7];
        const float* ffn_norm = A->in[8]; const float* w_f1 = A->in[9]; const float* w_f2 = A->in[10];
        bf16* Wqkv_t = WSP(bf16, WS_WQKV); bf16* Wo_t = WSP(bf16, WS_WO); bf16* Wf1_t = WSP(bf16, WS_WF1); bf16* Wf2_t = WSP(bf16, WS_WF2); bf16* Wci_t = WSP(bf16, WS_WCI); bf16* Wco_t = WSP(bf16, WS_WCO);
        bf16* XB = WSP(bf16, WS_XB); float* ss0 = WSP(float, WS_SS0);
        LAS unsigned char* scr = lds + RING_OFF + wave * 16384;
        constexpr int I_QKV = (DM / 64) * (3 * DM / 64), I_O = (DM / 64) * (DM / 64), I_F1 = (DM / 64) * (2 * FF / 64), I_F2 = (FF / 64) * (DM / 64);
        constexpr int NITEMS = I_QKV + I_O + 2 * I_F1 + 2 * I_F2 + I_QKV + I_O;
        for (int it = gw; it < NITEMS; it += NGW) {
            int r = it;
            if (r < I_QKV) { const int nb = 3 * DM / 64, k0 = 64 * (r / nb), n0 = 64 * (r % nb); p0_item(w_qkv, 3 * DM, DM, k0, n0, Wqkv_t, n0, attn_norm, scr, lane); continue; } r -= I_QKV;
            if (r < I_O) { const int nb = DM / 64, k0 = 64 * (r / nb), n0 = 64 * (r % nb); p0_item(w_o, DM, DM, k0, n0, Wo_t, n0, nullptr, scr, lane); continue; } r -= I_O;
            if (r < 2 * I_F1) { const int L = r / I_F1; r -= L * I_F1; const int nb = 2 * FF / 64, k0 = 64 * (r / nb), n0 = 64 * (r % nb);
                p0_item(w_f1 + (size_t)L * DM * 2 * FF, 2 * FF, DM, k0, n0, Wf1_t + (size_t)L * 2 * FF * DM, interleave128(n0, FF), ffn_norm + L * DM, scr, lane); continue; } r -= 2 * I_F1;
            if (r < 2 * I_F2) { const int L = r / I_F2; r -= L * I_F2; const int nb = DM / 64, k0 = 64 * (r / nb), n0 = 64 * (r % nb);
                p0_item(w_f2 + (size_t)L * FF * DM, DM, FF, k0, n0, Wf2_t + (size_t)L * DM * FF, n0, nullptr, scr, lane); continue; } r -= 2 * I_F2;
            if (r < I_QKV) { const int nb = 3 * DM / 64, k0 = 64 * (r / nb), n0 = 64 * (r % nb);
                const int nd = n0 < DM ? 2 * DM + n0 : interleave128(n0 - DM, DM);
                p0_item(w_ci, 3 * DM, DM, k0, n0, Wci_t, nd, conv_norm, scr, lane); continue; } r -= I_QKV;
            { const int nb = DM / 64, k0 = 64 * (r / nb), n0 = 64 * (r % nb); p0_item(w_co, DM, DM, k0, n0, Wco_t, n0, nullptr, scr, lane); }
        }
        for (int i = gt; i < (int)(MiB / 16); i += NGT) ((v4u*)(ws + WS_KSUM))[i] = (v4u){0u, 0u, 0u, 0u};
        for (int m = gw; m < MROWS; m += 2 * NGW) {
            const int m2 = m + NGW;
            const bool has2 = m2 < MROWS; const int mb = has2 ? m2 : m;
            const f32x4* xa = (const f32x4*)(x + (size_t)m * DM) + lane; const f32x4* xc = (const f32x4*)(x + (size_t)mb * DM) + lane; f32x4 va[4], vc[4]; float sa = 0.f, sc = 0.f;
#pragma unroll
            for (int j = 0; j < 4; ++j) { va[j] = __builtin_nontemporal_load(xa + 64 * j); vc[j] = __builtin_nontemporal_load(xc + 64 * j); }
#pragma unroll
            for (int j = 0; j < 4; ++j) { sa += (va[j].x * va[j].x + va[j].y * va[j].y) + (va[j].z * va[j].z + va[j].w * va[j].w); sc += (vc[j].x * vc[j].x + vc[j].y * vc[j].y) + (vc[j].z * vc[j].z + vc[j].w * vc[j].w); }
            sa = wave_sum(sa); sc = wave_sum(sc);
            if (lane == 0) { ss0[m] = sa; if (has2) ss0[m2] = sc; }
            unsigned long long* oa = (unsigned long long*)(XB + (size_t)m * DM) + lane; unsigned long long* oc = (unsigned long long*)(XB + (size_t)mb * DM) + lane;
#pragma unroll
            for (int j = 0; j < 4; ++j) oa[64 * j] = (unsigned long long)pk2(va[j].x, va[j].y) | ((unsigned long long)pk2(va[j].z, va[j].w) << 32);
            if (has2) {
#pragma unroll
                for (int j = 0; j < 4; ++j) oc[64 * j] = (unsigned long long)pk2(vc[j].x, vc[j].y) | ((unsigned long long)pk2(vc[j].z, vc[j].w) << 32);
            }
        }
        PH_END(0);
    }
    GRID_BAR();

    {
        PH_BEGIN(); PHASE_IDS();
        unsigned char* ws = get_args()->ws;
        pg8::Gemm g{WSP(bf16, WS_XB), WSP(bf16, WS_WQKV), MROWS, 3 * DM, DM}; pg8::StaticOrder S; S.init(MROWS, 3 * DM, G, bx, WGM_N3072);
        pg8::EpiQKV E{WSP(bf16, WS_Q), (size_t)MROWS * DM, WSP(float, WS_SS0), WSP(float, WS_KSUM), QSCALE};
        pg8::gemm_phase<pg8::EpiQKV, pg8::StaticOrder, PG8_ALIGN, PG8_SP2>(lds + RING_OFF, g, S, E, wave);
        PH_END(1);
    }
    GRID_BAR();

    {
        PH_BEGIN(); PHASE_IDS();
        KArgs A = get_args(); unsigned char* ws = A->ws;
        for (int u = vcu_; u < BATCH * NBLK * NH; u += G) gate_unit(u >> 8, (u >> 3) & 31, u & 7, WSP(bf16, WS_Q), WSP(float, WS_KSUM), (gu32*)(ws + WS_CTL) + CW_CNT, (unsigned*)A->out + OUT_LIST_OFF, lds + RING_OFF, tid, lane, wave);
        PH_END(2);
    }
    GRID_BAR();
    {
        PH_BEGIN(); PHASE_IDS();
        KArgs A = get_args(); unsigned char* ws = A->ws;
        attn_phase(lds + RING_OFF, MISC + 16, (gu32*)(ws + WS_CTL), WSP(bf16, WS_Q), WSP(bf16, WS_K), WSP(bf16, WS_V), WSP(bf16, WS_XB), A->out + OUT_LSE_OFF, (const unsigned*)A->out + OUT_LIST_OFF, tid, lane, wave);
        PH_END(3);
    }
    GRID_BAR();
    {
        PH_BEGIN(); PHASE_IDS();
        KArgs A = get_args(); unsigned char* ws = A->ws;
        const float* lse = A->out + OUT_LSE_OFF; const bf16* Opart = WSP(bf16, WS_XB); bf16* Qb = WSP(bf16, WS_Q);
        for (int base = gt; base < MROWS * NH * 16; base += 4 * NGT) {
            f32x4 L[4]; v4u o[4][4]; int mhv[4];
#pragma unroll
            for (int q = 0; q < 4; ++q) { const int idx = base + q * NGT; mhv[q] = (idx < MROWS * NH * 16 ? idx : base) >> 4; L[q] = *(const f32x4*)(lse + (size_t)mhv[q] * 4); }
#pragma unroll
            for (int q = 0; q < 4; ++q) { const bf16* op = Opart + (size_t)mhv[q] * 4 * HD + (gt & 15) * 8;
#pragma unroll
                for (int k = 0; k < 4; ++k) o[q][k] = __builtin_nontemporal_load((const v4u*)(op + k * HD)); }
#pragma unroll
            for (int q = 0; q < 4; ++q) {
                const int idx = base + q * NGT; if (idx >= MROWS * NH * 16) break;
                const int mh = mhv[q], piece = gt & 15, m = mh >> 3, ib = (m & (SEQ - 1)) >> 8, nsel = ib < 3 ? ib : 3;
                float mx = L[q][3]; if (nsel > 0) mx = fmaxf(mx, L[q][0]); if (nsel > 1) mx = fmaxf(mx, L[q][1]); if (nsel > 2) mx = fmaxf(mx, L[q][2]);
                float w[4]; w[3] = __builtin_amdgcn_exp2f(L[q][3] - mx);
#pragma unroll
                for (int k = 0; k < 3; ++k) w[k] = nsel > k ? __builtin_amdgcn_exp2f(L[q][k] - mx) : 0.f;
                float a8[8];
#pragma unroll
                for (int e = 0; e < 8; ++e) a8[e] = 0.f;
#pragma unroll
                for (int k = 0; k < 4; ++k) { const bool ok = (k == 3 || nsel > k);
#pragma unroll
                    for (int e = 0; e < 4; ++e) { const unsigned wd = ok ? o[q][k][e] : 0u; a8[2 * e] += w[k] * bf_lo(wd); a8[2 * e + 1] += w[k] * bf_hi(wd); } }
                const float inv = 1.0f / ((w[0] + w[1]) + (w[2] + w[3]));
                v4u y;
#pragma unroll
                for (int e = 0; e < 4; ++e) y[e] = pk2(a8[2 * e] * inv, a8[2 * e + 1] * inv);
                *(v4u*)(Qb + (size_t)m * DM + (mh & 7) * HD + piece * 8) = y;
            }
        }
        PH_END(4);
    }
    GRID_BAR();

    {
        PH_BEGIN(); PHASE_IDS();
        KArgs A = get_args(); unsigned char* ws = A->ws;
        pg8::Gemm g{WSP(bf16, WS_Q), WSP(bf16, WS_WO), MROWS, DM, DM}; pg8::StaticOrder S; S.init(MROWS, DM, G, bx, WGM_N1024);
        pg8::EpiRes<true, true> E{A->in[0], WSP(bf16, WS_XB), WSP(float, WS_SS)};
        pg8::gemm_phase<pg8::EpiRes<true, true>, pg8::StaticOrder, PG8_ALIGN, PG8_SP2>(lds + RING_OFF, g, S, E, wave);
        PH_END(5);
    }
    GRID_BAR();

    {
        PH_BEGIN(); PHASE_IDS();
        unsigned char* ws = get_args()->ws;
        pg8::Gemm g{WSP(bf16, WS_XB), WSP(bf16, WS_WF1), MROWS, 2 * FF, DM}; pg8::StaticOrder S; S.init(MROWS, 2 * FF, G, bx, WGM_FFNIN);
        pg8::EpiSwiglu E{WSP(bf16, WS_H), FF, WSP(float, WS_SS)};
        pg8::gemm_phase<pg8::EpiSwiglu, pg8::StaticOrder, PG8_ALIGN, PG8_SP2>(lds + RING_OFF, g, S, E, wave);
        PH_END(6);
    }
    GRID_BAR();
    {
        PH_BEGIN(); PHASE_IDS();
        KArgs A = get_args(); unsigned char* ws = A->ws;
        pg8::Gemm g{WSP(bf16, WS_H), WSP(bf16, WS_WF2), MROWS, DM, FF}; pg8::StaticOrder S; S.init(MROWS, DM, G, bx, WGM_FFNOUT);
        pg8::EpiRes<false, true> E{nullptr, WSP(bf16, WS_XB), WSP(float, WS_SS) + MROWS};
        pg8::gemm_phase<pg8::EpiRes<false, true>, pg8::StaticOrder, PG8_ALIGN, PG8_SP2>(lds + RING_OFF, g, S, E, wave);
        PH_END(7);
    }
    GRID_BAR();

    {
        PH_BEGIN(); PHASE_IDS();
        unsigned char* ws = get_args()->ws;
        pg8::Gemm g{WSP(bf16, WS_XB), WSP(bf16, WS_WCI), MROWS, 3 * DM, DM}; pg8::StaticOrder S; S.init(MROWS, 3 * DM, G, bx, WGM_N3072);
        pg8::EpiConvIn E{WSP(bf16, WS_Q), WSP(bf16, WS_K), WSP(float, WS_SS) + MROWS};
        pg8::gemm_phase<pg8::EpiConvIn, pg8::StaticOrder, PG8_ALIGN, PG8_SP2>(lds + RING_OFF, g, S, E, wave);
        PH_END(8);
    }
    GRID_BAR();

    {
        PH_BEGIN(); PHASE_IDS();
        KArgs A = get_args(); unsigned char* ws = A->ws; const float* conv_w = A->in[6];
        const bf16* Qb = WSP(bf16, WS_Q); const bf16* Kb = WSP(bf16, WS_K); bf16* Vb = WSP(bf16, WS_V);
        const int c8 = (gt & 127) * 8;
        const f32x4 w0a = *(const f32x4*)(conv_w + c8), w0b = *(const f32x4*)(conv_w + c8 + 4), w1a = *(const f32x4*)(conv_w + DM + c8), w1b = *(const f32x4*)(conv_w + DM + c8 + 4),
                    w2a = *(const f32x4*)(conv_w + 2 * DM + c8), w2b = *(const f32x4*)(conv_w + 2 * DM + c8 + 4);
        for (int base = gt; base < MROWS * (DM / 8); base += 4 * NGT) {
            v4u u2[4], u1[4], u0[4], bb[4]; size_t offs[4]; bool okq[4];
#pragma unroll
            for (int q = 0; q < 4; ++q) {
                const int idx = base + q * NGT; okq[q] = idx < MROWS * (DM / 8); const int m = (okq[q] ? idx : base) >> 7, t = m & (SEQ - 1);
                offs[q] = (size_t)m * DM + c8;
                u2[q] = *(const v4u*)(Qb + offs[q]); bb[q] = __builtin_nontemporal_load((const v4u*)(Kb + offs[q]));
                u1[q] = (v4u){0u, 0u, 0u, 0u}; u0[q] = (v4u){0u, 0u, 0u, 0u};
                if (t >= 1) u1[q] = *(const v4u*)(Qb + offs[q] - DM);
                if (t >= 2) u0[q] = *(const v4u*)(Qb + offs[q] - 2 * DM);
            }
#pragma unroll
            for (int q = 0; q < 4; ++q) {
                v4u y;
#pragma unroll
                for (int e = 0; e < 4; ++e) {
                    const float wl0 = e < 2 ? w0a[2 * e] : w0b[2 * e - 4], wh0 = e < 2 ? w0a[2 * e + 1] : w0b[2 * e - 3];
                    const float wl1 = e < 2 ? w1a[2 * e] : w1b[2 * e - 4], wh1 = e < 2 ? w1a[2 * e + 1] : w1b[2 * e - 3];
                    const float wl2 = e < 2 ? w2a[2 * e] : w2b[2 * e - 4], wh2 = e < 2 ? w2a[2 * e + 1] : w2b[2 * e - 3];
                    const float lo = bf_lo(bb[q][e]) * (wl0 * bf_lo(u0[q][e]) + wl1 * bf_lo(u1[q][e]) + wl2 * bf_lo(u2[q][e]));
                    const float hi = bf_hi(bb[q][e]) * (wh0 * bf_hi(u0[q][e]) + wh1 * bf_hi(u1[q][e]) + wh2 * bf_hi(u2[q][e]));
                    y[e] = pk2(lo, hi);
                }
                if (okq[q]) *(v4u*)(Vb + offs[q]) = y;
            }
        }
        PH_END(9);
    }
    GRID_BAR();

    {
        PH_BEGIN(); PHASE_IDS();
        KArgs A = get_args(); unsigned char* ws = A->ws;
        pg8::Gemm g{WSP(bf16, WS_V), WSP(bf16, WS_WCO), MROWS, DM, DM}; pg8::StaticOrder S; S.init(MROWS, DM, G, bx, WGM_N1024);
        pg8::EpiRes<false, true> E{nullptr, WSP(bf16, WS_XB), WSP(float, WS_SS) + 2 * MROWS};
        pg8::gemm_phase<pg8::EpiRes<false, true>, pg8::StaticOrder, PG8_ALIGN, PG8_SP2>(lds + RING_OFF, g, S, E, wave);
        PH_END(10);
    }
    GRID_BAR();

    {
        PH_BEGIN(); PHASE_IDS();
        unsigned char* ws = get_args()->ws;
        pg8::Gemm g{WSP(bf16, WS_XB), WSP(bf16, WS_WF1) + (size_t)2 * FF * DM, MROWS, 2 * FF, DM}; pg8::StaticOrder S; S.init(MROWS, 2 * FF, G, bx, WGM_FFNIN);
        pg8::EpiSwiglu E{WSP(bf16, WS_H), FF, WSP(float, WS_SS) + 2 * MROWS};
        pg8::gemm_phase<pg8::EpiSwiglu, pg8::StaticOrder, PG8_ALIGN, PG8_SP2>(lds + RING_OFF, g, S, E, wave);
        PH_END(11);
    }
    GRID_BAR();
    {
        PH_BEGIN(); PHASE_IDS();
        KArgs A = get_args(); unsigned char* ws = A->ws;
        pg8::Gemm g{WSP(bf16, WS_H), WSP(bf16, WS_WF2) + (size_t)DM * FF, MROWS, DM, FF}; pg8::StaticOrder S; S.init(MROWS, DM, G, bx, WGM_FFNOUT);
        pg8::EpiRes<false, false> E{nullptr, WSP(bf16, WS_XB), nullptr};
        pg8::gemm_phase<pg8::EpiRes<false, false>, pg8::StaticOrder, PG8_ALIGN, PG8_SP2>(lds + RING_OFF, g, S, E, wave);
        PH_END(12);
    }
    GRID_BAR();

    {
        PH_BEGIN(); PHASE_IDS();
        KArgs A = get_args(); float* out = A->out; const float* final_norm = A->in[11]; const bf16* XB = (const bf16*)(A->ws + WS_XB);
        const f32x4* gr = (const f32x4*)final_norm + lane; f32x4 gg[4];
#pragma unroll
        for (int j = 0; j < 4; ++j) gg[j] = gr[64 * j];
        for (int m = gw; m < MROWS; m += 2 * NGW) {
            const int m2 = m + NGW; const bool has2 = m2 < MROWS; const int mb = has2 ? m2 : m;
            typedef unsigned u32x2_t __attribute__((ext_vector_type(2)));
            const u32x2_t* xa = (const u32x2_t*)(XB + (size_t)m * DM) + lane; const u32x2_t* xc = (const u32x2_t*)(XB + (size_t)mb * DM) + lane; u32x2_t pa[4], pc[4];
#pragma unroll
            for (int j = 0; j < 4; ++j) { pa[j] = xa[64 * j]; pc[j] = xc[64 * j]; }
            f32x4 va[4], vc[4]; float sa = 0.f, sc = 0.f;
#pragma unroll
            for (int j = 0; j < 4; ++j) { va[j] = (f32x4){bf_lo(pa[j].x), bf_hi(pa[j].x), bf_lo(pa[j].y), bf_hi(pa[j].y)}; vc[j] = (f32x4){bf_lo(pc[j].x), bf_hi(pc[j].x), bf_lo(pc[j].y), bf_hi(pc[j].y)};
                sa += (va[j].x * va[j].x + va[j].y * va[j].y) + (va[j].z * va[j].z + va[j].w * va[j].w); sc += (vc[j].x * vc[j].x + vc[j].y * vc[j].y) + (vc[j].z * vc[j].z + vc[j].w * vc[j].w); }
            const float ra = __builtin_amdgcn_rsqf(wave_sum(sa) * (1.0f / DM) + EPS), rc = __builtin_amdgcn_rsqf(wave_sum(sc) * (1.0f / DM) + EPS);
            f32x4* oa = (f32x4*)(out + (size_t)m * DM) + lane; f32x4* oc = (f32x4*)(out + (size_t)mb * DM) + lane;
#pragma unroll
            for (int j = 0; j < 4; ++j) oa[64 * j] = va[j] * ra * gg[j];
            if (has2) {
#pragma unroll
                for (int j = 0; j < 4; ++j) oc[64 * j] = vc[j] * rc * gg[j];
            }
        }
        PH_END(13);
    }
}

extern "C" void kernel_launch(void* const* d_in, const int* in_sizes, int n_in, void* d_out, int out_size, void* d_ws, size_t ws_size, hipStream_t stream) {
    static int grid = 0;
    if (grid == 0) {
        if (n_in != 12 || in_sizes[0] != MROWS * DM || out_size != MROWS * DM || ws_size < WS_END) {
            fprintf(stderr, "kernel_launch: unexpected shapes (n_in %d, in0 %d, out %d, ws %zu); nothing launched\n", n_in, n_in > 0 ? in_sizes[0] : -1, out_size, ws_size); grid = -1; return; }
        int dev = 0, cus = 0, per_cu = 0;
        if (hipGetDevice(&dev) != hipSuccess || hipDeviceGetAttribute(&cus, hipDeviceAttributeMultiprocessorCount, dev) != hipSuccess) { grid = -1; return; }
        if (hipFuncSetAttribute((const void*)moba_fwd, hipFuncAttributeMaxDynamicSharedMemorySize, LDS_BYTES) != hipSuccess) { fprintf(stderr, "kernel_launch: hipFuncSetAttribute failed\n"); grid = -1; return; }
        if (hipOccupancyMaxActiveBlocksPerMultiprocessor(&per_cu, (const void*)moba_fwd, NWAVES * 64, LDS_BYTES) != hipSuccess || per_cu < 1) {
            fprintf(stderr, "kernel_launch: occupancy query reports %d blocks per CU; nothing launched\n", per_cu); (void)hipGetLastError(); grid = -1; return; }
        grid = cus;
    }
    if (grid < 0) return;
    if (hipMemsetAsync((char*)d_ws + WS_CTL, 0, CTL_ZERO_BYTES, stream) != hipSuccess) return;
    Args a{};
    for (int i = 0; i < 12; ++i) a.in[i] = (const float*)d_in[i];
    a.out = (float*)d_out; a.ws = (unsigned char*)d_ws;
    hipLaunchKernelGGL(moba_fwd, dim3(grid), dim3(NWAVES * 64), LDS_BYTES, stream, a);
}
```
